# Optimizing an MI355X kernel written in HIP

```python
import math
import jax
import jax.numpy as jnp
from jax import lax
import numpy as np

D_MODEL = 1024
BATCH = 32
SEQ = 2048
DEPTH = 2

CTX_LEN = 256
GRID_W = 64
NORM_EPS = 1e-6
N_MODS = 6
N_BRANCH = 3
BRANCH_W = D_MODEL
LRU_WIDTH = BRANCH_W
LRU_BLOCKS = 8
LRU_BLOCK = LRU_WIDTH // LRU_BLOCKS
LRU_C = 8.0
CONV_WIDTH = 4
CONV_PAD = (2, 1)
ML_HEADS = 4
ML_DV = BRANCH_W // ML_HEADS
ML_DQK = ML_DV // 2
ML_CHUNK = 64
ML_GATES = 2 * 2 * ML_HEADS
DA_HEADS = 8
DA_DV = BRANCH_W // DA_HEADS
DA_DH = DA_DV // 2
ROPE_THETA = 10000.0
Q_BLOCK = 128
N_EXPERTS = 64
TOP_K = 6
EXPERT_FF = D_MODEL // 4
SHARED_FF = D_MODEL // 4
ROUTED_SCALE = 2.5
EXPERT_GROUP = 8
PROJ_SIZES = (LRU_WIDTH, LRU_WIDTH,
              ML_HEADS * ML_DQK, ML_HEADS * ML_DQK, ML_HEADS * ML_DV, ML_HEADS * ML_DV, ML_GATES,
              DA_HEADS * 2 * DA_DH, DA_HEADS * 2 * DA_DH, DA_HEADS * DA_DV,
              N_BRANCH * D_MODEL)
PROJ_WIDTH = sum(PROJ_SIZES)

kernel_name = 'hybrid_rglru_mlstm_diffattn_moe_dit'


def rms_norm(x, g):
    xf = x.astype(jnp.float32)
    y = xf * lax.rsqrt(jnp.mean(xf * xf, axis=-1, keepdims=True) + NORM_EPS)
    return (y * g.astype(jnp.float32)).astype(x.dtype)


def modulate(h, shift, scale):
    return h * (1 + scale) + shift


def ada_mods(cond, w_ada, b_ada):
    m = jax.nn.silu(cond) @ w_ada + b_ada
    return jnp.split(m, N_MODS, axis=-1)


def flip_seq(t):
    return t[:, ::-1]


def no_flip(t):
    return t


def proj_split_points():
    return [int(v) for v in np.cumsum(PROJ_SIZES)[:-1]]


def short_conv(x, w, b):
    y = lax.conv_general_dilated(x, w.astype(x.dtype)[:, None, :], window_strides=(1,),
                                 padding=[CONV_PAD], dimension_numbers=('NWC', 'WIO', 'NWC'),
                                 feature_group_count=x.shape[-1])
    return y + b.astype(x.dtype)


def rglru_coeffs(u, wa, ba, wx, bx, lam):
    uf = u.astype(jnp.float32)
    ub = uf.reshape(*uf.shape[:-1], LRU_BLOCKS, LRU_BLOCK)
    r = jax.nn.sigmoid(jnp.einsum('bshi,hij->bshj', ub, wa.astype(jnp.float32)).reshape(uf.shape) + ba.astype(jnp.float32))
    i = jax.nn.sigmoid(jnp.einsum('bshi,hij->bshj', ub, wx.astype(jnp.float32)).reshape(uf.shape) + bx.astype(jnp.float32))
    log_a = -LRU_C * r * jax.nn.softplus(-lam.astype(jnp.float32))
    a = jnp.exp(log_a)
    b = jnp.sqrt(-jnp.expm1(2.0 * log_a)) * (i * uf)
    return a, b


def linear_recurrence(a, b, h0):
    def combine(l, r):
        return l[0] * r[0], r[0] * l[1] + r[1]
    a_cum, h = lax.associative_scan(combine, (a, b), axis=1)
    return h + a_cum * h0[:, None, :]


def rglru_branch(ctx_in, lat_in, conv_w, conv_b, wa, ba, wx, bx, lam, need_ctx):
    xa_c, ga_c = ctx_in
    xa_l, ga_l = lat_in
    u_c = short_conv(xa_c, conv_w, conv_b)
    u_l = short_conv(xa_l, conv_w, conv_b)
    h_zero = jnp.zeros((u_l.shape[0], LRU_WIDTH), jnp.float32)
    h_l = 0.0
    h_c = 0.0
    for d in range(2):
        fl = flip_seq if d else no_flip
        a_c, b_c = rglru_coeffs(fl(u_c), wa[d], ba[d], wx[d], bx[d], lam[d])
        hs_c = linear_recurrence(a_c, b_c, h_zero)
        a_l, b_l = rglru_coeffs(fl(u_l), wa[d], ba[d], wx[d], bx[d], lam[d])
        hs_l = linear_recurrence(a_l, b_l, hs_c[:, -1])
        h_l = h_l + fl(hs_l)
        if need_ctx:
            h_c = h_c + fl(hs_c)
    y_l = (jax.nn.gelu(ga_l) * h_l).astype(ga_l.dtype)
    y_c = (jax.nn.gelu(ga_c) * h_c).astype(ga_c.dtype) if need_ctx else None
    return y_l, y_c


def mlstm_heads(q, k, v, g, gate_b):
    B, S = q.shape[:2]
    q = q.reshape(B, S, ML_HEADS, ML_DQK)
    k = k.reshape(B, S, ML_HEADS, ML_DQK) * (ML_DQK ** -0.5)
    v = v.reshape(B, S, ML_HEADS, ML_DV)
    g = g.astype(jnp.float32).reshape(B, S, 2, 2, ML_HEADS) + gate_b.astype(jnp.float32)
    return q, k, v, g[:, :, :, 0], jax.nn.log_sigmoid(g[:, :, :, 1])


def mlstm_chunkwise(q, k, v, ig, lf, state):
    B, S, H, DK = q.shape
    DV = v.shape[-1]
    nc = S // ML_CHUNK
    causal = jnp.tril(jnp.ones((ML_CHUNK, ML_CHUNK), dtype=bool))

    def chunks(t):
        return t.reshape(B, nc, ML_CHUNK, *t.shape[2:]).swapaxes(0, 1)

    def step(carry, xs):
        C, n, m = carry
        qc, kc, vc, ic, fc = xs
        b = jnp.cumsum(fc, axis=1).swapaxes(1, 2)
        i_ = ic.swapaxes(1, 2)
        d_intra = jnp.where(causal, b[..., :, None] - b[..., None, :] + i_[..., None, :], -jnp.inf)
        d_inter = b + m[..., None]
        m_row = jnp.maximum(d_inter, d_intra.max(-1))
        w_intra = jnp.exp(d_intra - m_row[..., None])
        w_inter = jnp.exp(d_inter - m_row)
        s = jnp.einsum('bjhd,bshd->bhjs', qc, kc).astype(jnp.float32) * w_intra
        num = (jnp.einsum('bhjs,bshe->bjhe', s, vc)
               + jnp.einsum('bjhd,bhde->bjhe', qc, C) * w_inter.swapaxes(1, 2)[..., None])
        den = s.sum(-1) + jnp.einsum('bjhd,bhd->bhj', qc, n) * w_inter
        h = num / jnp.maximum(jnp.abs(den), jnp.exp(-m_row)).swapaxes(1, 2)[..., None]
        g_end = b[..., -1:] - b + i_
        m_new = jnp.maximum(b[..., -1] + m, g_end.max(-1))
        w_s = jnp.exp(g_end - m_new[..., None])
        w_c = jnp.exp(b[..., -1] + m - m_new)
        kw = kc * w_s.swapaxes(1, 2)[..., None]
        C_new = w_c[..., None, None] * C + jnp.einsum('bshd,bshe->bhde', kw, vc)
        n_new = w_c[..., None] * n + kw.sum(axis=1)
        return (C_new, n_new, m_new), h

    state, h = lax.scan(step, state, tuple(chunks(t) for t in (q, k, v, ig, lf)))
    return h.swapaxes(0, 1).reshape(B, S, H, DV), state


def mlstm_branch(ctx_in, lat_in, gate_b, norm_g, need_ctx):
    qc, kc, vc, ic, fc = mlstm_heads(ctx_in[0], ctx_in[1], ctx_in[2], ctx_in[4], gate_b)
    ql, kl, vl, il, flg = mlstm_heads(lat_in[0], lat_in[1], lat_in[2], lat_in[4], gate_b)
    B = ql.shape[0]
    zero = (jnp.zeros((B, ML_HEADS, ML_DQK, ML_DV), jnp.float32),
            jnp.zeros((B, ML_HEADS, ML_DQK), jnp.float32),
            jnp.zeros((B, ML_HEADS), jnp.float32))
    h_l = 0.0
    h_c = 0.0
    for d in range(2):
        fl = flip_seq if d else no_flip
        hs_c, st = mlstm_chunkwise(fl(qc), fl(kc), fl(vc), fl(ic[:, :, d]), fl(fc[:, :, d]), zero)
        hs_l, _ = mlstm_chunkwise(fl(ql), fl(kl), fl(vl), fl(il[:, :, d]), fl(flg[:, :, d]), st)
        h_l = h_l + fl(hs_l)
        if need_ctx:
            h_c = h_c + fl(hs_c)

    def finish(h, o):
        hn = rms_norm(h, norm_g).reshape(o.shape)
        return (hn * jax.nn.sigmoid(o.astype(jnp.float32))).astype(o.dtype)

    y_l = finish(h_l, lat_in[3])
    y_c = finish(h_c, ctx_in[3]) if need_ctx else None
    return y_l, y_c


def axial_rope_tables(rows):
    nf = DA_DH // 4
    freqs = jnp.power(ROPE_THETA, -jnp.arange(nf, dtype=jnp.float32) / nf)
    row = jnp.repeat(jnp.arange(rows, dtype=jnp.float32), GRID_W)
    col = jnp.tile(jnp.arange(GRID_W, dtype=jnp.float32), rows)
    ang = jnp.stack([row, col], axis=-1)[..., None] * freqs
    return jnp.cos(ang), jnp.sin(ang)


def apply_axial_rope(t, cos, sin):
    xs = t.reshape(*t.shape[:-1], 2, 2, DA_DH // 4)
    x1, x2 = xs[..., 0, :], xs[..., 1, :]
    c = cos[:, None, None].astype(t.dtype)
    s = sin[:, None, None].astype(t.dtype)
    return jnp.stack([x1 * c - x2 * s, x2 * c + x1 * s], axis=-2).reshape(t.shape)


def diff_softmax_attend(q, k, v, lam):
    s = jnp.einsum('bqhcd,bkhcd->bhcqk', q, k).astype(jnp.float32) * (DA_DH ** -0.5)
    p = jax.nn.softmax(s, axis=-1)
    a = p[:, :, 0] - lam * p[:, :, 1]
    return jnp.einsum('bhqk,bkhe->bqhe', a.astype(v.dtype), v)


def blocked_diff_attention(q, k, v, lam):
    B, S = q.shape[:2]
    nb = S // Q_BLOCK
    qb = q.reshape(B, nb, Q_BLOCK, *q.shape[2:]).swapaxes(0, 1)
    out = lax.map(lambda qi: diff_softmax_attend(qi, k, v, lam), qb)
    return out.swapaxes(0, 1).reshape(B, S, *out.shape[3:])


def diff_attn_branch(ctx_in, lat_in, qn_g, kn_g, lam_vec, subln_g, lam_init, cos, sin, need_ctx):
    def heads(q, k, v):
        B, S = q.shape[:2]
        q = rms_norm(q.reshape(B, S, DA_HEADS, 2, DA_DH), qn_g)
        k = rms_norm(k.reshape(B, S, DA_HEADS, 2, DA_DH), kn_g)
        return q, k, v.reshape(B, S, DA_HEADS, DA_DV)

    qc, kc, vc = heads(*ctx_in)
    ql, kl, vl = heads(*lat_in)
    ql = apply_axial_rope(ql, cos, sin)
    kl = apply_axial_rope(kl, cos, sin)
    lv = lam_vec.astype(jnp.float32)
    lam = jnp.exp(jnp.sum(lv[0] * lv[1])) - jnp.exp(jnp.sum(lv[2] * lv[3])) + lam_init
    k_all = jnp.concatenate([kc, kl], axis=1)
    v_all = jnp.concatenate([vc, vl], axis=1)

    def finish(o):
        B, S = o.shape[:2]
        return (rms_norm(o, subln_g) * (1.0 - lam_init)).reshape(B, S, BRANCH_W)

    y_l = finish(blocked_diff_attention(ql, k_all, v_all, lam))
    y_c = finish(diff_softmax_attend(qc, kc, vc, lam)) if need_ctx else None
    return y_l, y_c


def merge_branches(ys, gate_pre, w_branch, w_out):
    g = jax.nn.sigmoid(gate_pre.reshape(*gate_pre.shape[:-1], N_BRANCH, D_MODEL))
    y = g[..., 0, :] * (ys[0] @ w_branch[0])
    for j in range(1, N_BRANCH):
        y = y + g[..., j, :] * (ys[j] @ w_branch[j])
    return y @ w_out


def moe_ffn(h, w_router, b_router, w_e_gate, w_e_up, w_e_down, w_s_gate, w_s_up, w_s_down):
    shp = h.shape
    t = h.reshape(-1, D_MODEL)
    scores = jax.nn.sigmoid((t @ w_router).astype(jnp.float32))
    _, idx = lax.top_k(scores + b_router.astype(jnp.float32), TOP_K)
    sel = jnp.take_along_axis(scores, idx, axis=-1)
    wts = sel / jnp.sum(sel, axis=-1, keepdims=True) * ROUTED_SCALE
    rows = jnp.arange(t.shape[0])[:, None]
    combine = jnp.zeros((t.shape[0], N_EXPERTS), jnp.float32).at[rows, idx].set(wts).astype(t.dtype)
    out = (jax.nn.silu(t @ w_s_gate) * (t @ w_s_up)) @ w_s_down
    for g0 in range(0, N_EXPERTS, EXPERT_GROUP):
        sl = slice(g0, g0 + EXPERT_GROUP)
        hg = jnp.einsum('td,edf->tef', t, w_e_gate[sl])
        hu = jnp.einsum('td,edf->tef', t, w_e_up[sl])
        act = jax.nn.silu(hg) * hu * combine[:, sl, None]
        out = out + jnp.einsum('tef,efd->td', act, w_e_down[sl])
    return out.reshape(shp)


def trunk_layer(x, xc, c, c_ctx, p, layer_idx, cos, sin, need_ctx):
    lam_init = 0.8 - 0.6 * math.exp(-0.3 * layer_idx)
    m_l = [m[:, None, :] for m in ada_mods(c, p['w_ada'], p['b_ada'])]
    m_c = ada_mods(c_ctx, p['w_ada'], p['b_ada'])
    splits = proj_split_points()
    h_l = modulate(rms_norm(x, p['norm1_g']), m_l[0], m_l[1])
    h_c = modulate(rms_norm(xc, p['norm1_g']), m_c[0], m_c[1])
    P_l = jnp.split(h_l @ p['w_in'], splits, axis=-1)
    P_c = jnp.split(h_c @ p['w_in'], splits, axis=-1)
    yA = rglru_branch(P_c[0:2], P_l[0:2], p['conv_w'], p['conv_b'], p['lru_wa'], p['lru_ba'],
                      p['lru_wx'], p['lru_bx'], p['lru_lam'], need_ctx)
    yB = mlstm_branch(P_c[2:7], P_l[2:7], p['ml_gate_b'], p['ml_norm_g'], need_ctx)
    yC = diff_attn_branch(P_c[7:10], P_l[7:10], p['da_qnorm_g'], p['da_knorm_g'], p['da_lambda'],
                          p['da_subln_g'], lam_init, cos, sin, need_ctx)
    moe_w = (p['w_router'], p['b_router'], p['w_e_gate'], p['w_e_up'], p['w_e_down'],
             p['w_s_gate'], p['w_s_up'], p['w_s_down'])
    x = x + m_l[2] * merge_branches((yA[0], yB[0], yC[0]), P_l[10], p['w_branch'], p['w_out'])
    x = x + m_l[5] * moe_ffn(modulate(rms_norm(x, p['norm2_g']), m_l[3], m_l[4]), *moe_w)
    if need_ctx:
        xc = xc + m_c[2] * merge_branches((yA[1], yB[1], yC[1]), P_c[10], p['w_branch'], p['w_out'])
        xc = xc + m_c[5] * moe_ffn(modulate(rms_norm(xc, p['norm2_g']), m_c[3], m_c[4]), *moe_w)
    return x, xc


def setup_inputs(seed: int = 0) -> dict:
    key = jax.random.key(seed)
    keys = iter(jax.random.split(key, 40))
    L, D = DEPTH, D_MODEL

    def nrm(shape, scale):
        return jax.random.normal(next(keys), shape, jnp.float32) * scale

    u = jax.random.uniform(next(keys), (L, 2, LRU_WIDTH), jnp.float32, 0.9, 0.999)
    a0 = u ** (1.0 / LRU_C)
    ml_gate_b = nrm((L, 2, 2, ML_HEADS), 0.1)
    ml_gate_b = ml_gate_b.at[:, :, 1].add(jnp.linspace(3.0, 6.0, ML_HEADS))
    return {
        'x': nrm((BATCH, SEQ, D), 1.0),
        'c': nrm((BATCH, D), 1.0),
        'ctx': nrm((BATCH, CTX_LEN, D), 1.0),
        'c_ctx': nrm((D,), 1.0),
        'norm1_g': 1.0 + nrm((L, D), 0.02),
        'norm2_g': 1.0 + nrm((L, D), 0.02),
        'w_ada': nrm((L, D, N_MODS * D), 0.5 * D ** -0.5),
        'b_ada': nrm((L, N_MODS * D), 0.02),
        'w_in': nrm((L, D, PROJ_WIDTH), D ** -0.5),
        'conv_w': nrm((L, CONV_WIDTH, LRU_WIDTH), CONV_WIDTH ** -0.5),
        'conv_b': nrm((L, LRU_WIDTH), 0.02),
        'lru_wa': nrm((L, 2, LRU_BLOCKS, LRU_BLOCK, LRU_BLOCK), LRU_BLOCK ** -0.5),
        'lru_ba': nrm((L, 2, LRU_WIDTH), 0.02),
        'lru_wx': nrm((L, 2, LRU_BLOCKS, LRU_BLOCK, LRU_BLOCK), LRU_BLOCK ** -0.5),
        'lru_bx': nrm((L, 2, LRU_WIDTH), 0.02),
        'lru_lam': jnp.log(a0) - jnp.log1p(-a0),
        'ml_gate_b': ml_gate_b,
        'ml_norm_g': 1.0 + nrm((L, ML_HEADS, ML_DV), 0.02),
        'da_qnorm_g': 1.0 + nrm((L, DA_DH), 0.02),
        'da_knorm_g': 1.0 + nrm((L, DA_DH), 0.02),
        'da_lambda': nrm((L, 4, DA_DH), 0.1),
        'da_subln_g': 1.0 + nrm((L, DA_DV), 0.02),
        'w_branch': nrm((L, N_BRANCH, BRANCH_W, D), BRANCH_W ** -0.5),
        'w_out': nrm((L, D, D), D ** -0.5),
        'w_router': nrm((L, D, N_EXPERTS), D ** -0.5),
        'b_router': nrm((L, N_EXPERTS), 0.01),
        'w_e_gate': nrm((L, N_EXPERTS, D, EXPERT_FF), D ** -0.5),
        'w_e_up': nrm((L, N_EXPERTS, D, EXPERT_FF), D ** -0.5),
        'w_e_down': nrm((L, N_EXPERTS, EXPERT_FF, D), EXPERT_FF ** -0.5),
        'w_s_gate': nrm((L, D, SHARED_FF), D ** -0.5),
        'w_s_up': nrm((L, D, SHARED_FF), D ** -0.5),
        'w_s_down': nrm((L, SHARED_FF, D), SHARED_FF ** -0.5),
    }


def reference(x, c, ctx, c_ctx, norm1_g, norm2_g, w_ada, b_ada, w_in, conv_w, conv_b,
              lru_wa, lru_ba, lru_wx, lru_bx, lru_lam, ml_gate_b, ml_norm_g,
              da_qnorm_g, da_knorm_g, da_lambda, da_subln_g, w_branch, w_out,
              w_router, b_router, w_e_gate, w_e_up, w_e_down, w_s_gate, w_s_up, w_s_down):
    rows = x.shape[1] // GRID_W
    cos, sin = axial_rope_tables(rows)
    xc = ctx
    for i in range(DEPTH):
        p = dict(norm1_g=norm1_g[i], norm2_g=norm2_g[i], w_ada=w_ada[i], b_ada=b_ada[i],
                 w_in=w_in[i], conv_w=conv_w[i], conv_b=conv_b[i], lru_wa=lru_wa[i],
                 lru_ba=lru_ba[i], lru_wx=lru_wx[i], lru_bx=lru_bx[i], lru_lam=lru_lam[i],
                 ml_gate_b=ml_gate_b[i], ml_norm_g=ml_norm_g[i], da_qnorm_g=da_qnorm_g[i],
                 da_knorm_g=da_knorm_g[i], da_lambda=da_lambda[i], da_subln_g=da_subln_g[i],
                 w_branch=w_branch[i], w_out=w_out[i], w_router=w_router[i], b_router=b_router[i],
                 w_e_gate=w_e_gate[i], w_e_up=w_e_up[i], w_e_down=w_e_down[i],
                 w_s_gate=w_s_gate[i], w_s_up=w_s_up[i], w_s_down=w_s_down[i])
        x, xc = trunk_layer(x, xc, c, c_ctx, p, i, cos, sin, need_ctx=(i < DEPTH - 1))
    return x
```

```cpp
#include <hip/hip_runtime.h>
#include <stdint.h>
#include <string.h>
#include <stdio.h>
#include <hip/hip_cooperative_groups.h>

#define LAS __attribute__((address_space(3)))
typedef unsigned short bf16_t;
typedef short bf16x8 __attribute__((ext_vector_type(8)));
typedef short s16x4 __attribute__((ext_vector_type(4)));
typedef float f32x4 __attribute__((ext_vector_type(4)));
typedef __bf16 bf2_t __attribute__((ext_vector_type(2)));
typedef unsigned u32x4 __attribute__((ext_vector_type(4)));
typedef unsigned u32x2 __attribute__((ext_vector_type(2)));
typedef float f32x2 __attribute__((ext_vector_type(2)));
__host__ __device__ __forceinline__ u32x4 mk4(unsigned a, unsigned b, unsigned c, unsigned d) { u32x4 r = {a, b, c, d}; return r; }
__host__ __device__ __forceinline__ u32x2 mk2(unsigned a, unsigned b) { u32x2 r = {a, b}; return r; }

#ifndef MK_ONE_LAUNCH
#define MK_ONE_LAUNCH 1
#define PROBE 0
#ifndef MK_CG_SYNC
#define MK_CG_SYNC 0
#endif
#endif

constexpr int DM = 1024, NBATCH = 32, SEQ = 2048, CTXL = 256, SALL = 2304;
constexpr int TLAT = NBATCH * SEQ, TCTX = NBATCH * CTXL, TALL = TLAT + TCTX;
constexpr int PWID = 11264;
constexpr int BTIN_ROWS = 11520;
constexpr int NT_IN = 45;
constexpr int PC_XA = 0, PC_GA = 1024, PC_MQ = 2048, PC_MK = 2560, PC_MV = 3072, PC_MO = 4096, PC_DQ = 5120, PC_DK = 6144, PC_DV = 7168, PC_GATE = 8192;
constexpr int NEXP = 64, TOPK = 6;
#ifndef IN_F8_MASK_V
#define IN_F8_MASK_V 0x1FFFFFFFFF01ull
#endif
constexpr unsigned long long IN_F8_MASK = IN_F8_MASK_V, IN_BF_MASK = ~IN_F8_MASK & ((1ull << 45) - 1);
constexpr int IN_N8 = __builtin_popcountll(IN_F8_MASK), IN_NBF = 45 - IN_N8;
constexpr bool DOWN_F8 = true;
constexpr float ACT_SC = 4.0f, DW_SC = 128.0f;
constexpr bool MERGE_F8 = true;
constexpr float D_SCALE = 4.0f, D_ISCALE = 1.0f / 4.0f;
constexpr int LDS_BYTES = 147456;
constexpr int NTHREADS = 512;

struct Params {
    const float *x, *c, *ctx, *c_ctx, *norm1_g, *norm2_g, *w_ada, *b_ada, *w_in, *conv_w, *conv_b, *lru_wa, *lru_ba, *lru_wx, *lru_bx, *lru_lam,
        *ml_gate_b, *ml_norm_g, *da_qnorm_g, *da_knorm_g, *da_lambda, *da_subln_g, *w_branch, *w_out, *w_router, *b_router, *w_e_gate, *w_e_up,
        *w_e_down, *w_s_gate, *w_s_up, *w_s_down;
    float* out;
    unsigned* bar; int* ecnt; float* lamv; float* mods_l; float* mods_c; float* rope;
    bf16_t *bt_in, *bt_br, *bt_out, *bt_eup, *bt_edn, *bt_lru;
    bf16_t *H, *P, *YA, *YB, *HB, *YC; float* GATES; float* LSUM; float* XC1;
    bf16_t* H2; int* LIST; float* LISTW; bf16_t* ACT; bf16_t* DBUF; bf16_t* HB2; unsigned char* GP8; int* CC; int* PE; float* PW; int* POS; bf16_t* Z;
    int G; int ngroups;
    unsigned char* MO8;
    unsigned char* YB8;
    unsigned char* H8; unsigned char* bt_in8;
};

typedef const Params __attribute__((address_space(4))) * CP;
__device__ __forceinline__ int ltid() { int t = threadIdx.x; asm volatile("" : "+v"(t)); return t; }
__device__ __forceinline__ float bf2f(bf16_t b) { return __uint_as_float(((unsigned)b) << 16); }
__device__ __forceinline__ unsigned pk2(float lo, float hi) { bf2_t v = {(__bf16)lo, (__bf16)hi}; return __builtin_bit_cast(unsigned, v); }
__device__ __forceinline__ float lo_bf(unsigned u) { return __uint_as_float(u << 16); }
__device__ __forceinline__ float hi_bf(unsigned u) { return __uint_as_float(u & 0xffff0000u); }
__device__ __forceinline__ float sx_(float v, int mask) { return __builtin_bit_cast(float, __builtin_amdgcn_ds_bpermute(((ltid() & 63) ^ mask) << 2, __builtin_bit_cast(int, v))); }
__device__ __forceinline__ float sidx_(float v, int src) { return __builtin_bit_cast(float, __builtin_amdgcn_ds_bpermute(src << 2, __builtin_bit_cast(int, v))); }
__device__ __forceinline__ float sup_(float v, int o) { return __builtin_bit_cast(float, __builtin_amdgcn_ds_bpermute(((ltid() & 63) - o) << 2, __builtin_bit_cast(int, v))); }
template <int CTRL> __device__ __forceinline__ float dppf(float oldv, float v) { return __builtin_bit_cast(float, __builtin_amdgcn_update_dpp(__builtin_bit_cast(int, oldv), __builtin_bit_cast(int, v), CTRL, 0xf, 0xf, false)); }
__device__ __forceinline__ float wave_sum(float v) {
#pragma unroll
    for (int o = 32; o >= 1; o >>= 1) v += sx_(v, o);
    return v;
}
__device__ __forceinline__ float sigmoidf_(float x) { return __builtin_amdgcn_rcpf(1.0f + __expf(-x)); }
__device__ __forceinline__ float gelu_tanh(float x) {
    const float u = 0.7978845608028654f * (x + 0.044715f * x * x * x);
    const float e = __expf(2.0f * u);
    const float t = 1.0f - 2.0f * __builtin_amdgcn_rcpf(e + 1.0f);
    return 0.5f * x * (1.0f + t);
}

constexpr int GS_ROW = 144;
constexpr int GS_A = 128 * GS_ROW, GS_STAGE = 384 * GS_ROW;

template <class AF>
__device__ __forceinline__ void gemm_kloop(LAS unsigned char* lds, const AF& af, const bf16_t* __restrict__ Bt, int ldb, int K, f32x4 (&acc)[4][4]) {
    const int tid = ltid(), lane = tid & 63, wid = tid >> 6, wm = wid >> 2, wn = wid & 3;
    const int srow = tid >> 3, sch = tid & 7;
    const bf16_t* pa0 = af(srow) + sch * 8;
    const bf16_t* pa1 = af(srow + 64) + sch * 8;
    const bf16_t* pb0 = Bt + (size_t)(srow) * ldb + sch * 8;
    const bf16_t* pb1 = Bt + (size_t)(srow + 64) * ldb + sch * 8;
    const bf16_t* pb2 = Bt + (size_t)(srow + 128) * ldb + sch * 8;
    const bf16_t* pb3 = Bt + (size_t)(srow + 192) * ldb + sch * 8;
    const int wofs = srow * GS_ROW + sch * 16;
    const int nkt = K >> 6;
    u32x4 ra0 = *(const u32x4*)pa0, ra1 = *(const u32x4*)pa1, rb0 = *(const u32x4*)pb0, rb1 = *(const u32x4*)pb1, rb2 = *(const u32x4*)pb2, rb3 = *(const u32x4*)pb3;
    {
        LAS unsigned char* s = lds;
        *(LAS u32x4*)(s + wofs) = ra0; *(LAS u32x4*)(s + wofs + 64 * GS_ROW) = ra1;
        *(LAS u32x4*)(s + GS_A + wofs) = rb0; *(LAS u32x4*)(s + GS_A + wofs + 64 * GS_ROW) = rb1;
        *(LAS u32x4*)(s + GS_A + wofs + 128 * GS_ROW) = rb2; *(LAS u32x4*)(s + GS_A + wofs + 192 * GS_ROW) = rb3;
    }
    __syncthreads();
    const int aoff = (wm * 64 + (lane & 15)) * GS_ROW + (lane >> 4) * 16;
    const int boff = GS_A + (wn * 64 + (lane & 15)) * GS_ROW + (lane >> 4) * 16;
    for (int kt = 0; kt < nkt; ++kt) {
        LAS unsigned char* cur = lds + (kt & 1) * GS_STAGE;
        LAS unsigned char* nxt = lds + ((kt + 1) & 1) * GS_STAGE;
        const bool more = (kt + 1 < nkt);
        if (more) {
            const int ko = (kt + 1) * 64;
            ra0 = *(const u32x4*)(pa0 + ko); ra1 = *(const u32x4*)(pa1 + ko);
            rb0 = *(const u32x4*)(pb0 + ko); rb1 = *(const u32x4*)(pb1 + ko); rb2 = *(const u32x4*)(pb2 + ko); rb3 = *(const u32x4*)(pb3 + ko);
        }
#pragma unroll
        for (int ks = 0; ks < 2; ++ks) {
            bf16x8 a[4], b[4];
#pragma unroll
            for (int m = 0; m < 4; ++m) a[m] = *(LAS bf16x8*)(cur + aoff + m * 16 * GS_ROW + ks * 64);
#pragma unroll
            for (int n = 0; n < 4; ++n) b[n] = *(LAS bf16x8*)(cur + boff + n * 16 * GS_ROW + ks * 64);
#pragma unroll
            for (int m = 0; m < 4; ++m)
#pragma unroll
                for (int n = 0; n < 4; ++n) acc[m][n] = __builtin_amdgcn_mfma_f32_16x16x32_bf16(b[n], a[m], acc[m][n], 0, 0, 0);
        }
        if (more) {
            *(LAS u32x4*)(nxt + wofs) = ra0; *(LAS u32x4*)(nxt + wofs + 64 * GS_ROW) = ra1;
            *(LAS u32x4*)(nxt + GS_A + wofs) = rb0; *(LAS u32x4*)(nxt + GS_A + wofs + 64 * GS_ROW) = rb1;
            *(LAS u32x4*)(nxt + GS_A + wofs + 128 * GS_ROW) = rb2; *(LAS u32x4*)(nxt + GS_A + wofs + 192 * GS_ROW) = rb3;
        }
        __syncthreads();
    }
}
__device__ __forceinline__ void acc_zero(f32x4 (&acc)[4][4]) {
#pragma unroll
    for (int m = 0; m < 4; ++m)
#pragma unroll
        for (int n = 0; n < 4; ++n) acc[m][n] = (f32x4){0.f, 0.f, 0.f, 0.f};
}
struct ARowLinear { const bf16_t* base; int ld; __device__ __forceinline__ const bf16_t* operator()(int r) const { return base + (size_t)r * ld; } };

__device__ __forceinline__ bool dense_unit(int it, int bid, int nb, int MT, int NT, int& mt, int& nt) {
    if (nb == 256) {
        const int xcd = bid & 7, loc = bid >> 3, nmacN = (NT + 3) >> 2, nmacM = (MT + 7) >> 3;
        const int q = it * 8 + xcd;
        if (q >= nmacM * nmacN) { mt = -1; return false; }
        const int mm = q / nmacN, nn = q - mm * nmacN;
        mt = mm * 8 + (loc & 7); nt = nn * 4 + (loc >> 3);
        if (mt >= MT || nt >= NT) mt = -1;
        return true;
    }
    const int u = it * nb + bid;
    if (u >= MT * NT) { mt = -1; return false; }
    mt = u / NT; nt = u - mt * NT; return true;
}

namespace pg8 {
typedef unsigned short bf16_t;
constexpr float F8_WMUL = 64.0f, F8_WINV = 1.0f / 64.0f;
constexpr int BM = 256, BK = 64, HALF = 128, HTB = HALF * BK * 2, STAGE_BYTES = 8 * HTB, NXCD = 8, WGM = 8;
__host__ __device__ __forceinline__ int lds_byte(int r, int c) { const int st = (r >> 4) * 2 + (c >> 5), rr = r & 15, cc = c & 31, ob = rr * 64 + cc * 2; return st * 1024 + (ob ^ (((ob >> 9) & 1) << 5)); }
__host__ __device__ __forceinline__ void stage_rc(int b, int& R, int& C) { const int st = b / 1024, sb = b % 1024, swz = sb ^ (((sb >> 9) & 1) << 5); R = (st >> 1) * 16 + swz / 64; C = (st & 1) * 32 + (swz % 64) / 2; }
__host__ __device__ __forceinline__ int perm32(int rho) { const int n = rho >> 4, i = rho & 15; return 8 * (i >> 2) + 4 * n + (i & 3); }
struct Unit { const char* a; const char* b; const int* rows; int pm, pn, tag; };
__device__ __forceinline__ bool static_tile(int i, int G, int c, int nM, int nN, int& pm, int& pn) {
    const int nwg = nM * nN; const long L = (long)i * G + c; if (L >= nwg) return false;
    int wgid = (int)L; { const int q = nwg / NXCD, r = nwg % NXCD, xcd = wgid % NXCD, off = wgid / NXCD; wgid = (xcd < r ? xcd * (q + 1) : r * (q + 1) + (xcd - r) * q) + off; }
    const int nig = WGM * nN, gid = wgid / nig, fm = gid * WGM, gsz = (nM - fm) < WGM ? (nM - fm) : WGM;
    pm = fm + ((wgid % nig) % gsz); pn = (wgid % nig) / gsz; return true;
}
typedef int i32x8 __attribute__((ext_vector_type(8)));
typedef int i32x4 __attribute__((ext_vector_type(4)));
template <bool GATHER, bool F8, class Epi, class Sched>
__device__ __forceinline__ void gemm_phase(LAS unsigned char* lds, const int K, const Sched& S, const Epi& E) {
    const int tid = ltid(), wid = __builtin_amdgcn_readfirstlane(tid >> 6), lane = tid & 63, wr = wid >> 2, wc = wid & 3, fr = lane & 15, fq = lane >> 4;
    const int nt = K / BK;
    unsigned voffA[2], voffB[2];
#pragma unroll
    for (int i = 0; i < 2; ++i) { int R, C; stage_rc(tid * 16 + i * 8192, R, C); const int Rb = Epi::PERM ? ((R & ~31) + perm32(R & 31)) : R;
        voffA[i] = (unsigned)(R * K + C) * 2u; voffB[i] = (unsigned)(Rb * K + C) * 2u; }
    (void)voffA;
    const size_t kstep = (size_t)(BK * 2);
    const size_t hstep = (size_t)HALF * K * 2;
    const unsigned ldsw = (unsigned)wid * 1024u;
    const int aoff = lds_byte(wr * 64 + fr, fq * 8), boff = lds_byte(wc * 32 + fr, fq * 8);
#define PG8_SA(b, h) (((b) * 2 + (h)) * HTB)
#define PG8_SB(b, h) ((4 + (b) * 2 + (h)) * HTB)
#define PG8_STAGE(bufoff, gbase, voff) do { _Pragma("unroll") for (int _i = 0; _i < 2; ++_i) { unsigned vo_ = (voff)[_i]; asm volatile("" : "+v"(vo_));     \
        __builtin_amdgcn_global_load_lds((const unsigned*)((const char*)(gbase) + vo_), (LAS unsigned*)(lds + (bufoff) + ldsw + _i * 8192), 16, 0, 0); } } while (0)
#define PG8_LDA(dst, b, h) do { if constexpr (F8) { _Pragma("unroll") for (int m = 0; m < 4; ++m) { dst##8[m].lo = *(const LAS i32x4*)(lds + PG8_SA(b, h) + aoff + m * 2048); dst##8[m].hi = *(const LAS i32x4*)(lds + PG8_SA(b, h) + aoff + m * 2048 + 1024); } } \
        else { _Pragma("unroll") for (int m = 0; m < 4; ++m) _Pragma("unroll") for (int k = 0; k < 2; ++k) dst[m][k] = *(const LAS bf16x8*)(lds + PG8_SA(b, h) + aoff + m * 2048 + k * 1024); } } while (0)
#define PG8_LDB(dst, b, h) do { if constexpr (F8) { _Pragma("unroll") for (int n = 0; n < 2; ++n) { dst##8[n].lo = *(const LAS i32x4*)(lds + PG8_SB(b, h) + boff + n * 2048); dst##8[n].hi = *(const LAS i32x4*)(lds + PG8_SB(b, h) + boff + n * 2048 + 1024); } } \
        else { _Pragma("unroll") for (int n = 0; n < 2; ++n) _Pragma("unroll") for (int k = 0; k < 2; ++k) dst[n][k] = *(const LAS bf16x8*)(lds + PG8_SB(b, h) + boff + n * 2048 + k * 1024); } } while (0)
#define PG8_MMA(ai, bj, At, Bt) do { __builtin_amdgcn_s_setprio(1); _Pragma("unroll") for (int m = 0; m < 4; ++m) _Pragma("unroll") for (int n = 0; n < 2; ++n) { \
        if constexpr (F8) acc[ai][bj][m][n] = __builtin_amdgcn_mfma_scale_f32_16x16x128_f8f6f4(Bt##8[n], At##8[m], acc[ai][bj][m][n], 0, 0, 0, 0, 0, 0); \
        else { _Pragma("unroll") for (int k = 0; k < 2; ++k) acc[ai][bj][m][n] = __builtin_amdgcn_mfma_f32_16x16x32_bf16(Bt[n][k], At[m][k], acc[ai][bj][m][n], 0, 0, 0); } } \
        __builtin_amdgcn_s_setprio(0); } while (0)
#define PG8_WAIT_V(n) asm volatile("s_waitcnt vmcnt(" #n ")" ::: "memory")
#define PG8_WAIT_L(n) asm volatile("s_waitcnt lgkmcnt(" #n ")" ::: "memory")
#define PG8_BAR __builtin_amdgcn_s_barrier()
#define PG8_SCHED __builtin_amdgcn_sched_barrier(0)
    Unit cur, nxt; int ui = 0;
    if (!S.next(0, cur)) return;
    f32x4 acc[2][2][4][2];
#pragma unroll
    for (int a = 0; a < 2; ++a)
#pragma unroll
        for (int b = 0; b < 2; ++b)
#pragma unroll
            for (int m = 0; m < 4; ++m)
#pragma unroll
                for (int n = 0; n < 2; ++n) acc[a][b][m][n] = (f32x4){0.f, 0.f, 0.f, 0.f};
    bf16x8 At[4][2], B0[2][2], B1[2][2];
    i32x8 At8[4], B08[2], B18[2];
    (void)At; (void)B0; (void)B1; (void)At8; (void)B08; (void)B18;
    const char* cA = cur.a; const char* cB = cur.b;
    unsigned ca0[2], ca1[2], na0[2], na1[2];
#define PG8_AOFFS(u, o0, o1) do { _Pragma("unroll") for (int _i = 0; _i < 2; ++_i) { \
        if constexpr (GATHER) { int R_, C_; stage_rc(ltid() * 16 + _i * 8192, R_, C_); const int* rw_ = (u).rows + R_; \
            o0[_i] = (unsigned)rw_[0] * (unsigned)(K * 2) + (unsigned)C_ * 2u; o1[_i] = (unsigned)rw_[128] * (unsigned)(K * 2) + (unsigned)C_ * 2u; } \
        else { o0[_i] = voffA[_i]; o1[_i] = voffA[_i] + (unsigned)hstep; } } } while (0)
    PG8_AOFFS(cur, ca0, ca1);
#pragma unroll
    for (int i = 0; i < 2; ++i) { na0[i] = ca0[i]; na1[i] = ca1[i]; }
    (void)na0; (void)na1;
    PG8_STAGE(PG8_SB(0, 0), cB, voffB); PG8_STAGE(PG8_SA(0, 0), cA, ca0); PG8_STAGE(PG8_SB(0, 1), cB + hstep, voffB); PG8_STAGE(PG8_SA(0, 1), cA, ca1);
    if (wr == 1) PG8_BAR;
    PG8_WAIT_V(4); PG8_BAR;
    PG8_STAGE(PG8_SB(1, 0), cB + kstep, voffB); PG8_STAGE(PG8_SA(1, 0), cA + kstep, ca0); PG8_STAGE(PG8_SB(1, 1), cB + hstep + kstep, voffB);
    PG8_WAIT_V(6); PG8_BAR;
    for (;;) {
        const bool has_next = S.next(ui + 1, nxt);
        const char* nA = has_next ? nxt.a : cA; const char* nB = has_next ? nxt.b : cB;
        if constexpr (!GATHER) { if (has_next) PG8_AOFFS(nxt, na0, na1); }
#pragma nounroll
        for (int t = 0; t < nt; t += 2) {
            const bool last = (t == nt - 2);
            const char* a1 = cA + (size_t)(t + 1) * kstep;
            const char* a2 = last ? nA : cA + (size_t)(t + 2) * kstep; const char* b2 = last ? nB : cB + (size_t)(t + 2) * kstep;
            const char* a3 = a2 + kstep; const char* b3 = b2 + kstep;
            unsigned xa0[2] = {ca0[0], ca0[1]}, xa1[2] = {ca1[0], ca1[1]};
            if (last) {
                if constexpr (GATHER) { if (has_next) PG8_AOFFS(nxt, xa0, xa1); }
                else { xa0[0] = na0[0]; xa0[1] = na0[1]; xa1[0] = na1[0]; xa1[1] = na1[1]; }
            }
            PG8_LDB(B0, 0, 0); PG8_SCHED; PG8_LDA(At, 0, 0); PG8_STAGE(PG8_SA(1, 1), a1, ca1);
            PG8_WAIT_L(8); PG8_BAR; PG8_WAIT_L(0); PG8_MMA(0, 0, At, B0); PG8_BAR; PG8_SCHED;
            PG8_LDB(B1, 0, 1); PG8_STAGE(PG8_SB(0, 0), b2, voffB);
            PG8_BAR; PG8_WAIT_L(0); PG8_MMA(0, 1, At, B1); PG8_BAR;
            PG8_LDA(At, 0, 1); PG8_STAGE(PG8_SA(0, 0), a2, xa0);
            PG8_BAR; PG8_WAIT_L(0); PG8_MMA(1, 0, At, B0); PG8_BAR; PG8_SCHED;
            PG8_STAGE(PG8_SB(0, 1), b2 + hstep, voffB);
            PG8_WAIT_V(6); PG8_BAR; PG8_MMA(1, 1, At, B1); PG8_BAR;
            PG8_LDB(B0, 1, 0); PG8_SCHED; PG8_LDA(At, 1, 0); PG8_STAGE(PG8_SA(0, 1), a2, xa1);
            PG8_WAIT_L(8); PG8_BAR; PG8_WAIT_L(0); PG8_MMA(0, 0, At, B0); PG8_BAR; PG8_SCHED;
            PG8_LDB(B1, 1, 1); PG8_STAGE(PG8_SB(1, 0), b3, voffB);
            PG8_BAR; PG8_WAIT_L(0); PG8_MMA(0, 1, At, B1); PG8_BAR;
            PG8_LDA(At, 1, 1); PG8_STAGE(PG8_SA(1, 0), a3, xa0);
            PG8_BAR; PG8_WAIT_L(0); PG8_MMA(1, 0, At, B0); PG8_BAR; PG8_SCHED;
            PG8_STAGE(PG8_SB(1, 1), b3 + hstep, voffB);
            PG8_WAIT_V(6); PG8_BAR; PG8_MMA(1, 1, At, B1); PG8_BAR;
        }
        { const int le = ltid() & 63; E(acc, cur, wr, wc, le & 15, le >> 4); }
        if (!has_next) break;
#pragma unroll
        for (int a = 0; a < 2; ++a)
#pragma unroll
            for (int b = 0; b < 2; ++b)
#pragma unroll
                for (int m = 0; m < 4; ++m)
#pragma unroll
                    for (int n = 0; n < 2; ++n) acc[a][b][m][n] = (f32x4){0.f, 0.f, 0.f, 0.f};
        cur = nxt; cA = nA; cB = nB; ++ui;
        if constexpr (GATHER) PG8_AOFFS(cur, ca0, ca1);
        else {
#pragma unroll
            for (int i = 0; i < 2; ++i) { ca0[i] = na0[i]; ca1[i] = na1[i]; }
        }
    }
    PG8_WAIT_V(0);
    if (wr == 0) PG8_BAR;
    PG8_BAR;
#undef PG8_AOFFS
#undef PG8_SA
#undef PG8_SB
#undef PG8_STAGE
#undef PG8_LDA
#undef PG8_LDB
#undef PG8_MMA
#undef PG8_WAIT_V
#undef PG8_WAIT_L
#undef PG8_BAR
#undef PG8_SCHED
}
}

template <bool F8>
struct SchedInproj { const char* A; const char* B; int nM, G, c;
    __device__ __forceinline__ bool next(int i, pg8::Unit& u) const { int pm, j; if (!pg8::static_tile(i, G, c, nM, F8 ? IN_N8 : IN_NBF, pm, j)) return false;
        unsigned long long m = F8 ? IN_F8_MASK : IN_BF_MASK; for (int q = 0; q < j; ++q) m &= m - 1;
        const int pn = __builtin_ctzll(m);
        u.pm = pm; u.pn = pn; u.tag = 0; u.rows = nullptr; u.a = A + (size_t)pm * 256 * 1024 * (F8 ? 1 : 2); u.b = B + (size_t)pn * 256 * 1024 * (F8 ? 1 : 2); return true; } };
template <bool F8>
struct EpiInproj { static constexpr bool PERM = true; bf16_t* P; float* GATES; unsigned char* GP8; unsigned char* MO8;
    __device__ __forceinline__ void operator()(const f32x4 (&acc)[2][2][4][2], const pg8::Unit& u, int wr, int wc, int fr, int fq) const {
        const size_t row0 = (size_t)u.pm * 256 + wr * 64 + fr;
        constexpr float ASC = F8 ? pg8::F8_WINV : 1.0f;
        if (u.pn >= 16 && u.pn < 20) {
#pragma unroll
            for (int ai = 0; ai < 2; ++ai)
#pragma unroll
                for (int m = 0; m < 4; ++m) { unsigned char* rowp = MO8 + (row0 + ai * 128 + m * 16) * 1024 + (u.pn - 16) * 256 + wc * 32 + 8 * fq;
#pragma unroll
                    for (int bj = 0; bj < 2; ++bj) { const f32x4 v0 = acc[ai][bj][m][0] * ASC, v1 = acc[ai][bj][m][1] * ASC;
                        int w0 = 0, w1 = 0;
                        w0 = __builtin_amdgcn_cvt_pk_fp8_f32(v0[0], v0[1], w0, false); w0 = __builtin_amdgcn_cvt_pk_fp8_f32(v0[2], v0[3], w0, true);
                        w1 = __builtin_amdgcn_cvt_pk_fp8_f32(v1[0], v1[1], w1, false); w1 = __builtin_amdgcn_cvt_pk_fp8_f32(v1[2], v1[3], w1, true);
                        *(u32x2*)(rowp + bj * 128) = mk2((unsigned)w0, (unsigned)w1); } }
        } else if (u.pn < 32) {
#pragma unroll
            for (int ai = 0; ai < 2; ++ai)
#pragma unroll
                for (int m = 0; m < 4; ++m) { bf16_t* rowp = P + (row0 + ai * 128 + m * 16) * PWID + u.pn * 256 + wc * 32 + 8 * fq;
#pragma unroll
                    for (int bj = 0; bj < 2; ++bj) { const f32x4 v0 = acc[ai][bj][m][0] * ASC, v1 = acc[ai][bj][m][1] * ASC;
                        *(u32x4*)(rowp + bj * 128) = mk4(pk2(v0[0], v0[1]), pk2(v0[2], v0[3]), pk2(v1[0], v1[1]), pk2(v1[2], v1[3])); } }
        } else if (u.pn < 44) {
#pragma unroll
            for (int ai = 0; ai < 2; ++ai)
#pragma unroll
                for (int m = 0; m < 4; ++m) { unsigned char* rowp = GP8 + (row0 + ai * 128 + m * 16) * 3072 + (u.pn - 32) * 256 + wc * 32 + 8 * fq;
#pragma unroll
                    for (int bj = 0; bj < 2; ++bj) { const f32x4 v0 = acc[ai][bj][m][0] * ASC, v1 = acc[ai][bj][m][1] * ASC;
                        int w0 = 0, w1 = 0;
                        w0 = __builtin_amdgcn_cvt_pk_fp8_f32(v0[0], v0[1], w0, false); w0 = __builtin_amdgcn_cvt_pk_fp8_f32(v0[2], v0[3], w0, true);
                        w1 = __builtin_amdgcn_cvt_pk_fp8_f32(v1[0], v1[1], w1, false); w1 = __builtin_amdgcn_cvt_pk_fp8_f32(v1[2], v1[3], w1, true);
                        *(u32x2*)(rowp + bj * 128) = mk2((unsigned)w0, (unsigned)w1); } }
        } else if (wc == 0 && fq < 2) {
#pragma unroll
            for (int ai = 0; ai < 2; ++ai)
#pragma unroll
                for (int m = 0; m < 4; ++m) { float* g = GATES + (row0 + ai * 128 + m * 16) * 16 + 8 * fq; *(f32x4*)g = acc[ai][0][m][0] * ASC; *(f32x4*)(g + 4) = acc[ai][0][m][1] * ASC; }
        }
    } };
__device__ __forceinline__ void phase_inproj8(CP p, LAS unsigned char* lds, int bid, int nb) {
    if constexpr (IN_N8 > 0) {
        SchedInproj<true> S{(const char*)p->H8, (const char*)p->bt_in8, p->G * SALL / 256, nb, bid};
        EpiInproj<true> E{p->P, p->GATES, p->GP8, p->MO8};
        pg8::gemm_phase<false, true>(lds, 512, S, E);
    }
    if constexpr (IN_NBF > 0) {
        SchedInproj<false> S{(const char*)p->H, (const char*)p->bt_in, p->G * SALL / 256, nb, nb - 1 - bid};
        EpiInproj<false> E{p->P, p->GATES, p->GP8, p->MO8};
        pg8::gemm_phase<false, false>(lds, 1024, S, E);
    }
}

struct CvtItem { const float* src; int sld; bf16_t* dst; int dld; int zero; float scale; int f8; };
__device__ __forceinline__ CvtItem cvt_decode(CP p, int L, int item) {
    CvtItem c; c.zero = 0; c.scale = 1.0f; c.f8 = 0;
    if (item < 11520) {
        const int g = item >> 4, kb = item & 15; int sc = 0;
        if (g < 320) sc = 16 * g; else if (g < 704) sc = 16 * g + 16; else if (g == 704) sc = 5120; else c.zero = 1;
        c.src = p->w_in + (size_t)L * 1024 * 11280 + (size_t)kb * 64 * 11280 + sc; c.sld = 11280;
        if ((IN_F8_MASK >> (g >> 4)) & 1) { c.dst = (bf16_t*)(p->bt_in8 + (size_t)g * 16 * 1024 + kb * 64); c.dld = 1024; c.f8 = 1; c.scale = pg8::F8_WMUL; return c; }
        c.dst = p->bt_in + (size_t)g * 16 * 1024 + kb * 64; c.dld = 1024; return c;
    }
    item -= 11520;
    if (item < 3072) {
        const int j = item >> 10, r = item & 1023, g = r >> 4, kb = r & 15;
        c.src = p->w_branch + ((size_t)(L * 3 + j) * 1024 + kb * 64) * 1024 + g * 16; c.sld = 1024;
        if (MERGE_F8 && j > 0) { c.dst = (bf16_t*)((unsigned char*)p->bt_br + (size_t)j * 1024 * 1024 * 2 + (size_t)g * 16 * 1024 + kb * 64); c.dld = 1024; c.f8 = 1; c.scale = pg8::F8_WMUL; return c; }
        c.dst = p->bt_br + ((size_t)j * 1024 + g * 16) * 1024 + kb * 64; c.dld = 1024; return c;
    }
    item -= 3072;
    if (item < 1024) {
        const int g = item >> 4, kb = item & 15;
        c.src = p->w_out + ((size_t)L * 1024 + kb * 64) * 1024 + g * 16; c.sld = 1024;
        c.dst = p->bt_out + (size_t)g * 16 * 1024 + kb * 64; c.dld = 1024; return c;
    }
    item -= 1024;
    if (item < 33280) {
        const int e = item >> 9, r = item & 511, g = r >> 4, kb = r & 15;
        const int nt = g >> 4, n = ((g >> 3) & 1) * 2, f = nt * 128 + (g & 7) * 16;
        const float* base = (e < 64) ? ((n < 2 ? p->w_e_gate : p->w_e_up) + ((size_t)(L * 64 + e)) * 1024 * 256) : ((n < 2 ? p->w_s_gate : p->w_s_up) + (size_t)L * 1024 * 256);
        c.src = base + (size_t)kb * 64 * 256 + f; c.sld = 256;
        c.dst = (bf16_t*)((unsigned char*)p->bt_eup + ((size_t)e * 512 + g * 16) * 1024 + kb * 64); c.dld = 1024; c.f8 = 1; c.scale = 64.0f; return c;
    }
    item -= 33280;
    if (item < 16640) {
        const int e = item >> 8, r = item & 255, g = r >> 2, kb = r & 3;
        const float* base = (e < 64) ? (p->w_e_down + ((size_t)(L * 64 + e)) * 256 * 1024) : (p->w_s_down + (size_t)L * 256 * 1024);
        c.src = base + (size_t)kb * 64 * 1024 + g * 16; c.sld = 1024;
        if (DOWN_F8) { c.dst = (bf16_t*)((unsigned char*)p->bt_edn + ((size_t)e * 1024 + g * 16) * 256 + kb * 64); c.dld = 256; c.f8 = 1; c.scale = DW_SC; return c; }
        c.dst = p->bt_edn + ((size_t)e * 1024 + g * 16) * 256 + kb * 64; c.dld = 256; c.scale = D_SCALE; return c;
    }
    item -= 16640;
    {
        const int dh = item >> 5, r = item & 31, g = r >> 1, kb = r & 1;
        const int cq = g >> 2, n = g & 3, ch = cq * 32 + (n & 1) * 16;
        const float* base = (n < 2 ? p->lru_wa : p->lru_wx) + ((size_t)(L * 16 + dh)) * 128 * 128;
        c.src = base + (size_t)kb * 64 * 128 + ch; c.sld = 128;
        c.dst = p->bt_lru + ((size_t)dh * 256 + g * 16) * 128 + kb * 64; c.dld = 128; return c;
    }
}
constexpr int CVT_ITEMS = 11520 + 3072 + 1024 + 33280 + 16640 + 512;
__device__ __forceinline__ void phase_convert(CP p, int L, LAS unsigned char* lds, int bid, int nb) {
    const int tid = ltid(), sub = tid >> 7, t = tid & 127;
    for (int it = bid; it * 8 < CVT_ITEMS; it += nb) {
        CvtItem c[2]; bool valid[2];
        float4 v0[2], v1[2];
        const int kk = t >> 1, half = t & 1;
#pragma unroll
        for (int q = 0; q < 2; ++q) {
            const int item = it * 8 + sub * 2 + q;
            valid[q] = item < CVT_ITEMS;
            c[q].src = nullptr; c[q].dst = nullptr; c[q].sld = 0; c[q].dld = 0; c[q].zero = 1; c[q].scale = 1.0f; c[q].f8 = 0;
            if (valid[q]) c[q] = cvt_decode(p, L, item);
            v0[q] = make_float4(0.f, 0.f, 0.f, 0.f); v1[q] = v0[q];
            if (valid[q] && !c[q].zero) { const float* s2 = c[q].src + (size_t)kk * c[q].sld + half * 8; v0[q] = *(const float4*)s2; v1[q] = *(const float4*)(s2 + 4); }
        }
#pragma unroll
        for (int q = 0; q < 2; ++q) {
            LAS bf16_t* tile = (LAS bf16_t*)(lds + (sub * 2 + q) * (16 * 66 * 2));
            const float vv[8] = {v0[q].x, v0[q].y, v0[q].z, v0[q].w, v1[q].x, v1[q].y, v1[q].z, v1[q].w};
#pragma unroll
            for (int i = 0; i < 8; ++i) tile[(half * 8 + i) * 66 + kk] = (bf16_t)(pk2(vv[i] * c[q].scale, 0.f) & 0xffffu);
        }
        __syncthreads();
#pragma unroll
        for (int q = 0; q < 2; ++q) {
            if (valid[q]) {
                LAS bf16_t* tile = (LAS bf16_t*)(lds + (sub * 2 + q) * (16 * 66 * 2));
                const int i = t >> 3, seg = t & 7;
                unsigned w[4];
#pragma unroll
                for (int x = 0; x < 4; ++x) w[x] = (unsigned)tile[i * 66 + seg * 8 + 2 * x] | ((unsigned)tile[i * 66 + seg * 8 + 2 * x + 1] << 16);
                if (c[q].f8) { int f0 = 0, f1 = 0;
                    f0 = __builtin_amdgcn_cvt_pk_fp8_f32(lo_bf(w[0]), hi_bf(w[0]), f0, false); f0 = __builtin_amdgcn_cvt_pk_fp8_f32(lo_bf(w[1]), hi_bf(w[1]), f0, true);
                    f1 = __builtin_amdgcn_cvt_pk_fp8_f32(lo_bf(w[2]), hi_bf(w[2]), f1, false); f1 = __builtin_amdgcn_cvt_pk_fp8_f32(lo_bf(w[3]), hi_bf(w[3]), f1, true);
                    *(u32x2*)((unsigned char*)c[q].dst + (size_t)i * c[q].dld + seg * 8) = mk2((unsigned)f0, (unsigned)f1); }
                else *(u32x4*)(c[q].dst + (size_t)i * c[q].dld + seg * 8) = mk4(w[0], w[1], w[2], w[3]);
            }
        }
        __syncthreads();
    }
}

__device__ __forceinline__ void phase_mods(CP p, LAS unsigned char* lds, int bid, int nb) {
    const int tid = ltid();
    LAS float* sl = (LAS float*)lds;
    const int tcol = tid & 63, kp = tid >> 6;
    for (int item = bid; item < 192; item += nb) {
        const int L = item / 96, n0 = (item % 96) * 64;
        __syncthreads();
#pragma unroll 1
        for (int q0 = 0; q0 < 66; q0 += 22) {
            float cvv[22];
#pragma unroll
            for (int q = 0; q < 22; ++q) { const int e = tid + (q0 + q) * NTHREADS; cvv[q] = (q0 + q < 64) ? p->c[e] : p->c_ctx[e - 32768]; }
#pragma unroll
            for (int q = 0; q < 22; ++q) { const int e = tid + (q0 + q) * NTHREADS; sl[(e & 1023) * 33 + (e >> 10)] = cvv[q] * __builtin_amdgcn_rcpf(1.0f + __expf(-cvv[q])); }
        }
        __syncthreads();
        float acc[33];
#pragma unroll
        for (int r = 0; r < 33; ++r) acc[r] = 0.f;
        const float* w = p->w_ada + ((size_t)L * 1024 + kp * 128) * 6144 + n0 + tcol;
        for (int k0 = 0; k0 < 128; k0 += 16) {
            float wv[16];
#pragma unroll
            for (int k = 0; k < 16; ++k) wv[k] = w[(size_t)(k0 + k) * 6144];
            LAS float* sk = sl + (kp * 128 + k0) * 33;
#pragma unroll
            for (int k = 0; k < 16; ++k)
#pragma unroll
                for (int r = 0; r < 33; ++r) acc[r] += sk[k * 33 + r] * wv[k];
        }
        __syncthreads();
#pragma unroll
        for (int r = 0; r < 33; ++r) sl[(kp * 33 + r) * 64 + tcol] = acc[r];
        __syncthreads();
        const float bv = p->b_ada[L * 6144 + n0 + tcol];
        for (int r = kp; r < 33; r += 8) {
            float sum = 0.f;
#pragma unroll
            for (int q = 0; q < 8; ++q) sum += sl[(q * 33 + r) * 64 + tcol];
            if (r < 32) p->mods_l[((size_t)L * 32 + r) * 6144 + n0 + tcol] = sum + bv;
            else p->mods_c[(size_t)L * 6144 + n0 + tcol] = sum + bv;
        }
    }
    for (int e = bid * NTHREADS + tid; e < 2048 * 32; e += nb * NTHREADS) {
        const int s = e >> 5, a = (e >> 4) & 1, f = e & 15;
        const float pos = (float)(a == 0 ? (s >> 6) : (s & 63));
        const float fr = powf(10000.0f, -(float)f / 16.0f);
        float sn, cs; sincosf(pos * fr, &sn, &cs);
        p->rope[2 * e] = cs; p->rope[2 * e + 1] = sn;
    }
    if (bid == 0 && tid < 128) {
        const int L = tid >> 6, lane = tid & 63;
        const float* lv = p->da_lambda + L * 256;
        const float a = wave_sum(lv[lane] * lv[64 + lane]), b = wave_sum(lv[128 + lane] * lv[192 + lane]);
        const float lam_init = 0.8f - 0.6f * expf(-0.3f * (float)L);
        if (lane == 0) p->lamv[L] = expf(a) - expf(b) + lam_init;
        float gq = fabsf(p->da_qnorm_g[L * 64 + lane]), gk = fabsf(p->da_knorm_g[L * 64 + lane]);
#pragma unroll
        for (int o = 32; o >= 1; o >>= 1) { gq = fmaxf(gq, sx_(gq, o)); gk = fmaxf(gk, sx_(gk, o)); }
        if (lane == 0) p->lamv[2 + L] = 64.0f * gq * gk * 0.125f * 1.4426950408889634f * 1.001f + 0.01f;
    }
}

__device__ __forceinline__ void phase_prenorm(CP p, int L, int grp, int bid, int nb) {
    const int lane = ltid() & 63, wid = ltid() >> 6;
    const int RG = p->G * SALL;
    const float* g1 = p->norm1_g + L * 1024;
    for (int r = bid * 8 + wid; r < RG; r += nb * 8) {
        const int bl = r / SALL, pos = r - bl * SALL, b = grp * p->G + bl;
        const float* src; const float* md;
        if (pos < CTXL) { src = (L == 0 ? p->ctx : p->XC1) + ((size_t)b * CTXL + pos) * 1024; md = p->mods_c + (size_t)L * 6144; }
        else { src = (L == 0 ? p->x : p->out) + ((size_t)b * SEQ + (pos - CTXL)) * 1024; md = p->mods_l + ((size_t)L * 32 + b) * 6144; }
        float4 v[4]; float ss = 0.f;
#pragma unroll
        for (int i = 0; i < 4; ++i) { v[i] = *(const float4*)(src + i * 256 + lane * 4); ss += v[i].x * v[i].x + v[i].y * v[i].y + v[i].z * v[i].z + v[i].w * v[i].w; }
        ss = wave_sum(ss);
        const float rstd = rsqrtf(ss * (1.0f / 1024.0f) + 1e-6f);
#pragma unroll
        for (int i = 0; i < 4; ++i) {
            const int col = i * 256 + lane * 4;
            const float4 g = *(const float4*)(g1 + col), sh = *(const float4*)(md + col), sc = *(const float4*)(md + 1024 + col);
            const float o0 = v[i].x * rstd * g.x * (1.f + sc.x) + sh.x, o1 = v[i].y * rstd * g.y * (1.f + sc.y) + sh.y;
            const float o2 = v[i].z * rstd * g.z * (1.f + sc.z) + sh.z, o3 = v[i].w * rstd * g.w * (1.f + sc.w) + sh.w;
            if (IN_N8 > 0) { int w8 = 0; w8 = __builtin_amdgcn_cvt_pk_fp8_f32(o0, o1, w8, false); w8 = __builtin_amdgcn_cvt_pk_fp8_f32(o2, o3, w8, true); *(unsigned*)(p->H8 + (size_t)r * 1024 + col) = (unsigned)w8; }
            if (IN_NBF > 0) *(u32x2*)(p->H + (size_t)r * 1024 + col) = mk2(pk2(o0, o1), pk2(o2, o3));
        }
    }
}

__device__ __forceinline__ void phase_daprep(CP p, int L, int grp, int bid, int nb) {
    const int lane = ltid() & 63, wid = ltid() >> 6;
    const int RG = p->G * SALL;
    const float* qg = p->da_qnorm_g + L * 64; const float* kg = p->da_knorm_g + L * 64;
    const int d0 = (lane & 7) * 8;
    float gq[8], gk[8];
    const float qscale = 0.125f * 1.4426950408889634f;
#pragma unroll
    for (int j = 0; j < 8; ++j) { gq[j] = qg[d0 + j] * qscale; gk[j] = kg[d0 + j]; }
    const bool second = (lane & 2) != 0;
    for (int r = bid * 8 + wid; r < RG; r += nb * 8) {
        const int bl = r / SALL, pos = r - bl * SALL;
        bf16_t* row = p->P + (size_t)r * PWID + PC_DQ;
        const bool lat = pos >= CTXL;
        u32x4 u[4];
#pragma unroll
        for (int i = 0; i < 4; ++i) u[i] = *(const u32x4*)(row + (lane + 64 * i) * 8);
        f32x4 rt4[4];
#pragma unroll
        for (int q = 0; q < 4; ++q) rt4[q] = (f32x4){1.f, 0.f, 1.f, 0.f};
        if (lat) {
            const int s2 = pos - CTXL, ax = (lane >> 2) & 1, f0 = (lane & 1) * 8;
            const float* rt = p->rope + ((size_t)s2 * 32 + ax * 16 + f0) * 2;
#pragma unroll
            for (int q = 0; q < 4; ++q) rt4[q] = *(const f32x4*)(rt + 4 * q);
        }
#pragma unroll
        for (int i = 0; i < 4; ++i) {
            float v[8] = {lo_bf(u[i].x), hi_bf(u[i].x), lo_bf(u[i].y), hi_bf(u[i].y), lo_bf(u[i].z), hi_bf(u[i].z), lo_bf(u[i].w), hi_bf(u[i].w)};
            float ss = 0.f;
#pragma unroll
            for (int j = 0; j < 8; ++j) ss += v[j] * v[j];
            ss += dppf<0xB1>(0.f, ss); ss += dppf<0x4E>(0.f, ss); ss += dppf<0x141>(0.f, ss);
            const float rstd = rsqrtf(ss * (1.0f / 64.0f) + 1e-6f);
#pragma unroll
            for (int j = 0; j < 8; ++j) v[j] = v[j] * rstd * (i < 2 ? gq[j] : gk[j]);
            if (lat) {
#pragma unroll
                for (int j = 0; j < 8; ++j) {
                    const float cs = rt4[j >> 1][(j & 1) * 2], sn = rt4[j >> 1][(j & 1) * 2 + 1];
                    const float o = dppf<0x4E>(0.f, v[j]);
                    v[j] = second ? (v[j] * cs + o * sn) : (v[j] * cs - o * sn);
                }
            }
            u[i] = mk4(pk2(v[0], v[1]), pk2(v[2], v[3]), pk2(v[4], v[5]), pk2(v[6], v[7]));
        }
#pragma unroll
        for (int i = 0; i < 4; ++i) *(u32x4*)(row + (lane + 64 * i) * 8) = u[i];
    }
}

constexpr int AT_KROW = 272, AT_VROW = 288, AT_K = 64 * AT_KROW, AT_STAGE = 64 * AT_KROW + 64 * AT_VROW;
constexpr int A2_QROW = 272, A2_KV = 256 * A2_QROW, A3_STAGE_BYTES = 32768;
static_assert(A2_KV + 2 * AT_STAGE <= 147456 - 64, "attention LDS");
__device__ __forceinline__ void attn_unit2(CP p, int L, LAS unsigned char* lds, int bl, int hd, int qt) {
    const int tid = ltid(), lane = tid & 63, wid = tid >> 6, q4 = lane >> 4, l15 = lane & 15;
    const size_t rowbase = (size_t)bl * SALL;
    const int qpos0 = (qt < 8) ? (CTXL + qt * 256) : 0;
    const int nkt = (qt < 8) ? 36 : 4;
    LAS unsigned char* kv = lds + A2_KV;
    __syncthreads();
    {
#pragma unroll
        for (int i = 0; i < 8; ++i) {
            const int id = tid + NTHREADS * i, row = id >> 4, ch = id & 15;
            *(LAS u32x4*)(lds + row * A2_QROW + ch * 16) = *(const u32x4*)(p->P + (rowbase + qpos0 + row) * PWID + PC_DQ + hd * 128 + ch * 8);
        }
    }
    const bf16_t* kbase = p->P + rowbase * PWID + PC_DK + hd * 128;
    const bf16_t* vbase = kbase + (PC_DV - PC_DK);
    const int drow = wid * 8 + (lane >> 4);
    const unsigned dof0 = (unsigned)drow * PWID + (((lane & 15) ^ (drow & 15)) << 3);
    const unsigned dof1 = (unsigned)(drow + 4) * PWID + (((lane & 15) ^ ((drow + 4) & 15)) << 3);
#define A3_STAGE(stg, kt_) do { const bf16_t* kb_ = kbase + (size_t)(kt_) * 64 * PWID; const bf16_t* vb_ = kb_ + (PC_DV - PC_DK); LAS unsigned char* d_ = kv + (stg) * A3_STAGE_BYTES + wid * 2048; \
        __builtin_amdgcn_global_load_lds((const unsigned*)(kb_ + dof0), (LAS unsigned*)(d_), 16, 0, 0); __builtin_amdgcn_global_load_lds((const unsigned*)(kb_ + dof1), (LAS unsigned*)(d_ + 1024), 16, 0, 0); \
        __builtin_amdgcn_global_load_lds((const unsigned*)(vb_ + dof0), (LAS unsigned*)(d_ + 16384), 16, 0, 0); __builtin_amdgcn_global_load_lds((const unsigned*)(vb_ + dof1), (LAS unsigned*)(d_ + 16384 + 1024), 16, 0, 0); } while (0)
    A3_STAGE(0, 0);
    asm volatile("s_waitcnt vmcnt(0)" ::: "memory");
    __syncthreads();
    f32x4 o[2][2][8];
#pragma unroll
    for (int c = 0; c < 2; ++c)
#pragma unroll
        for (int mt = 0; mt < 2; ++mt)
#pragma unroll
            for (int d = 0; d < 8; ++d) o[c][mt][d] = (f32x4){0.f, 0.f, 0.f, 0.f};
    float ls[2][2] = {{0.f, 0.f}, {0.f, 0.f}};
    const float nbound = -p->lamv[2 + L];
    const int qro = (wid * 32 + l15) * A2_QROW + q4 * 16;
    bf16x8 qf[2][2];
#pragma unroll
    for (int mt = 0; mt < 2; ++mt)
#pragma unroll
        for (int ks = 0; ks < 2; ++ks) qf[mt][ks] = *(LAS bf16x8*)(lds + qro + mt * 16 * A2_QROW + ks * 64);
    for (int kt = 0; kt < nkt; ++kt) {
        LAS unsigned char* cur = kv + (kt & 1) * A3_STAGE_BYTES;
        const bool more = kt + 1 < nkt;
        int lz = l15; asm volatile("" : "+v"(lz));
        const int kro = lz * 256, vrow0 = 4 * q4 + (lz >> 2);
        if (more) A3_STAGE((kt + 1) & 1, kt + 1);
        bf16x8 pf[2][2][2];
        f32x4 sacc[2][2][4];
#define A3_QLOAD(c_) do { _Pragma("unroll") for (int mt = 0; mt < 2; ++mt) _Pragma("unroll") for (int ks = 0; ks < 2; ++ks) qf[mt][ks] = *(LAS bf16x8*)(lds + qro + mt * 16 * A2_QROW + (c_) * 128 + ks * 64); } while (0)
#define A3_SC(s_) ((((s_) >> 3) == 0) ? (((s_) & 7) >> 2) : (1 - (((s_) & 7) >> 2)))
#define A3_SN(s_) (2 * ((s_) >> 3) + ((((s_) & 7) >> 1) & 1))
#define A3_KLOAD(s_) kf[(s_) % 3] = *(LAS bf16x8*)(cur + kro + A3_SN(s_) * 4096 + (((A3_SC(s_) * 8 + ((s_) & 1) * 4 + q4) ^ lz) << 4))
#define A3_EXP4(c_, mt_, n_) do { _Pragma("unroll") for (int j = 0; j < 4; ++j) { sacc[c_][mt_][n_][j] = __builtin_amdgcn_exp2f(sacc[c_][mt_][n_][j]); ls[c_][mt_] += sacc[c_][mt_][n_][j]; } } while (0)
#define A3_PACK(c_, mt_, k2_) do { union { bf16x8 v; unsigned u[4]; } cv; \
            cv.u[0] = pk2(sacc[c_][mt_][2 * (k2_)][0], sacc[c_][mt_][2 * (k2_)][1]); cv.u[1] = pk2(sacc[c_][mt_][2 * (k2_)][2], sacc[c_][mt_][2 * (k2_)][3]); \
            cv.u[2] = pk2(sacc[c_][mt_][2 * (k2_) + 1][0], sacc[c_][mt_][2 * (k2_) + 1][1]); cv.u[3] = pk2(sacc[c_][mt_][2 * (k2_) + 1][2], sacc[c_][mt_][2 * (k2_) + 1][3]); pf[c_][mt_][k2_] = cv.v; } while (0)
#define A3_VREAD(v_) do { const int d_ = (v_) & 7, k2_ = (v_) >> 3; const int vr0 = 32 * k2_ + vrow0, vr1 = vr0 + 16; \
            const int vsw = (((d_ * 2 + ((lz & 3) >> 1)) ^ (vr0 & 15)) << 4) + (lz & 1) * 8; \
            const s16x4 v0 = __builtin_amdgcn_ds_read_tr16_b64_v4i16((LAS s16x4*)(cur + 16384 + vr0 * 256 + vsw)); \
            const s16x4 v1 = __builtin_amdgcn_ds_read_tr16_b64_v4i16((LAS s16x4*)(cur + 16384 + vr1 * 256 + vsw)); \
            vf[(v_) % 3] = (bf16x8){v0[0], v0[1], v0[2], v0[3], v1[0], v1[1], v1[2], v1[3]}; } while (0)
        bf16x8 kf[3], vf[3];
        A3_KLOAD(0); A3_KLOAD(1);
#pragma unroll
        for (int sq = 0; sq < 16; ++sq) {
            if (sq == 4) A3_QLOAD(1);
            if (sq == 12) A3_QLOAD(0);
            if (sq + 2 < 16) A3_KLOAD(sq + 2); else A3_VREAD(sq + 2 - 16);
            {
                const int c = A3_SC(sq), n = A3_SN(sq), ks = sq & 1;
                if (ks == 0) { sacc[c][0][n] = (f32x4){nbound, nbound, nbound, nbound}; sacc[c][1][n] = (f32x4){nbound, nbound, nbound, nbound}; }
                sacc[c][0][n] = __builtin_amdgcn_mfma_f32_16x16x32_bf16(kf[sq % 3], qf[0][ks], sacc[c][0][n], 0, 0, 0);
                sacc[c][1][n] = __builtin_amdgcn_mfma_f32_16x16x32_bf16(kf[sq % 3], qf[1][ks], sacc[c][1][n], 0, 0, 0);
            }
            if (sq >= 4) { const int e = sq - 4; A3_EXP4((e >> 2) ? 1 : 0, (e >> 1) & 1, ((e >> 3) ? 2 : 0) + (e & 1)); }
            if (sq == 7) { A3_PACK(0, 0, 0); A3_PACK(0, 1, 0); }
            if (sq == 11) { A3_PACK(1, 0, 0); A3_PACK(1, 1, 0); }
            if (sq == 15) { A3_PACK(1, 0, 1); A3_PACK(1, 1, 1); }
            __builtin_amdgcn_sched_barrier(0);
        }
#pragma unroll
        for (int v = 0; v < 16; ++v) {
            if (v + 2 < 16) A3_VREAD(v + 2);
            if (v == 8) { A3_PACK(0, 0, 1); A3_PACK(0, 1, 1); }
            {
                const int d = v & 7, k2 = v >> 3;
                o[0][0][d] = __builtin_amdgcn_mfma_f32_16x16x32_bf16(vf[v % 3], pf[0][0][k2], o[0][0][d], 0, 0, 0); o[0][1][d] = __builtin_amdgcn_mfma_f32_16x16x32_bf16(vf[v % 3], pf[0][1][k2], o[0][1][d], 0, 0, 0);
                o[1][0][d] = __builtin_amdgcn_mfma_f32_16x16x32_bf16(vf[v % 3], pf[1][0][k2], o[1][0][d], 0, 0, 0); o[1][1][d] = __builtin_amdgcn_mfma_f32_16x16x32_bf16(vf[v % 3], pf[1][1][k2], o[1][1][d], 0, 0, 0);
            }
            if (v < 8 && (v & 1) == 0) A3_EXP4(0, (v >> 2) & 1, 2 + ((v >> 1) & 1));
            __builtin_amdgcn_sched_barrier(0);
        }
#undef A3_VREAD
#undef A3_QLOAD
#undef A3_SC
#undef A3_SN
#undef A3_KLOAD
#undef A3_EXP4
#undef A3_PACK
        asm volatile("s_waitcnt vmcnt(0)" ::: "memory");
        __syncthreads();
    }
#undef A3_STAGE
    const float lam = p->lamv[L];
    const float lam_init = 0.8f - 0.6f * expf(-0.3f * (float)L);
    const float* sg = p->da_subln_g + L * 128;
#pragma unroll
    for (int mt = 0; mt < 2; ++mt) {
        float l0 = ls[0][mt], l1 = ls[1][mt];
        l0 += sx_(l0, 16); l0 += sx_(l0, 32); l1 += sx_(l1, 16); l1 += sx_(l1, 32);
        const float i0 = 1.0f / l0, i1 = lam / l1;
        float ss = 0.f;
#pragma unroll
        for (int d = 0; d < 8; ++d)
#pragma unroll
            for (int j = 0; j < 4; ++j) { const float v = o[0][mt][d][j] * i0 - o[1][mt][d][j] * i1; o[0][mt][d][j] = v; ss += v * v; }
        ss += sx_(ss, 16); ss += sx_(ss, 32);
        const float rstd = rsqrtf(ss * (1.0f / 128.0f) + 1e-6f) * (1.0f - lam_init);
        bf16_t* orow = p->YC + (rowbase + qpos0 + wid * 32 + mt * 16 + l15) * 1024 + hd * 128;
#pragma unroll
        for (int d = 0; d < 8; ++d) {
            const int dv = d * 16 + 4 * q4;
            const f32x4 g = *(const f32x4*)(sg + dv);
            if (MERGE_F8) { int w8 = 0; w8 = __builtin_amdgcn_cvt_pk_fp8_f32(o[0][mt][d][0] * rstd * g[0], o[0][mt][d][1] * rstd * g[1], w8, false); w8 = __builtin_amdgcn_cvt_pk_fp8_f32(o[0][mt][d][2] * rstd * g[2], o[0][mt][d][3] * rstd * g[3], w8, true);
                *(unsigned*)((unsigned char*)p->YC + (rowbase + qpos0 + wid * 32 + mt * 16 + l15) * 1024 + hd * 128 + dv) = (unsigned)w8; }
            else *(u32x2*)(orow + dv) = mk2(pk2(o[0][mt][d][0] * rstd * g[0], o[0][mt][d][1] * rstd * g[1]), pk2(o[0][mt][d][2] * rstd * g[2], o[0][mt][d][3] * rstd * g[3]));
        }
    }
}

constexpr int ML_QROW = 272, ML_KROW = 288, ML_VROW = 544, ML_SROW = 144;
constexpr int ML_Q = 0, ML_K = ML_Q + 64 * ML_QROW, ML_V = ML_K + 64 * ML_KROW, ML_S = ML_V + 64 * ML_VROW, ML_ARR = ML_S + 64 * ML_SROW, ML_N = ML_ARR + 4 * 256, ML_RD = ML_N + 2 * 512, ML_NP = ML_RD + 8 * 256, ML_H = ML_NP + 4 * 512, ML_HROW = 528, ML_SSP = ML_H + 64 * ML_HROW  , ML_QN = ML_SSP + 1024  , ML_END = ML_QN + 256;
static_assert(ML_END <= LDS_BYTES, "mlstm LDS");
__device__ __forceinline__ void mlstm_unit(CP p, int L, LAS unsigned char* lds, int bl, int hd, int dir) {
    const int tid = ltid(), lane = tid & 63, wid = tid >> 6, q4 = lane >> 4, l15 = lane & 15;
    const size_t rowbase = (size_t)bl * SALL;
    LAS float* carr = (LAS float*)(lds + ML_ARR);
    LAS float* Marr = carr + 64;
    LAS float* wsarr = carr + 128;
    LAS float* wiarr = carr + 192;
    LAS float* nbuf = (LAS float*)(lds + ML_N);
    LAS float* npart = (LAS float*)(lds + ML_NP);
    const float gbi = p->ml_gate_b[((L * 2 + dir) * 2 + 0) * 4 + hd], gbf = p->ml_gate_b[((L * 2 + dir) * 2 + 1) * 4 + hd];
    __syncthreads();
    if (tid < 128) nbuf[tid] = 0.f;
    f32x4 C[8][2];
#pragma unroll
    for (int a = 0; a < 8; ++a) { C[a][0] = (f32x4){0.f, 0.f, 0.f, 0.f}; C[a][1] = C[a][0]; }
    float mstate = 0.f;
    const int srow = tid >> 4, sch = tid & 15;
    const int vrow = tid >> 5, vch = tid & 31;
    u32x4 rq[2], rk[2], rv[4]; float rgi = 0.f, rgf = 0.f;
    auto chunk_pb = [&](int t) -> int { return dir == 0 ? t * 64 : (t < 4 ? (3 - t) * 64 : (39 - t) * 64); };
    auto grow_of = [&](int pb, int j) -> size_t { return rowbase + pb + (dir ? 63 - j : j); };
    auto issue = [&](int t) {
        const int pb = chunk_pb(t);
#pragma unroll
        for (int i = 0; i < 2; ++i) {
            const bf16_t* r = p->P + grow_of(pb, srow + 32 * i) * PWID;
            rq[i] = *(const u32x4*)(r + PC_MQ + hd * 128 + sch * 8);
            rk[i] = *(const u32x4*)(r + PC_MK + hd * 128 + sch * 8);
        }
#pragma unroll
        for (int i = 0; i < 4; ++i) rv[i] = *(const u32x4*)(p->P + grow_of(pb, vrow + 16 * i) * PWID + PC_MV + hd * 256 + vch * 8);
        { const float* gr = p->GATES + grow_of(pb, lane) * 16 + dir * 8 + hd; rgi = gr[0]; rgf = gr[4]; }
    };
    issue(0);
    for (int t = 0; t < 36; ++t) {
        const int pb = chunk_pb(t);
        const float gi = rgi + gbi, gf = rgf + gbf;
        const float lf = fminf(gf, 0.f) - __logf(1.0f + __expf(-fabsf(gf)));
        float bcs = lf;
        bcs += dppf<0x111>(0.f, bcs); bcs += dppf<0x112>(0.f, bcs); bcs += dppf<0x114>(0.f, bcs); bcs += dppf<0x118>(0.f, bcs);
        {
            const float t0 = __builtin_bit_cast(float, __builtin_amdgcn_readlane(__builtin_bit_cast(int, bcs), 15));
            const float t1 = __builtin_bit_cast(float, __builtin_amdgcn_readlane(__builtin_bit_cast(int, bcs), 31));
            const float t2 = __builtin_bit_cast(float, __builtin_amdgcn_readlane(__builtin_bit_cast(int, bcs), 47));
            bcs += (q4 == 0) ? 0.f : ((q4 == 1) ? t0 : ((q4 == 2) ? (t0 + t1) : (t0 + t1 + t2)));
        }
        const float cval = gi - bcs;
        float cm = cval;
        cm = fmaxf(cm, dppf<0x111>(-3.0e38f, cm)); cm = fmaxf(cm, dppf<0x112>(-3.0e38f, cm)); cm = fmaxf(cm, dppf<0x114>(-3.0e38f, cm)); cm = fmaxf(cm, dppf<0x118>(-3.0e38f, cm));
        {
            const float t0 = __builtin_bit_cast(float, __builtin_amdgcn_readlane(__builtin_bit_cast(int, cm), 15));
            const float t1 = __builtin_bit_cast(float, __builtin_amdgcn_readlane(__builtin_bit_cast(int, cm), 31));
            const float t2 = __builtin_bit_cast(float, __builtin_amdgcn_readlane(__builtin_bit_cast(int, cm), 47));
            const float pm = (q4 == 0) ? -3.0e38f : ((q4 == 1) ? t0 : ((q4 == 2) ? fmaxf(t0, t1) : fmaxf(fmaxf(t0, t1), t2)));
            cm = fmaxf(cm, pm);
        }
        const float Mj = fmaxf(mstate, cm);
        const float bL = __builtin_bit_cast(float, __builtin_amdgcn_readlane(__builtin_bit_cast(int, bcs), 63)), ML = __builtin_bit_cast(float, __builtin_amdgcn_readlane(__builtin_bit_cast(int, Mj), 63));
        const float w_inter = __expf(mstate - Mj);
        const float w_s = __expf(cval - ML);
        const float w_c = __expf(mstate - ML);
        const float floorj = __expf(-bcs - Mj);
        if (wid == 0) { carr[lane] = cval; Marr[lane] = Mj; wsarr[lane] = w_s; wiarr[lane] = w_inter; }
        {
            const float ksc = 0.08838834764831845f;
#pragma unroll
            for (int i = 0; i < 2; ++i) {
                *(LAS u32x4*)(lds + ML_Q + (srow + 32 * i) * ML_QROW + sch * 16) = rq[i];
                u32x4 u = rk[i];
                u.x = pk2(lo_bf(u.x) * ksc, hi_bf(u.x) * ksc); u.y = pk2(lo_bf(u.y) * ksc, hi_bf(u.y) * ksc);
                u.z = pk2(lo_bf(u.z) * ksc, hi_bf(u.z) * ksc); u.w = pk2(lo_bf(u.w) * ksc, hi_bf(u.w) * ksc);
                *(LAS u32x4*)(lds + ML_K + (srow + 32 * i) * ML_KROW + sch * 16) = u;
            }
#pragma unroll
            for (int i = 0; i < 4; ++i) *(LAS u32x4*)(lds + ML_V + (vrow + 16 * i) * ML_VROW + vch * 16) = rv[i];
        }
        __syncthreads();
        if (t + 1 < 36) issue(t + 1);
#pragma unroll
        for (int ti = 0; ti < 2; ++ti) {
            const int idx = wid * 2 + ti, jt = idx >> 2, st = idx & 3;
            f32x4 s = (f32x4){0.f, 0.f, 0.f, 0.f};
            if (st <= jt) {
#pragma unroll
                for (int ks = 0; ks < 4; ++ks) {
                    const bf16x8 kf = *(LAS bf16x8*)(lds + ML_K + (st * 16 + l15) * ML_KROW + ks * 64 + q4 * 16);
                    const bf16x8 qf = *(LAS bf16x8*)(lds + ML_Q + (jt * 16 + l15) * ML_QROW + ks * 64 + q4 * 16);
                    s = __builtin_amdgcn_mfma_f32_16x16x32_bf16(kf, qf, s, 0, 0, 0);
                }
                const int j = jt * 16 + l15;
                const float Mv = Marr[j];
#pragma unroll
                for (int r = 0; r < 4; ++r) { const int sidx = st * 16 + 4 * q4 + r; s[r] = (sidx <= j) ? s[r] * __expf(carr[sidx] - Mv) : 0.f; }
            }
            const unsigned p01 = pk2(s[0], s[1]), p23 = pk2(s[2], s[3]);
            *(LAS u32x2*)(lds + ML_S + (jt * 16 + l15) * ML_SROW + (st * 16 + 4 * q4) * 2) = mk2(p01, p23);
            {
                float rs = (lo_bf(p01) + hi_bf(p01)) + (lo_bf(p23) + hi_bf(p23));
                rs += sx_(rs, 16); rs += sx_(rs, 32);
                if (q4 == 0) ((LAS float*)(lds + ML_SSP))[st * 64 + jt * 16 + l15] = rs;
            }
        }
        {
            const int row = tid >> 3, part = tid & 7;
            LAS unsigned char* qp = lds + ML_Q + row * ML_QROW + part * 32;
            const u32x4 u0 = *(LAS u32x4*)qp, u1 = *(LAS u32x4*)(qp + 16);
            LAS float* nv = nbuf + (t & 1) * 128 + part * 16;
            const f32x4 n0 = *(LAS f32x4*)nv, n1 = *(LAS f32x4*)(nv + 4), n2 = *(LAS f32x4*)(nv + 8), n3 = *(LAS f32x4*)(nv + 12);
            float a = lo_bf(u0.x) * n0[0] + hi_bf(u0.x) * n0[1] + lo_bf(u0.y) * n0[2] + hi_bf(u0.y) * n0[3] + lo_bf(u0.z) * n1[0] + hi_bf(u0.z) * n1[1] + lo_bf(u0.w) * n1[2] + hi_bf(u0.w) * n1[3]
                    + lo_bf(u1.x) * n2[0] + hi_bf(u1.x) * n2[1] + lo_bf(u1.y) * n2[2] + hi_bf(u1.y) * n2[3] + lo_bf(u1.z) * n3[0] + hi_bf(u1.z) * n3[1] + lo_bf(u1.w) * n3[2] + hi_bf(u1.w) * n3[3];
            a += dppf<0xB1>(0.f, a); a += dppf<0x4E>(0.f, a); a += dppf<0x141>(0.f, a);
            if (part == 0) ((LAS float*)(lds + ML_QN))[row] = a;
        }
        {
            const int dk = tid & 127, part = tid >> 7;
            float a = 0.f;
#pragma unroll
            for (int s2 = 0; s2 < 16; ++s2) a += wsarr[part * 16 + s2] * bf2f(*(LAS bf16_t*)(lds + ML_K + (part * 16 + s2) * ML_KROW + dk * 2));
            npart[part * 128 + dk] = a;
        }
        __syncthreads();
        if (tid < 128) nbuf[((t + 1) & 1) * 128 + tid] = w_c * nbuf[(t & 1) * 128 + tid] + (npart[tid] + npart[128 + tid]) + (npart[256 + tid] + npart[384 + tid]);
        float rden;
        {
            LAS float* ssp = (LAS float*)(lds + ML_SSP);
            const float ssum = (ssp[lane] + ssp[64 + lane]) + (ssp[128 + lane] + ssp[192 + lane]);
            const float den = ssum + w_inter * ((LAS float*)(lds + ML_QN))[lane];
            rden = __builtin_amdgcn_rcpf(fmaxf(fabsf(den), floorj));
        }
        f32x4 acc[4][2];
#pragma unroll
        for (int m = 0; m < 4; ++m) { acc[m][0] = (f32x4){0.f, 0.f, 0.f, 0.f}; acc[m][1] = acc[m][0]; }
#pragma unroll
        for (int tt = 0; tt < 4; ++tt) {
            bf16x8 cb[2];
#pragma unroll
            for (int nn = 0; nn < 2; ++nn) {
                union { bf16x8 v; unsigned u[4]; } cv;
                cv.u[0] = pk2(C[2 * tt][nn][0], C[2 * tt][nn][1]); cv.u[1] = pk2(C[2 * tt][nn][2], C[2 * tt][nn][3]);
                cv.u[2] = pk2(C[2 * tt + 1][nn][0], C[2 * tt + 1][nn][1]); cv.u[3] = pk2(C[2 * tt + 1][nn][2], C[2 * tt + 1][nn][3]);
                cb[nn] = cv.v;
            }
#pragma unroll
            for (int m = 0; m < 4; ++m) {
                LAS unsigned char* qp = lds + ML_Q + (m * 16 + l15) * ML_QROW + (32 * tt + 4 * q4) * 2;
                const u32x2 a0 = *(LAS u32x2*)qp, a1 = *(LAS u32x2*)(qp + 32);
                union { bf16x8 v; unsigned u[4]; } av; av.u[0] = a0.x; av.u[1] = a0.y; av.u[2] = a1.x; av.u[3] = a1.y;
                acc[m][0] = __builtin_amdgcn_mfma_f32_16x16x32_bf16(av.v, cb[0], acc[m][0], 0, 0, 0);
                acc[m][1] = __builtin_amdgcn_mfma_f32_16x16x32_bf16(av.v, cb[1], acc[m][1], 0, 0, 0);
            }
        }
#pragma unroll
        for (int m = 0; m < 4; ++m) {
            const f32x4 wi = *(LAS f32x4*)(wiarr + m * 16 + 4 * q4);
#pragma unroll
            for (int r = 0; r < 4; ++r) { acc[m][0][r] *= wi[r]; acc[m][1][r] *= wi[r]; }
        }
        bf16x8 vfr[2][2];
#pragma unroll
        for (int nn = 0; nn < 2; ++nn)
#pragma unroll
            for (int ks = 0; ks < 2; ++ks) {
                LAS unsigned char* vp2 = lds + ML_V + (32 * ks + 8 * q4 + (l15 >> 2)) * ML_VROW + ((2 * wid + nn) * 16 + (l15 & 3) * 4) * 2;
                const s16x4 v0 = __builtin_amdgcn_ds_read_tr16_b64_v4i16((LAS s16x4*)vp2);
                const s16x4 v1 = __builtin_amdgcn_ds_read_tr16_b64_v4i16((LAS s16x4*)(vp2 + 4 * ML_VROW));
                vfr[nn][ks] = (bf16x8){v0[0], v0[1], v0[2], v0[3], v1[0], v1[1], v1[2], v1[3]};
            }
#pragma unroll
        for (int m = 0; m < 4; ++m)
#pragma unroll
            for (int ks = 0; ks < 2; ++ks) {
                const bf16x8 sf = *(LAS bf16x8*)(lds + ML_S + (m * 16 + l15) * ML_SROW + ks * 64 + q4 * 16);
                acc[m][0] = __builtin_amdgcn_mfma_f32_16x16x32_bf16(sf, vfr[0][ks], acc[m][0], 0, 0, 0);
                acc[m][1] = __builtin_amdgcn_mfma_f32_16x16x32_bf16(sf, vfr[1][ks], acc[m][1], 0, 0, 0);
            }
        {
            LAS float* rdw = (LAS float*)(lds + ML_RD) + wid * 64;
            rdw[lane] = rden;
#pragma unroll
            for (int m = 0; m < 4; ++m) {
                const f32x4 rd = *(LAS f32x4*)(rdw + m * 16 + 4 * q4);
#pragma unroll
                for (int r = 0; r < 4; ++r) {
                    LAS bf16_t* hp = (LAS bf16_t*)(lds + ML_H + (m * 16 + 4 * q4 + r) * ML_HROW) + (2 * wid) * 16 + l15;
                    hp[0] = (bf16_t)(pk2(acc[m][0][r] * rd[r], 0.f) & 0xffffu);
                    hp[16] = (bf16_t)(pk2(acc[m][1][r] * rd[r], 0.f) & 0xffffu);
                }
            }
        }
        {
            bf16x8 vw[2][2];
#pragma unroll
            for (int ks = 0; ks < 2; ++ks) {
                const f32x4 w0 = *(LAS f32x4*)(wsarr + 32 * ks + 8 * q4), w1 = *(LAS f32x4*)(wsarr + 32 * ks + 8 * q4 + 4);
#pragma unroll
                for (int nn = 0; nn < 2; ++nn) {
                    union { bf16x8 v; unsigned u[4]; } x; x.v = vfr[nn][ks];
                    x.u[0] = pk2(lo_bf(x.u[0]) * w0[0], hi_bf(x.u[0]) * w0[1]); x.u[1] = pk2(lo_bf(x.u[1]) * w0[2], hi_bf(x.u[1]) * w0[3]);
                    x.u[2] = pk2(lo_bf(x.u[2]) * w1[0], hi_bf(x.u[2]) * w1[1]); x.u[3] = pk2(lo_bf(x.u[3]) * w1[2], hi_bf(x.u[3]) * w1[3]);
                    vw[nn][ks] = x.v;
                }
            }
#pragma unroll
            for (int dk = 0; dk < 8; ++dk) {
                C[dk][0] *= w_c; C[dk][1] *= w_c;
#pragma unroll
                for (int ks = 0; ks < 2; ++ks) {
                    LAS unsigned char* kp2 = lds + ML_K + (32 * ks + 8 * q4 + (l15 >> 2)) * ML_KROW + (dk * 16 + (l15 & 3) * 4) * 2;
                    const s16x4 k0 = __builtin_amdgcn_ds_read_tr16_b64_v4i16((LAS s16x4*)kp2);
                    const s16x4 k1 = __builtin_amdgcn_ds_read_tr16_b64_v4i16((LAS s16x4*)(kp2 + 4 * ML_KROW));
                    const bf16x8 kf = {k0[0], k0[1], k0[2], k0[3], k1[0], k1[1], k1[2], k1[3]};
                    C[dk][0] = __builtin_amdgcn_mfma_f32_16x16x32_bf16(kf, vw[0][ks], C[dk][0], 0, 0, 0);
                    C[dk][1] = __builtin_amdgcn_mfma_f32_16x16x32_bf16(kf, vw[1][ks], C[dk][1], 0, 0, 0);
                }
            }
        }
        mstate = bL + ML;
        __syncthreads();
        {
            bf16_t* hb = (dir == 0 ? p->YB : p->HB);
#pragma unroll
            for (int i = 0; i < 4; ++i) {
                const int j = vrow + 16 * i;
                const u32x4 v = *(LAS u32x4*)(lds + ML_H + j * ML_HROW + vch * 16);
                *(u32x4*)(hb + grow_of(pb, j) * 1024 + hd * 256 + vch * 8) = v;
            }
        }
    }
}

__device__ __forceinline__ void phase_mlfinish(CP p, int L, int bid, int nb) {
    const int lane = ltid() & 63, wid = ltid() >> 6;
    const int RG = p->G * SALL;
    const float* ng = p->ml_norm_g + L * 1024;
    for (int r = bid * 8 + wid; r < RG; r += nb * 8) {
        if (L == 1 && (r % SALL) < CTXL) continue;
        u32x2 a[4], b2[4], ov[4];
#pragma unroll
        for (int hh = 0; hh < 4; ++hh) {
            const int col = hh * 256 + lane * 4;
            a[hh] = *(const u32x2*)(p->YB + (size_t)r * 1024 + col); b2[hh] = *(const u32x2*)(p->HB + (size_t)r * 1024 + col); ov[hh] = mk2(*(const unsigned*)(p->MO8 + (size_t)r * 1024 + col), 0u);
        }
#pragma unroll
        for (int hh = 0; hh < 4; ++hh) {
            const int col = hh * 256 + lane * 4;
            float v[4] = {lo_bf(a[hh].x) + lo_bf(b2[hh].x), hi_bf(a[hh].x) + hi_bf(b2[hh].x), lo_bf(a[hh].y) + lo_bf(b2[hh].y), hi_bf(a[hh].y) + hi_bf(b2[hh].y)};
            const float ss = wave_sum(v[0] * v[0] + v[1] * v[1] + v[2] * v[2] + v[3] * v[3]);
            const float rstd = rsqrtf(ss * (1.0f / 256.0f) + 1e-6f);
            const float4 g = *(const float4*)(ng + col);
            const f32x2 q0 = __builtin_amdgcn_cvt_pk_f32_fp8((int)ov[hh].x, false), q1 = __builtin_amdgcn_cvt_pk_f32_fp8((int)ov[hh].x, true);
            const float o0 = sigmoidf_(q0[0]), o1 = sigmoidf_(q0[1]), o2 = sigmoidf_(q1[0]), o3 = sigmoidf_(q1[1]);
            if (MERGE_F8) { int w8 = 0; w8 = __builtin_amdgcn_cvt_pk_fp8_f32(v[0] * rstd * g.x * o0, v[1] * rstd * g.y * o1, w8, false); w8 = __builtin_amdgcn_cvt_pk_fp8_f32(v[2] * rstd * g.z * o2, v[3] * rstd * g.w * o3, w8, true); *(unsigned*)(p->YB8 + (size_t)r * 1024 + col) = (unsigned)w8; }
            else *(u32x2*)(p->YB + (size_t)r * 1024 + col) = mk2(pk2(v[0] * rstd * g.x * o0, v[1] * rstd * g.y * o1), pk2(v[2] * rstd * g.z * o2, v[3] * rstd * g.w * o3));
        }
    }
}

constexpr int LSEG = 128, LNSEG = SALL / LSEG, LCTXSEG = CTXL / LSEG, LMT = LSEG / 16;
constexpr int LC_XA = 0, LC_ROW = 272, LC_UB = LC_XA + (LSEG + 4) * LC_ROW, LC_HB = LC_UB + LSEG * LC_ROW, LC_CW = LC_HB + LSEG * LC_ROW, LC_END = LC_CW + 5 * 128 * 4;
static_assert(LC_END <= 131072, "LRU LDS");
template <int D>
__device__ __forceinline__ void lru_scan16(float (&a)[LMT][4], float (&b)[LMT][4]) {
#pragma unroll
    for (int m = 0; m < LMT; ++m)
#pragma unroll
        for (int j = 0; j < 4; ++j) {
            float av = a[m][j], bv = b[m][j], ap, bp;
            if (D == 0) { ap = dppf<0x111>(1.0f, av); bp = dppf<0x111>(0.0f, bv); } else { ap = dppf<0x101>(1.0f, av); bp = dppf<0x101>(0.0f, bv); }
            bv = av * bp + bv; av = av * ap;
            if (D == 0) { ap = dppf<0x112>(1.0f, av); bp = dppf<0x112>(0.0f, bv); } else { ap = dppf<0x102>(1.0f, av); bp = dppf<0x102>(0.0f, bv); }
            bv = av * bp + bv; av = av * ap;
            if (D == 0) { ap = dppf<0x114>(1.0f, av); bp = dppf<0x114>(0.0f, bv); } else { ap = dppf<0x104>(1.0f, av); bp = dppf<0x104>(0.0f, bv); }
            bv = av * bp + bv; av = av * ap;
            if (D == 0) { ap = dppf<0x118>(1.0f, av); bp = dppf<0x118>(0.0f, bv); } else { ap = dppf<0x108>(1.0f, av); bp = dppf<0x108>(0.0f, bv); }
            bv = av * bp + bv; av = av * ap;
            a[m][j] = av; b[m][j] = bv;
        }
}
template <int D>
__device__ __forceinline__ void lru_chain_dir(CP p, int L, LAS unsigned char* lds, int bl, int hb) {
    const int tid = ltid(), lane = tid & 63, wid = tid >> 6, q4 = lane >> 4, l15 = lane & 15;
    const size_t rowbase = (size_t)bl * SALL;
    LAS float* cwl = (LAS float*)(lds + LC_CW);
    __syncthreads();
    for (int e = tid; e < 5 * 128; e += NTHREADS) { const int j = e >> 7, ch = e & 127; cwl[e] = (j < 4) ? p->conv_w[((size_t)L * 4 + j) * 1024 + hb * 128 + ch] : p->conv_b[L * 1024 + hb * 128 + ch]; }
    bf16x8 wf[2][4];
    {
        const int cq = wid >> 1, n0 = wid & 1;
        const bf16_t* wb = p->bt_lru + ((size_t)(D * 8 + hb) * 256 + cq * 64 + n0 * 16 + l15) * 128 + q4 * 8;
#pragma unroll
        for (int g = 0; g < 2; ++g)
#pragma unroll
            for (int ks = 0; ks < 4; ++ks) wf[g][ks] = *(const bf16x8*)(wb + (size_t)g * 32 * 128 + ks * 32);
    }
    const int chb = wid * 16 + 4 * q4, gch = hb * 128 + chb;
    const f32x4 ba = *(const f32x4*)(p->lru_ba + (L * 2 + D) * 1024 + gch), bx = *(const f32x4*)(p->lru_bx + (L * 2 + D) * 1024 + gch);
    f32x4 sp;
    { const f32x4 lam = *(const f32x4*)(p->lru_lam + (L * 2 + D) * 1024 + gch);
#pragma unroll
      for (int j = 0; j < 4; ++j) { const float z = -lam[j]; sp[j] = -8.0f * (fmaxf(z, 0.f) + log1pf(__expf(-fabsf(z)))); } }
    float carry[4] = {0.f, 0.f, 0.f, 0.f};
    const int t = tid >> 3, c8 = tid & 7;
    const bf16_t* pbase = p->P + rowbase * PWID + PC_XA + hb * 128;
    bf16_t* obase = (D == 0 ? p->YA : p->HB2) + rowbase * 1024 + hb * 128;
    u32x4 x0[2], x1[2], h0, h1;
    auto seg_of = [&](int s) -> int { return D == 0 ? s : (s < LCTXSEG ? LCTXSEG - 1 - s : LNSEG + LCTXSEG - 1 - s); };
    auto issue = [&](int s) {
        const int seg = seg_of(s), pb = seg * LSEG, lo = (seg < LCTXSEG) ? 0 : CTXL, hi = (seg < LCTXSEG) ? CTXL : SALL;
        const int tid = ltid(), t = tid >> 3, c8 = tid & 7;
#pragma unroll
        for (int i = 0; i < 2; ++i) { const bf16_t* xr = (const bf16_t*)((const char*)pbase + (unsigned)(((pb + t + 64 * i) * PWID + c8 * 16) * 2)); x0[i] = *(const u32x4*)xr; x1[i] = *(const u32x4*)(xr + 8); }
        h0 = mk4(0u, 0u, 0u, 0u); h1 = h0;
        if (tid < 24) {
            const int pos = (t < 2) ? (pb - 2 + t) : (pb + LSEG);
            if (pos >= lo && pos < hi) { const bf16_t* hr = (const bf16_t*)((const char*)pbase + (unsigned)((pos * PWID + c8 * 16) * 2)); h0 = *(const u32x4*)hr; h1 = *(const u32x4*)(hr + 8); }
        }
    };
    issue(0);
    for (int s = 0; s < LNSEG; ++s) {
        const int seg = seg_of(s), pb = seg * LSEG;
#pragma unroll
        for (int i = 0; i < 2; ++i) { *(LAS u32x4*)(lds + LC_XA + (t + 64 * i + 2) * LC_ROW + c8 * 32) = x0[i]; *(LAS u32x4*)(lds + LC_XA + (t + 64 * i + 2) * LC_ROW + c8 * 32 + 16) = x1[i]; }
        if (tid < 24) { const int lr = (t < 2) ? t : (LSEG + 2); *(LAS u32x4*)(lds + LC_XA + lr * LC_ROW + c8 * 32) = h0; *(LAS u32x4*)(lds + LC_XA + lr * LC_ROW + c8 * 32 + 16) = h1; }
        if (s + 1 < LNSEG) issue(s + 1);
        __syncthreads();
        {
            const int cg = tid & 31, r0c = (tid >> 5) * 8;
            f32x4 cwr[5];
#pragma unroll
            for (int j = 0; j < 5; ++j) cwr[j] = *(LAS f32x4*)(cwl + j * 128 + cg * 4);
            float xw[4][4];
#pragma unroll
            for (int k = 0; k < 3; ++k) { const u32x2 a = *(LAS u32x2*)(lds + LC_XA + (r0c + k) * LC_ROW + cg * 8); xw[k][0] = lo_bf(a.x); xw[k][1] = hi_bf(a.x); xw[k][2] = lo_bf(a.y); xw[k][3] = hi_bf(a.y); }
#pragma unroll
            for (int k = 0; k < 8; ++k) {
                { const u32x2 a = *(LAS u32x2*)(lds + LC_XA + (r0c + k + 3) * LC_ROW + cg * 8); xw[(k + 3) & 3][0] = lo_bf(a.x); xw[(k + 3) & 3][1] = hi_bf(a.x); xw[(k + 3) & 3][2] = lo_bf(a.y); xw[(k + 3) & 3][3] = hi_bf(a.y); }
                float u[4];
#pragma unroll
                for (int i = 0; i < 4; ++i) u[i] = cwr[4][i] + cwr[0][i] * xw[k & 3][i] + cwr[1][i] * xw[(k + 1) & 3][i] + cwr[2][i] * xw[(k + 2) & 3][i] + cwr[3][i] * xw[(k + 3) & 3][i];
                *(LAS u32x2*)(lds + LC_UB + (r0c + k) * LC_ROW + cg * 8) = mk2(pk2(u[0], u[1]), pk2(u[2], u[3]));
            }
        }
        __syncthreads();
        float a[LMT][4], b[LMT][4];
#pragma unroll
        for (int m = 0; m < LMT; ++m) {
            f32x4 acc0 = (f32x4){0.f, 0.f, 0.f, 0.f}, acc1 = acc0;
#pragma unroll
            for (int ks = 0; ks < 4; ++ks) {
                const bf16x8 uu = *(LAS bf16x8*)(lds + LC_UB + (m * 16 + l15) * LC_ROW + ks * 64 + q4 * 16);
                acc0 = __builtin_amdgcn_mfma_f32_16x16x32_bf16(wf[0][ks], uu, acc0, 0, 0, 0);
                acc1 = __builtin_amdgcn_mfma_f32_16x16x32_bf16(wf[1][ks], uu, acc1, 0, 0, 0);
            }
            const u32x2 uv = *(LAS u32x2*)(lds + LC_UB + (m * 16 + l15) * LC_ROW + chb * 2);
            const float uf4[4] = {lo_bf(uv.x), hi_bf(uv.x), lo_bf(uv.y), hi_bf(uv.y)};
#pragma unroll
            for (int j = 0; j < 4; ++j) {
                const float rr = __builtin_amdgcn_rcpf(1.0f + __expf(-(acc0[j] + ba[j]))), ii = __builtin_amdgcn_rcpf(1.0f + __expf(-(acc1[j] + bx[j])));
                const float av = __expf(rr * sp[j]);
                a[m][j] = av; b[m][j] = __builtin_amdgcn_sqrtf(fmaxf(1.0f - av * av, 0.f)) * ii * uf4[j];
            }
        }
        lru_scan16<D>(a, b);
#pragma unroll
        for (int j = 0; j < 4; ++j) {
            float h = carry[j];
#pragma unroll
            for (int mi = 0; mi < LMT; ++mi) {
                const int m = (D == 0) ? mi : LMT - 1 - mi;
                const float hv = a[m][j] * h + b[m][j];
                b[m][j] = hv;
                h = (D == 0) ? dppf<0x15F>(0.f, hv) : dppf<0x150>(0.f, hv);
            }
            carry[j] = h;
        }
#pragma unroll
        for (int m = 0; m < LMT; ++m) *(LAS u32x2*)(lds + LC_HB + (m * 16 + l15) * LC_ROW + chb * 2) = mk2(pk2(b[m][0], b[m][1]), pk2(b[m][2], b[m][3]));
        __syncthreads();
#pragma unroll
        for (int i = 0; i < 2; ++i) {
            const int r = t + 64 * i;
            bf16_t* dst = (bf16_t*)((char*)obase + (unsigned)(((pb + r) * 1024 + c8 * 16) * 2));
            *(u32x4*)dst = *(LAS u32x4*)(lds + LC_HB + r * LC_ROW + c8 * 32); *(u32x4*)(dst + 8) = *(LAS u32x4*)(lds + LC_HB + r * LC_ROW + c8 * 32 + 16);
        }
    }
}
__device__ __forceinline__ void lru_chain_unit(CP p, int L, LAS unsigned char* lds, int bl, int hb, int d) {
    if (d == 0) lru_chain_dir<0>(p, L, lds, bl, hb); else lru_chain_dir<1>(p, L, lds, bl, hb);
}
__device__ __forceinline__ void phase_lrufinish(CP p, int L, int bid, int nb) {
    const int tid = ltid();
    const int nv = (L == 0) ? p->G * SALL : p->G * SEQ;
    const long total = (long)nv * 128, stride = (long)nb * NTHREADS;
    for (long e0 = (long)bid * NTHREADS + tid; e0 < total; e0 += 2 * stride) {
        u32x4 hf[2], hb[2], ga[2]; size_t off[2]; bool ok[2];
#pragma unroll
        for (int k = 0; k < 2; ++k) {
            const long e = e0 + k * stride; ok[k] = e < total;
            const int i = (int)((ok[k] ? e : e0) >> 7), c = (int)((ok[k] ? e : e0) & 127) * 8;
            const int r = (L == 0) ? i : ((i >> 11) * SALL + CTXL + (i & 2047));
            off[k] = (size_t)r * 1024 + c;
            hf[k] = *(const u32x4*)(p->YA + off[k]); hb[k] = *(const u32x4*)(p->HB2 + off[k]); ga[k] = *(const u32x4*)(p->P + (size_t)r * PWID + PC_GA + c);
        }
#pragma unroll
        for (int k = 0; k < 2; ++k) {
            if (!ok[k]) continue;
            u32x4 o;
            o.x = pk2(gelu_tanh(lo_bf(ga[k].x)) * (lo_bf(hf[k].x) + lo_bf(hb[k].x)), gelu_tanh(hi_bf(ga[k].x)) * (hi_bf(hf[k].x) + hi_bf(hb[k].x)));
            o.y = pk2(gelu_tanh(lo_bf(ga[k].y)) * (lo_bf(hf[k].y) + lo_bf(hb[k].y)), gelu_tanh(hi_bf(ga[k].y)) * (hi_bf(hf[k].y) + hi_bf(hb[k].y)));
            o.z = pk2(gelu_tanh(lo_bf(ga[k].z)) * (lo_bf(hf[k].z) + lo_bf(hb[k].z)), gelu_tanh(hi_bf(ga[k].z)) * (hi_bf(hf[k].z) + hi_bf(hb[k].z)));
            o.w = pk2(gelu_tanh(lo_bf(ga[k].w)) * (lo_bf(hf[k].w) + lo_bf(hb[k].w)), gelu_tanh(hi_bf(ga[k].w)) * (hi_bf(hf[k].w) + hi_bf(hb[k].w)));
            *(u32x4*)(p->YA + off[k]) = o;
        }
    }
}

__device__ __forceinline__ int next_unit(unsigned* ctr, LAS unsigned char* lds) {
    LAS int* slot = (LAS int*)(lds + LDS_BYTES - 32);
    __syncthreads();
    if (ltid() == 0) *slot = (int)__hip_atomic_fetch_add(ctr, 1u, __ATOMIC_RELAXED, __HIP_MEMORY_SCOPE_AGENT);
    __syncthreads();
    return __builtin_amdgcn_readfirstlane(*slot);
}
__device__ __forceinline__ void phase_probe_at(CP p, int L, LAS unsigned char* lds, int bid, int nb) {
    const int nqt = (L == 0) ? 9 : 8, nat = p->G * 8 * nqt;
    for (int u = bid; u < nat; u += nb) { const int qt = u % nqt, bh = u / nqt; attn_unit2(p, L, lds, bh >> 3, bh & 7, qt); }
}
__device__ __forceinline__ void phase_probe_lru(CP p, int L, LAS unsigned char* lds, int bid, int nb) {
    for (int v = bid; v < p->G * 16; v += nb) lru_chain_unit(p, L, lds, v >> 4, (v >> 1) & 7, v & 1);
}
__device__ __forceinline__ void phase_probe_ml(CP p, int L, LAS unsigned char* lds, int bid, int nb) {
    for (int u = bid; u < p->G * 8; u += nb) mlstm_unit(p, L, lds, u >> 3, (u >> 1) & 3, u & 1);
}
__device__ __forceinline__ void phase_mix_dyn(CP p, int L, int grp, LAS unsigned char* lds, int cofs = 0) {
    unsigned* ctr = (unsigned*)p->ecnt + 128 + (L * 8 + grp) * 4 + cofs;
    const int nml = p->G * 8, nqt = (L == 0) ? 9 : 8, nat = p->G * 8 * nqt, nlr = p->G * 16;
    int u = next_unit(ctr, lds);
    while (u < nml) { mlstm_unit(p, L, lds, u >> 3, (u >> 1) & 3, u & 1); u = next_unit(ctr, lds); }
    while (u < nml + nlr) { const int v = u - nml; lru_chain_unit(p, L, lds, v >> 4, (v >> 1) & 7, v & 1); u = next_unit(ctr, lds); }
    while (u < nml + nlr + nat) { const int v = u - nml - nlr; const int nlat = p->G * 64; const int qt = (v < nlat) ? (v & 7) : 8, bh = (v < nlat) ? (v >> 3) : (v - nlat);
        attn_unit2(p, L, lds, bh >> 3, bh & 7, qt); u = next_unit(ctr, lds); }
}
__device__ __forceinline__ int vidx_to_r(int L, int i) { return L == 0 ? i : ((i >> 11) * SALL + CTXL + (i & 2047)); }
__device__ __forceinline__ float* xrow_ptr(CP p, int grp, int r, int L, const float*& md) {
    const int bl = r / SALL, pos = r - bl * SALL, b = grp * p->G + bl;
    if (pos < CTXL) { md = p->mods_c + (size_t)L * 6144; return p->XC1 + ((size_t)b * CTXL + pos) * 1024; }
    md = p->mods_l + ((size_t)L * 32 + b) * 6144; return p->out + ((size_t)b * SEQ + (pos - CTXL)) * 1024;
}
constexpr int RCH = 32, RPICK = RCH * 6;
constexpr int RT_H = 0, RT_HROW = 1028, RT_PART = 16 * RT_HROW * 4, RT_PICK = RT_PART + 8 * 16 * 64 * 4, RT_END = RT_PICK + RPICK * 12;
__device__ __forceinline__ void split_bf(float a0, float a1, unsigned& hi, unsigned& lo) { hi = pk2(a0, a1); lo = pk2(a0 - lo_bf(hi), a1 - hi_bf(hi)); }
__device__ __forceinline__ void phase_route1(CP p, int L, int grp, LAS unsigned char* lds, int bid, int nb) {
    const int tid = ltid(), lane = tid & 63, wid = tid >> 6, q4 = lane >> 4, l15 = lane & 15;
    LAS float* hs = (LAS float*)(lds + RT_H);
    LAS float* part = (LAS float*)(lds + RT_PART);
    LAS int* pick_e = (LAS int*)(lds + RT_PICK);
    LAS float* pick_w = (LAS float*)(pick_e + RPICK);
    LAS int* pick_r = (LAS int*)(pick_e + 2 * RPICK);
    const float* g2 = p->norm2_g + L * 1024;
    const float brv = p->b_router[L * 64 + lane];
    const float* wr = p->w_router + (size_t)L * 1024 * 64;
    const int nchunks = p->G * SALL / RCH;
    bf16x8 whi[4][4], wlo[4][4];
#pragma unroll
    for (int ks = 0; ks < 4; ++ks)
#pragma unroll
        for (int n = 0; n < 4; ++n) { unsigned h[4], l[4];
#pragma unroll
            for (int jj = 0; jj < 4; ++jj) { const float* wp = wr + (size_t)(wid * 128 + ks * 32 + q4 * 8 + 2 * jj) * 64 + n * 16 + l15; split_bf(wp[0], wp[64], h[jj], l[jj]); }
            whi[ks][n] = __builtin_bit_cast(bf16x8, mk4(h[0], h[1], h[2], h[3])); wlo[ks][n] = __builtin_bit_cast(bf16x8, mk4(l[0], l[1], l[2], l[3])); }
    const int cpb = SALL / RCH, cctx = CTXL / RCH;
#define RT_NEXT_VALID(cv) do { while ((cv) < nchunks && L == 1 && ((cv) % cpb) < cctx) { if (tid < 64) p->CC[(cv) * 64 + tid] = 0; (cv) += nb; } } while (0)
#define RT_LOAD(rbase) do { _Pragma("unroll") for (int rr = 0; rr < 2; ++rr) { const float* md_; const float* src_ = xrow_ptr(p, grp, (rbase) + rr, L, md_); \
        _Pragma("unroll") for (int i = 0; i < 4; ++i) v[rr][i] = *(const float4*)(src_ + i * 256 + lane * 4); } } while (0)
    int chunk = bid; RT_NEXT_VALID(chunk);
    float4 v[2][4];
    if (chunk < nchunks) RT_LOAD(chunk * RCH + wid * 2);
    while (chunk < nchunks) {
        int nchunk = chunk + nb; RT_NEXT_VALID(nchunk);
#pragma nounroll
        for (int sub = 0; sub < RCH / 16; ++sub) {
            const int r0 = chunk * RCH + sub * 16;
            __syncthreads();
            {
                float ss[2] = {0.f, 0.f};
#pragma unroll
                for (int rr = 0; rr < 2; ++rr)
#pragma unroll
                    for (int i = 0; i < 4; ++i) ss[rr] += v[rr][i].x * v[rr][i].x + v[rr][i].y * v[rr][i].y + v[rr][i].z * v[rr][i].z + v[rr][i].w * v[rr][i].w;
#pragma unroll
                for (int o = 32; o >= 1; o >>= 1) { ss[0] += sx_(ss[0], o); ss[1] += sx_(ss[1], o); }
#pragma unroll
                for (int rr = 0; rr < 2; ++rr) {
                    const int tl = wid * 2 + rr, r = r0 + tl;
                    const float* md; (void)xrow_ptr(p, grp, r, L, md);
                    const float rstd = rsqrtf(ss[rr] * (1.0f / 1024.0f) + 1e-6f);
#pragma unroll
                    for (int i = 0; i < 4; ++i) {
                        const int col = i * 256 + lane * 4;
                        const float4 g = *(const float4*)(g2 + col), sh = *(const float4*)(md + 3072 + col), sc = *(const float4*)(md + 4096 + col);
                        const float o0 = v[rr][i].x * rstd * g.x * (1.f + sc.x) + sh.x, o1 = v[rr][i].y * rstd * g.y * (1.f + sc.y) + sh.y;
                        const float o2 = v[rr][i].z * rstd * g.z * (1.f + sc.z) + sh.z, o3 = v[rr][i].w * rstd * g.w * (1.f + sc.w) + sh.w;
                        { int w8 = 0; w8 = __builtin_amdgcn_cvt_pk_fp8_f32(o0, o1, w8, false); w8 = __builtin_amdgcn_cvt_pk_fp8_f32(o2, o3, w8, true); *(unsigned*)((unsigned char*)p->H2 + (size_t)r * 1024 + col) = (unsigned)w8; }
                        *(LAS f32x4*)(hs + tl * RT_HROW + col) = (f32x4){o0, o1, o2, o3};
                    }
                }
                if (sub == 0) RT_LOAD(r0 + 16 + wid * 2); else if (nchunk < nchunks) RT_LOAD(nchunk * RCH + wid * 2);
            }
            __syncthreads();
            {
                f32x4 lg[4];
#pragma unroll
                for (int n = 0; n < 4; ++n) lg[n] = (f32x4){0.f, 0.f, 0.f, 0.f};
#pragma unroll
                for (int ks = 0; ks < 4; ++ks) {
                    const LAS float* hp = hs + l15 * RT_HROW + wid * 128 + ks * 32 + q4 * 8;
                    const f32x4 x0 = *(const LAS f32x4*)hp, x1 = *(const LAS f32x4*)(hp + 4);
                    unsigned h[4], l[4];
                    split_bf(x0[0], x0[1], h[0], l[0]); split_bf(x0[2], x0[3], h[1], l[1]); split_bf(x1[0], x1[1], h[2], l[2]); split_bf(x1[2], x1[3], h[3], l[3]);
                    const bf16x8 ah = __builtin_bit_cast(bf16x8, mk4(h[0], h[1], h[2], h[3])), al = __builtin_bit_cast(bf16x8, mk4(l[0], l[1], l[2], l[3]));
#pragma unroll
                    for (int n = 0; n < 4; ++n) {
                        lg[n] = __builtin_amdgcn_mfma_f32_16x16x32_bf16(al, whi[ks][n], lg[n], 0, 0, 0);
                        lg[n] = __builtin_amdgcn_mfma_f32_16x16x32_bf16(ah, wlo[ks][n], lg[n], 0, 0, 0);
                        lg[n] = __builtin_amdgcn_mfma_f32_16x16x32_bf16(ah, whi[ks][n], lg[n], 0, 0, 0);
                    }
                }
#pragma unroll
                for (int n = 0; n < 4; ++n)
#pragma unroll
                    for (int r = 0; r < 4; ++r) part[(wid * 16 + 4 * q4 + r) * 64 + n * 16 + l15] = lg[n][r];
            }
            __syncthreads();
            {
                float score[2], sel[2], ssum[2] = {0.f, 0.f}; int myrank[2] = {-1, -1};
#pragma unroll
                for (int rr = 0; rr < 2; ++rr) {
                    const int tl = wid * 2 + rr; float lgt = 0.f;
#pragma unroll
                    for (int w8 = 0; w8 < 8; ++w8) lgt += part[(w8 * 16 + tl) * 64 + lane];
                    score[rr] = 1.0f / (1.0f + expf(-lgt)); sel[rr] = score[rr] + brv;
                }
#pragma unroll
                for (int k = 0; k < TOPK; ++k) {
#pragma unroll
                    for (int rr = 0; rr < 2; ++rr) {
                        float mv = sel[rr];
                        mv = fmaxf(mv, dppf<0x111>(-3.0e38f, mv)); mv = fmaxf(mv, dppf<0x112>(-3.0e38f, mv)); mv = fmaxf(mv, dppf<0x114>(-3.0e38f, mv)); mv = fmaxf(mv, dppf<0x118>(-3.0e38f, mv));
                        const float m0 = __builtin_bit_cast(float, __builtin_amdgcn_readlane(__builtin_bit_cast(int, mv), 15)), m1 = __builtin_bit_cast(float, __builtin_amdgcn_readlane(__builtin_bit_cast(int, mv), 31));
                        const float m2 = __builtin_bit_cast(float, __builtin_amdgcn_readlane(__builtin_bit_cast(int, mv), 47)), m3 = __builtin_bit_cast(float, __builtin_amdgcn_readlane(__builtin_bit_cast(int, mv), 63));
                        const float wm = fmaxf(fmaxf(m0, m1), fmaxf(m2, m3));
                        const unsigned long long bal = __ballot(sel[rr] == wm);
                        const int win = __ffsll((long long)bal) - 1;
                        ssum[rr] += __builtin_bit_cast(float, __builtin_amdgcn_readlane(__builtin_bit_cast(int, score[rr]), win));
                        if (lane == win) { myrank[rr] = k; sel[rr] = -1e30f; }
                    }
                }
#pragma unroll
                for (int rr = 0; rr < 2; ++rr)
                    if (myrank[rr] >= 0) { const int slot = (sub * 16 + wid * 2 + rr) * 6 + myrank[rr]; pick_e[slot] = lane; pick_w[slot] = score[rr] / ssum[rr] * 2.5f; }
            }
        }
        __syncthreads();
        {
            const int lane = ltid() & 63;
            const int e0 = pick_e[lane], e1 = pick_e[64 + lane], e2 = pick_e[128 + lane];
            int rk0 = 0, rk1 = 0, rk2 = 0, mycnt = 0;
#pragma unroll
            for (int x = 0; x < 8; ++x) {
                const int ex = wid * 8 + x;
                const unsigned long long m0 = __ballot(e0 == ex), m1 = __ballot(e1 == ex), m2 = __ballot(e2 == ex);
                const int c0 = __builtin_popcountll(m0), c1 = __builtin_popcountll(m1), c2 = __builtin_popcountll(m2);
                if (e0 == ex) rk0 = __builtin_amdgcn_mbcnt_hi((unsigned)(m0 >> 32), __builtin_amdgcn_mbcnt_lo((unsigned)m0, 0));
                if (e1 == ex) rk1 = c0 + __builtin_amdgcn_mbcnt_hi((unsigned)(m1 >> 32), __builtin_amdgcn_mbcnt_lo((unsigned)m1, 0));
                if (e2 == ex) rk2 = c0 + c1 + __builtin_amdgcn_mbcnt_hi((unsigned)(m2 >> 32), __builtin_amdgcn_mbcnt_lo((unsigned)m2, 0));
                if (lane == x) mycnt = c0 + c1 + c2;
            }
            if ((e0 >> 3) == wid) pick_r[lane] = rk0;
            if ((e1 >> 3) == wid) pick_r[64 + lane] = rk1;
            if ((e2 >> 3) == wid) pick_r[128 + lane] = rk2;
            if (lane < 8) p->CC[chunk * 64 + wid * 8 + lane] = mycnt;
        }
        __syncthreads();
        { const int s2 = ltid(); if (s2 < RPICK) { p->PE[(size_t)chunk * RPICK + s2] = pick_e[s2] | (pick_r[s2] << 8); p->PW[(size_t)chunk * RPICK + s2] = pick_w[s2]; } }
        chunk = nchunk;
    }
#undef RT_NEXT_VALID
#undef RT_LOAD
}
__device__ __forceinline__ void phase_route2(CP p, int L, LAS unsigned char* lds, int bid, int nb) {
    const int tid = ltid();
    LAS int* basel = (LAS int*)lds; LAS int* totl = basel + 256; LAS int* tabl = totl + 64; LAS int* pb = tabl + 128; LAS int* pt = pb + 4 * 512;
    const int nchunks = p->G * SALL / RCH;
    const int e = tid & 63, part = tid >> 6, per = (nchunks + 7) >> 3;
    __syncthreads();
    {
        int t = 0, b0 = 0, b1 = 0, b2 = 0, b3 = 0;
        const int k0 = bid, k1 = bid + nb, k2 = bid + 2 * nb, k3 = bid + 3 * nb;
        const int c0 = part * per, c1 = (c0 + per < nchunks) ? c0 + per : nchunks;
#pragma unroll 12
        for (int c = c0; c < c1; ++c) { const int v = p->CC[c * 64 + e]; t += v; b0 += (c < k0) ? v : 0; b1 += (c < k1) ? v : 0; b2 += (c < k2) ? v : 0; b3 += (c < k3) ? v : 0; }
        pt[part * 64 + e] = t; pb[part * 64 + e] = b0; pb[512 + part * 64 + e] = b1; pb[1024 + part * 64 + e] = b2; pb[1536 + part * 64 + e] = b3;
    }
    __syncthreads();
    if (tid < 64) {
        int t = 0, b[4] = {0, 0, 0, 0};
#pragma unroll
        for (int q = 0; q < 8; ++q) { t += pt[q * 64 + tid];
#pragma unroll
            for (int k = 0; k < 4; ++k) b[k] += pb[k * 512 + q * 64 + tid]; }
        totl[tid] = t;
#pragma unroll
        for (int k = 0; k < 4; ++k) basel[k * 64 + tid] = b[k];
        if (bid == 0) p->ecnt[tid] = t;
    }
    __syncthreads();
    if (tid == 0) { int acc = 0; for (int x = 0; x < 64; ++x) { tabl[x] = acc; acc += (totl[x] + 255) >> 8; } tabl[64] = acc; }
    __syncthreads();
    if (bid == 0) {
        const int dummy = (L == 0) ? 0 : CTXL;
        for (int x = tid; x < 64 * 256; x += NTHREADS) { const int ee = x >> 8, i = totl[ee] + (x & 255); if (i < (((totl[ee] + 255) >> 8) << 8)) { p->LIST[(size_t)tabl[ee] * 256 + i] = dummy; p->LISTW[(size_t)tabl[ee] * 256 + i] = 0.f; } }
    }
    {
        const int nv = (L == 0) ? p->G * SALL : p->G * SEQ; int* idl = p->LIST + (size_t)tabl[64] * 256;
        for (int i = bid * NTHREADS + tid; i < nv; i += nb * NTHREADS) idl[i] = vidx_to_r(L, i);
    }
    int kq = 0;
    for (int chunk = bid; chunk < nchunks; chunk += nb, ++kq) {
        if (L == 1 && (chunk % (SALL / RCH)) < (CTXL / RCH)) continue;
        for (int s2 = tid; s2 < RPICK; s2 += NTHREADS) {
            const int pe = p->PE[(size_t)chunk * RPICK + s2], ee = pe & 255, lr = pe >> 8;
            const int r = chunk * RCH + s2 / 6, pos = tabl[ee] * 256 + basel[kq * 64 + ee] + lr;
            p->LIST[pos] = r; p->LISTW[pos] = p->PW[(size_t)chunk * RPICK + s2];
            p->POS[(size_t)chunk * RPICK + s2] = pos;
        }
    }
}

constexpr int MOE_TAB = 131072;
__device__ __forceinline__ int moe_nshared(CP p, int L) { return L == 0 ? p->G * SALL : p->G * SEQ; }
__device__ __forceinline__ int moe_find(LAS int* tab, int tile) { int e = 0; for (int s = 64; s >= 1; s >>= 1) if (e + s <= 64 && tab[e + s] <= tile) e += s; return e; }
__device__ __forceinline__ void moe_table8(CP p, int L, LAS unsigned char* lds) {
    LAS int* tab = (LAS int*)(lds + MOE_TAB);
    __syncthreads();
    if (ltid() == 0) {
        int acc = 0;
        for (int e = 0; e < 65; ++e) { tab[e] = acc; const int c = (e < 64) ? p->ecnt[e] : moe_nshared(p, L); acc += (c + 255) >> 8; }
        tab[65] = acc;
    }
    __syncthreads();
}
__device__ __forceinline__ void phase_moe_combine(CP p, int L, int grp, LAS unsigned char* lds, int bid, int nb) {
    const int lane = ltid() & 63, wid = ltid() >> 6;
    moe_table8(p, L, lds);
    LAS int* tab = (LAS int*)(lds + MOE_TAB);
    const int nv = moe_nshared(p, L);
    const size_t sbase = (size_t)tab[64] * 256;
    const unsigned char* D8 = (const unsigned char*)p->DBUF;
    for (int i = bid * 8 + wid; i < nv; i += nb * 8) {
        const int r = vidx_to_r(L, i);
        const float* md; float* xr = xrow_ptr(p, grp, r, L, md);
        float a[16];
        u32x4 dv[7];
        int pos6[6];
#pragma unroll
        for (int k = 0; k < 6; ++k) pos6[k] = p->POS[(size_t)r * 6 + k];
        dv[0] = *(const u32x4*)(D8 + (sbase + i) * 1024 + lane * 16);
        f32x4 xv4[4], g4[4];
#pragma unroll
        for (int q = 0; q < 4; ++q) { xv4[q] = *(const f32x4*)(xr + lane * 16 + q * 4); g4[q] = *(const f32x4*)(md + 5120 + lane * 16 + q * 4); }
#pragma unroll
        for (int k = 0; k < 6; ++k) dv[k + 1] = *(const u32x4*)(D8 + (size_t)pos6[k] * 1024 + lane * 16);
#pragma unroll
        for (int q = 0; q < 16; ++q) a[q] = 0.f;
#pragma unroll
        for (int k = 0; k < 7; ++k)
#pragma unroll
            for (int w = 0; w < 4; ++w) {
                const f32x2 lo = __builtin_amdgcn_cvt_pk_f32_fp8((int)dv[k][w], false), hi = __builtin_amdgcn_cvt_pk_f32_fp8((int)dv[k][w], true);
                a[4 * w] += lo[0]; a[4 * w + 1] += lo[1]; a[4 * w + 2] += hi[0]; a[4 * w + 3] += hi[1];
            }
#pragma unroll
        for (int q = 0; q < 4; ++q) {
            const int col = lane * 16 + q * 4;
            const f32x4 g = g4[q];
            f32x4 xv = xv4[q];
            xv[0] += g[0] * a[4 * q] * D_ISCALE; xv[1] += g[1] * a[4 * q + 1] * D_ISCALE; xv[2] += g[2] * a[4 * q + 2] * D_ISCALE; xv[3] += g[3] * a[4 * q + 3] * D_ISCALE;
            *(f32x4*)(xr + col) = xv;
        }
    }
}

__device__ __forceinline__ int valid_tile(int L, int pmv) { return L == 0 ? pmv : ((pmv >> 3) * 9 + 1 + (pmv & 7)); }
struct SchedMerge { const char *Y, *B; size_t ystride; int nMv, L, G, c;
    __device__ __forceinline__ bool next(int i, pg8::Unit& u) const { int pmv, pn; if (!pg8::static_tile(i, G, c, nMv, 12, pmv, pn)) return false; const int pm = valid_tile(L, pmv), j = pn >> 2;
        u.pm = pm; u.pn = pn; u.tag = 0; u.rows = nullptr; u.a = Y + (size_t)j * ystride + (size_t)pm * 256 * 1024 * 2; u.b = B + (size_t)pn * 256 * 1024 * 2; return true; } };
struct SchedMerge8 { const char *YB8, *YC8, *B; int nMv, L, G, c;
    __device__ __forceinline__ bool next(int i, pg8::Unit& u) const { int pmv, q; if (!pg8::static_tile(i, G, c, nMv, 8, pmv, q)) return false; const int pm = valid_tile(L, pmv), pn = 4 + q, j = pn >> 2;
        u.pm = pm; u.pn = pn; u.tag = 0; u.rows = nullptr; u.a = (j == 1 ? YB8 : YC8) + (size_t)pm * 256 * 1024; u.b = B + (size_t)j * 1024 * 1024 * 2 + (size_t)(pn & 3) * 256 * 1024; return true; } };
struct SchedMerge0 { const char *Y, *B; int nMv, L, G, c;
    __device__ __forceinline__ bool next(int i, pg8::Unit& u) const { int pmv, pn; if (!pg8::static_tile(i, G, c, nMv, 4, pmv, pn)) return false; const int pm = valid_tile(L, pmv);
        u.pm = pm; u.pn = pn; u.tag = 0; u.rows = nullptr; u.a = Y + (size_t)pm * 256 * 1024 * 2; u.b = B + (size_t)pn * 256 * 1024 * 2; return true; } };
struct EpiBf16RowsS { static constexpr bool PERM = true; bf16_t* O; int ldo; float sc;
    __device__ __forceinline__ void operator()(const f32x4 (&acc)[2][2][4][2], const pg8::Unit& u, int wr, int wc, int fr, int fq) const {
        const size_t row0 = (size_t)u.pm * 256 + wr * 64 + fr;
#pragma unroll
        for (int ai = 0; ai < 2; ++ai)
#pragma unroll
            for (int m = 0; m < 4; ++m) { bf16_t* rowp = O + (row0 + ai * 128 + m * 16) * ldo + u.pn * 256 + wc * 32 + 8 * fq;
#pragma unroll
                for (int bj = 0; bj < 2; ++bj) { const f32x4 v0 = acc[ai][bj][m][0] * sc, v1 = acc[ai][bj][m][1] * sc;
                    *(u32x4*)(rowp + bj * 128) = mk4(pk2(v0[0], v0[1]), pk2(v0[2], v0[3]), pk2(v1[0], v1[1]), pk2(v1[2], v1[3])); } }
    } };
struct EpiBf16Rows { static constexpr bool PERM = true; bf16_t* O; int ldo;
    __device__ __forceinline__ void operator()(const f32x4 (&acc)[2][2][4][2], const pg8::Unit& u, int wr, int wc, int fr, int fq) const {
        const size_t row0 = (size_t)u.pm * 256 + wr * 64 + fr;
#pragma unroll
        for (int ai = 0; ai < 2; ++ai)
#pragma unroll
            for (int m = 0; m < 4; ++m) { bf16_t* rowp = O + (row0 + ai * 128 + m * 16) * ldo + u.pn * 256 + wc * 32 + 8 * fq;
#pragma unroll
                for (int bj = 0; bj < 2; ++bj) { const f32x4 v0 = acc[ai][bj][m][0], v1 = acc[ai][bj][m][1];
                    *(u32x4*)(rowp + bj * 128) = mk4(pk2(v0[0], v0[1]), pk2(v0[2], v0[3]), pk2(v1[0], v1[1]), pk2(v1[2], v1[3])); } }
    } };
template <int SCALED>
struct EpiFp8RowsT { static constexpr bool PERM = true; unsigned char* O; int ldo;
    __device__ __forceinline__ void operator()(const f32x4 (&acc)[2][2][4][2], const pg8::Unit& u, int wr, int wc, int fr, int fq) const {
        constexpr float SC = SCALED == 1 ? pg8::F8_WINV : (SCALED == 2 ? D_SCALE / (ACT_SC * DW_SC) : 1.0f);
        unsigned char* tb = O + ((size_t)u.pm * 256) * ldo + u.pn * 256;
        const unsigned lo0 = (unsigned)(wr * 64 + fr) * (unsigned)ldo + wc * 32 + 8 * fq;
#pragma unroll
        for (int ai = 0; ai < 2; ++ai)
#pragma unroll
            for (int m = 0; m < 4; ++m) { unsigned char* rowp = tb + (lo0 + (unsigned)(ai * 128 + m * 16) * (unsigned)ldo);
#pragma unroll
                for (int bj = 0; bj < 2; ++bj) { const f32x4 v0 = acc[ai][bj][m][0] * SC, v1 = acc[ai][bj][m][1] * SC;
                    int w0 = 0, w1 = 0;
                    w0 = __builtin_amdgcn_cvt_pk_fp8_f32(v0[0], v0[1], w0, false); w0 = __builtin_amdgcn_cvt_pk_fp8_f32(v0[2], v0[3], w0, true);
                    w1 = __builtin_amdgcn_cvt_pk_fp8_f32(v1[0], v1[1], w1, false); w1 = __builtin_amdgcn_cvt_pk_fp8_f32(v1[2], v1[3], w1, true);
                    *(u32x2*)(rowp + bj * 128) = mk2((unsigned)w0, (unsigned)w1); } }
    } };
typedef EpiFp8RowsT<0> EpiFp8Rows;
__device__ __forceinline__ void phase_merge8(CP p, int L, LAS unsigned char* lds, int bid, int nb) {
    if constexpr (MERGE_F8) {
        { SchedMerge8 S{(const char*)p->YB8, (const char*)p->YC, (const char*)p->bt_br, (L == 0 ? p->G * 9 : p->G * 8), L, nb, bid};
          EpiFp8RowsT<1> E{(unsigned char*)p->Z + 2048 - 4 * 256, 6144};
          pg8::gemm_phase<false, true>(lds, 512, S, E); }
        { SchedMerge0 S{(const char*)p->YA, (const char*)p->bt_br, (L == 0 ? p->G * 9 : p->G * 8), L, nb, nb - 1 - bid};
          EpiBf16Rows E{p->Z, 3072};
          pg8::gemm_phase<false, false>(lds, 1024, S, E); }
        return;
    }
    SchedMerge S{(const char*)p->YA, (const char*)p->bt_br, (size_t)((const char*)p->YB - (const char*)p->YA), (L == 0 ? p->G * 9 : p->G * 8), L, nb, bid};
    EpiBf16Rows E{p->Z, 3072};
    pg8::gemm_phase<false, false>(lds, 1024, S, E);
}
__device__ __forceinline__ void phase_gate(CP p, int L, int bid, int nb) {
    const int lane = ltid() & 63, wid = ltid() >> 6;
    const int nv = (L == 0) ? p->G * SALL : p->G * SEQ;
    for (int i = bid * 8 + wid; i < nv; i += nb * 8) {
        const int r = (L == 0) ? i : ((i >> 11) * SALL + CTXL + (i & 2047));
        const bf16_t* z = p->Z + (size_t)r * 3072; const unsigned char* g = p->GP8 + (size_t)r * 3072;
        u32x4 zv[2][3]; u32x2 gv[2][3];
#pragma unroll
        for (int q = 0; q < 2; ++q)
#pragma unroll
            for (int j = 0; j < 3; ++j) { const int col = q * 512 + lane * 8; gv[q][j] = *(const u32x2*)(g + j * 1024 + col);
                if (MERGE_F8 && j > 0) { const u32x2 t8 = *(const u32x2*)((const unsigned char*)z + 2048 + (j - 1) * 1024 + col); zv[q][j] = mk4(t8.x, t8.y, 0u, 0u); }
                else zv[q][j] = *(const u32x4*)(z + j * 1024 + col); }
#pragma unroll
        for (int q = 0; q < 2; ++q) {
            const int col = q * 512 + lane * 8;
            float a[8] = {0.f, 0.f, 0.f, 0.f, 0.f, 0.f, 0.f, 0.f};
#pragma unroll
            for (int j = 0; j < 3; ++j) {
                const f32x2 g0 = __builtin_amdgcn_cvt_pk_f32_fp8((int)gv[q][j].x, false), g1 = __builtin_amdgcn_cvt_pk_f32_fp8((int)gv[q][j].x, true), g2 = __builtin_amdgcn_cvt_pk_f32_fp8((int)gv[q][j].y, false), g3 = __builtin_amdgcn_cvt_pk_f32_fp8((int)gv[q][j].y, true);
                float zf[8];
                if (MERGE_F8 && j > 0) { const f32x2 z0 = __builtin_amdgcn_cvt_pk_f32_fp8((int)zv[q][j].x, false), z1 = __builtin_amdgcn_cvt_pk_f32_fp8((int)zv[q][j].x, true), z2 = __builtin_amdgcn_cvt_pk_f32_fp8((int)zv[q][j].y, false), z3 = __builtin_amdgcn_cvt_pk_f32_fp8((int)zv[q][j].y, true);
                    zf[0] = z0[0]; zf[1] = z0[1]; zf[2] = z1[0]; zf[3] = z1[1]; zf[4] = z2[0]; zf[5] = z2[1]; zf[6] = z3[0]; zf[7] = z3[1]; }
                else { zf[0] = lo_bf(zv[q][j].x); zf[1] = hi_bf(zv[q][j].x); zf[2] = lo_bf(zv[q][j].y); zf[3] = hi_bf(zv[q][j].y); zf[4] = lo_bf(zv[q][j].z); zf[5] = hi_bf(zv[q][j].z); zf[6] = lo_bf(zv[q][j].w); zf[7] = hi_bf(zv[q][j].w); }
                a[0] += sigmoidf_(g0[0]) * zf[0]; a[1] += sigmoidf_(g0[1]) * zf[1]; a[2] += sigmoidf_(g1[0]) * zf[2]; a[3] += sigmoidf_(g1[1]) * zf[3];
                a[4] += sigmoidf_(g2[0]) * zf[4]; a[5] += sigmoidf_(g2[1]) * zf[5]; a[6] += sigmoidf_(g3[0]) * zf[6]; a[7] += sigmoidf_(g3[1]) * zf[7];
            }
            *(u32x4*)(p->H + (size_t)r * 1024 + col) = mk4(pk2(a[0], a[1]), pk2(a[2], a[3]), pk2(a[4], a[5]), pk2(a[6], a[7]));
        }
    }
}
struct SchedOut { const char *A, *B; int nMv, L, G, c;
    __device__ __forceinline__ bool next(int i, pg8::Unit& u) const { int pmv, pn; if (!pg8::static_tile(i, G, c, nMv, 4, pmv, pn)) return false; const int pm = valid_tile(L, pmv);
        u.pm = pm; u.pn = pn; u.tag = 0; u.rows = nullptr; u.a = A + (size_t)pm * 256 * 1024 * 2; u.b = B + (size_t)pn * 256 * 1024 * 2; return true; } };
struct EpiOut { static constexpr bool PERM = false; CP p; int L, grp;
    __device__ __forceinline__ void operator()(const f32x4 (&acc)[2][2][4][2], const pg8::Unit& u, int wr, int wc, int fr, int fq) const {
        const int bl = u.pm / 9, mloc = u.pm - bl * 9, b = grp * p->G + bl;
        const bool isctx = mloc == 0;
        const float* md = isctx ? (p->mods_c + (size_t)L * 6144 + 2048) : (p->mods_l + ((size_t)L * 32 + b) * 6144 + 2048);
        const int col0 = u.pn * 256 + wc * 32 + 4 * fq;
#pragma unroll
        for (int ai = 0; ai < 2; ++ai)
#pragma unroll
            for (int m = 0; m < 4; ++m) {
                const int pos = mloc * 256 + ai * 128 + wr * 64 + m * 16 + fr;
                const float* src; float* dst;
                if (isctx) { src = p->ctx + ((size_t)b * CTXL + pos) * 1024; dst = p->XC1 + ((size_t)b * CTXL + pos) * 1024; }
                else { const size_t o = ((size_t)b * SEQ + pos - CTXL) * 1024; src = (L == 0 ? p->x : p->out) + o; dst = p->out + o; }
#pragma unroll
                for (int bj = 0; bj < 2; ++bj)
#pragma unroll
                    for (int n = 0; n < 2; ++n) { const int col = col0 + bj * 128 + n * 16; const f32x4 xv = *(const f32x4*)(src + col), g = *(const f32x4*)(md + col); *(f32x4*)(dst + col) = xv + g * acc[ai][bj][m][n]; }
            }
    } };
__device__ __forceinline__ void phase_outproj8(CP p, int L, int grp, LAS unsigned char* lds, int bid, int nb) {
    SchedOut S{(const char*)p->H, (const char*)p->bt_out, (L == 0 ? p->G * 9 : p->G * 8), L, nb, bid};
    EpiOut E{p, L, grp};
    pg8::gemm_phase<false, false>(lds, 1024, S, E);
}
struct SchedMoeUp { CP p; LAS int* tab; int L, G, c;
    __device__ __forceinline__ bool next(int i, pg8::Unit& u) const { const int x = i * G + c, tile = (x >> 4) * 8 + (x & 7), nt = (x >> 3) & 1; if (tile >= __builtin_amdgcn_readfirstlane(tab[65])) return false;
        const int e = __builtin_amdgcn_readfirstlane(moe_find(tab, tile));
        u.pm = tile; u.pn = nt; u.tag = e;
        u.rows = p->LIST + (size_t)tile * 256; u.a = (const char*)p->H2;
        u.b = (const char*)p->bt_eup + ((size_t)e * 512 + nt * 256) * 1024; return true; } };
struct EpiMoeUp { static constexpr bool PERM = true; bf16_t* ACT; const float* W;
    __device__ __forceinline__ void operator()(const f32x4 (&acc)[2][2][4][2], const pg8::Unit& u, int wr, int wc, int fr, int fq) const {
        const size_t pos0 = (size_t)u.pm * 256 + wr * 64 + fr;
#pragma unroll
        for (int ai = 0; ai < 2; ++ai)
#pragma unroll
            for (int m = 0; m < 4; ++m) { const size_t pos = pos0 + ai * 128 + m * 16; const float w = ((u.tag < 64) ? W[pos] : 1.0f) * pg8::F8_WINV;
                float v[8];
#pragma unroll
                for (int n = 0; n < 2; ++n)
#pragma unroll
                    for (int j = 0; j < 4; ++j) { const float g = acc[ai][0][m][n][j] * pg8::F8_WINV; v[n * 4 + j] = g * __builtin_amdgcn_rcpf(1.0f + __expf(-g)) * acc[ai][1][m][n][j] * w; }
                if (DOWN_F8) { int w0 = 0, w1 = 0;
                    w0 = __builtin_amdgcn_cvt_pk_fp8_f32(v[0] * ACT_SC, v[1] * ACT_SC, w0, false); w0 = __builtin_amdgcn_cvt_pk_fp8_f32(v[2] * ACT_SC, v[3] * ACT_SC, w0, true);
                    w1 = __builtin_amdgcn_cvt_pk_fp8_f32(v[4] * ACT_SC, v[5] * ACT_SC, w1, false); w1 = __builtin_amdgcn_cvt_pk_fp8_f32(v[6] * ACT_SC, v[7] * ACT_SC, w1, true);
                    *(u32x2*)((unsigned char*)ACT + pos * 256 + u.pn * 128 + wc * 32 + 8 * fq) = mk2((unsigned)w0, (unsigned)w1); }
                else *(u32x4*)(ACT + pos * 256 + u.pn * 128 + wc * 32 + 8 * fq) = mk4(pk2(v[0], v[1]), pk2(v[2], v[3]), pk2(v[4], v[5]), pk2(v[6], v[7])); }
    } };
__device__ __forceinline__ void phase_moe_up8(CP p, int L, LAS unsigned char* lds, int bid, int nb) {
    moe_table8(p, L, lds);
    SchedMoeUp S{p, (LAS int*)(lds + MOE_TAB), L, nb, bid};
    EpiMoeUp E{p->ACT, p->LISTW};
    pg8::gemm_phase<true, true>(lds, 512, S, E);
}
struct SchedMoeDown { CP p; LAS int* tab; int G, c;
    __device__ __forceinline__ bool next(int i, pg8::Unit& u) const { const int x = i * G + c, tile = (x >> 5) * 8 + (x & 7), nt = (x >> 3) & 3; if (tile >= __builtin_amdgcn_readfirstlane(tab[65])) return false;
        const int e = __builtin_amdgcn_readfirstlane(moe_find(tab, tile));
        u.pm = tile; u.pn = nt; u.tag = e; u.rows = nullptr; u.a = (const char*)p->ACT + (size_t)tile * 256 * 256 * (DOWN_F8 ? 1 : 2); u.b = (const char*)p->bt_edn + ((size_t)e * 1024 + nt * 256) * 256 * (DOWN_F8 ? 1 : 2); return true; } };
__device__ __forceinline__ void phase_moe_down8(CP p, int L, LAS unsigned char* lds, int bid, int nb) {
    moe_table8(p, L, lds);
    SchedMoeDown S{p, (LAS int*)(lds + MOE_TAB), nb, bid};
    if constexpr (DOWN_F8) { EpiFp8RowsT<2> E{(unsigned char*)p->DBUF, 1024}; pg8::gemm_phase<false, true>(lds, 128, S, E); return; }
    EpiFp8Rows E{(unsigned char*)p->DBUF, 1024};
    pg8::gemm_phase<false, false>(lds, 256, S, E);
}

extern __shared__ __attribute__((aligned(16))) unsigned char smem_raw[];
#define XB_TMO      128
#define XB_XCNT(j)  (256  + 64 * (j))
#define XB_XSUB(j)  (1280 + 64 * (j))
#define XB_XGEN(j)  (2304 + 64 * (j))
#define XB_TOP      3328
#define XB_TOPGEN   3392
#define XCD_BAR_WORDS 3456
#define XB_SPIN_CAP (1u << 18)

__device__ __forceinline__ unsigned xb_ld(unsigned* p)              { return __hip_atomic_load(p, __ATOMIC_RELAXED, __HIP_MEMORY_SCOPE_AGENT); }
__device__ __forceinline__ unsigned xb_add(unsigned* p, unsigned v) { return __hip_atomic_fetch_add(p, v, __ATOMIC_RELAXED, __HIP_MEMORY_SCOPE_AGENT); }
__device__ __forceinline__ unsigned xb_xcc_id() { return (unsigned)__builtin_amdgcn_s_getreg((3 << 11) | 20) & 0xFu; }
#define XB_SPIN(cond, bar) do { unsigned _sp = 0; while (cond) { __builtin_amdgcn_s_sleep(1); \
    if ((++_sp & 255u) == 0u) { if (xb_ld(&(bar)[XB_TMO])) break; if (_sp > XB_SPIN_CAP) { atomicAdd(&(bar)[XB_TMO], 1u); break; } } } } while (0)

struct XcdBarrier {
    unsigned* bar; unsigned x;
    volatile LAS unsigned* st;
};

__device__ __forceinline__ XcdBarrier xcd_barrier_post(unsigned* bar, volatile LAS unsigned* st) {
    XcdBarrier b; b.bar = bar; b.x = xb_xcc_id(); b.st = st;
    if (threadIdx.x == 0) (void)xb_add(&bar[XB_XCNT(b.x)], 1u);
    return b;
}
__device__ __forceinline__ void xcd_barrier_complete(unsigned* bar, unsigned x, unsigned& nloc, unsigned& nx) {
    const unsigned G = gridDim.x * gridDim.y * gridDim.z;
    unsigned sum, cnt, mine, sp = 0u;
    for (;;) {
        sum = 0u; cnt = 0u; mine = 0u;
#pragma unroll
        for (unsigned j = 0; j < 16; ++j) { const unsigned c = xb_ld(&bar[XB_XCNT(j)]); sum += c; cnt += (c > 0u) ? 1u : 0u; mine = (j == x) ? c : mine; }
        if (sum == G) break;
        __builtin_amdgcn_s_sleep(1);
        if ((++sp & 255u) == 0u) { if (xb_ld(&bar[XB_TMO])) break; if (sp > XB_SPIN_CAP) { atomicAdd(&bar[XB_TMO], 1u); break; } }
    }
    nloc = mine > 0u ? mine : 1u; nx = cnt > 0u ? cnt : 1u;
}

__device__ __forceinline__ void xcd_barrier(const XcdBarrier& b) {
    asm volatile("s_waitcnt vmcnt(0)" ::: "memory");
    __syncthreads();
    if (threadIdx.x == 0) {
        unsigned* bar = b.bar;
        __builtin_amdgcn_s_waitcnt(0);
        unsigned nloc = b.st[0], nx = b.st[1];
        if (nloc == 0u) { xcd_barrier_complete(bar, b.x, nloc, nx); b.st[0] = nloc; b.st[1] = nx; }
        const unsigned old = xb_add(&bar[XB_XSUB(b.x)], 1u);
        const unsigned gen = old / nloc;
        if (old + 1u == (gen + 1u) * nloc) {
            __builtin_amdgcn_fence(__ATOMIC_RELEASE, "agent");
            asm volatile("s_waitcnt vmcnt(0)" ::: "memory");
            const unsigned og = xb_add(&bar[XB_TOP], 1u);
            const unsigned tg = og / nx;
            if (og + 1u == (tg + 1u) * nx) xb_add(&bar[XB_TOPGEN], 1u);
            else XB_SPIN(xb_ld(&bar[XB_TOPGEN]) == tg, bar);
            __builtin_amdgcn_fence(__ATOMIC_ACQUIRE, "agent");
            xb_add(&bar[XB_XGEN(b.x)], 1u);
            asm volatile("s_waitcnt vmcnt(0)" ::: "memory");
        } else {
            XB_SPIN(xb_ld(&bar[XB_XGEN(b.x)]) == gen, bar);
            __builtin_amdgcn_fence(__ATOMIC_ACQUIRE, "agent");
            asm volatile("s_waitcnt vmcnt(0)" ::: "memory");
        }
    }
    __syncthreads();
}


constexpr int XB_LDS_OFF = LDS_BYTES - 16;
#if MK_CG_SYNC
#define GBAR() cooperative_groups::this_grid().sync()
#else
#define GBAR() do { XcdBarrier b2_ = bar; asm volatile("" : "+s"(b2_.bar), "+s"(b2_.x)); xcd_barrier(b2_); } while (0)
#endif
#define PH(call) do { CP p = pk; int bid = bid0, nb = nb0, L = L0v, grp = grp0v; LAS unsigned char* lds = lds0; asm volatile("" : "+s"(p), "+s"(bid), "+s"(nb), "+s"(lds), "+s"(L), "+s"(grp)); (void)L; (void)grp; (void)bid; (void)nb; (void)lds; __syncthreads(); call; } while (0)
__global__ void __launch_bounds__(NTHREADS, 2) k_fused(Params p_) {
    CP pk = (CP)__builtin_amdgcn_kernarg_segment_ptr();
    LAS unsigned char* lds0 = (LAS unsigned char*)smem_raw;
    asm volatile("s_setreg_imm32_b32 hwreg(HW_REG_MODE, 23, 1), 1");
    const int bid0 = blockIdx.x, nb0 = gridDim.x;
    if (ltid() == 0) *(LAS u32x4*)(lds0 + XB_LDS_OFF) = mk4(0u, 0u, 0u, 0u);
    __syncthreads();
    XcdBarrier bar = xcd_barrier_post(pk->bar, (volatile LAS unsigned*)(lds0 + XB_LDS_OFF));
    int L0v = 0, grp0v = 0;
    PH(phase_mods(p, lds, bid, nb));
    for (L0v = 0; L0v < 2; ++L0v) {
        PH(phase_convert(p, L, lds, bid, nb));
        GBAR();
        const int ngroups = pk->ngroups;
        for (grp0v = 0; grp0v < ngroups; ++grp0v) {
            PH(phase_prenorm(p, L, grp, bid, nb));          GBAR();
            if (PROBE & 128) { PH(phase_prenorm(p, L, grp, bid, nb)); GBAR(); }
            PH(phase_inproj8(p, lds, bid, nb));             GBAR();
            if (PROBE & 1) { PH(phase_inproj8(p, lds, bid, nb)); GBAR(); }
            PH(phase_daprep(p, L, grp, bid, nb));           GBAR();
            PH(phase_mix_dyn(p, L, grp, lds));              GBAR();
            if (PROBE & 2) { PH(phase_mix_dyn(p, L, grp, lds, 1)); GBAR(); }
            if (PROBE & 4) { PH(phase_probe_at(p, L, lds, bid, nb)); GBAR(); }
            if (PROBE & 8) { PH(phase_probe_lru(p, L, lds, bid, nb)); GBAR(); }
            if (PROBE & 512) { PH(phase_probe_ml(p, L, lds, bid, nb)); GBAR(); }
            PH(phase_lrufinish(p, L, bid, nb));
            PH(phase_mlfinish(p, L, bid, nb));              GBAR();
            PH(phase_merge8(p, L, lds, bid, nb));           GBAR();
            PH(phase_gate(p, L, bid, nb));                  GBAR();
            if (PROBE & 64) { PH(phase_merge8(p, L, lds, bid, nb)); GBAR(); PH(phase_gate(p, L, bid, nb)); GBAR(); }
            PH(phase_outproj8(p, L, grp, lds, bid, nb));    GBAR();
            PH(phase_route1(p, L, grp, lds, bid, nb));      GBAR();
            PH(phase_route2(p, L, lds, bid, nb));           GBAR();
            if (PROBE & 16384) { PH(phase_route1(p, L, grp, lds, bid, nb)); GBAR(); }
            if (PROBE & 32768) { PH(phase_route2(p, L, lds, bid, nb)); GBAR(); }
            if (PROBE & 16) { PH(phase_route1(p, L, grp, lds, bid, nb)); GBAR(); PH(phase_route2(p, L, lds, bid, nb)); GBAR(); }
            PH(phase_moe_up8(p, L, lds, bid, nb));          GBAR();
            PH(phase_moe_down8(p, L, lds, bid, nb));        GBAR();
            if (PROBE & 32) { PH(phase_moe_up8(p, L, lds, bid, nb)); GBAR(); PH(phase_moe_down8(p, L, lds, bid, nb)); GBAR(); }
            if (PROBE & 2048) { PH(phase_moe_up8(p, L, lds, bid, nb)); GBAR(); }
            if (PROBE & 4096) { PH(phase_moe_down8(p, L, lds, bid, nb)); GBAR(); }
            if (PROBE & 256) { for (int z = 0; z < 12; ++z) GBAR(); }
            PH(phase_moe_combine(p, L, grp, lds, bid, nb)); GBAR();
        }
    }
}

static inline size_t align_up(size_t v, size_t a) { return (v + a - 1) / a * a; }

extern "C" void kernel_launch(void* const* d_in, const int* in_sizes, int n_in, void* d_out, int out_size, void* d_ws, size_t ws_size, hipStream_t stream) {
    (void)in_sizes; (void)n_in; (void)out_size;
    Params p; memset(&p, 0, sizeof(p));
    const float** f = (const float**)&p;
    for (int i = 0; i < 32; ++i) f[i] = (const float*)d_in[i];
    p.out = (float*)d_out;
    unsigned char* ws = (unsigned char*)d_ws;
    int G = 8;
    for (;;) {
        size_t o = 0;
        auto take = [&](size_t bytes) { size_t r = o; o = align_up(o + bytes, 256); return r; };
        const size_t RG = (size_t)G * SALL;
        const size_t o_bar = take(16384), o_ecnt = take(1024), o_lam = take(256), o_modsl = take((size_t)2 * 32 * 6144 * 4), o_modsc = take((size_t)2 * 6144 * 4), o_rope = take((size_t)2048 * 32 * 2 * 4);
        const size_t o_btin = take((size_t)BTIN_ROWS * 1024 * 2), o_btbr = take((size_t)3 * 1024 * 1024 * 2), o_btout = take((size_t)1024 * 1024 * 2);
        const size_t o_bteup = take((size_t)65 * 512 * 1024), o_btin8 = take((size_t)BTIN_ROWS * 1024), o_h8 = take(RG * 1024), o_yb8 = take(RG * 1024), o_mo8 = take(RG * 1024), o_btedn = take((size_t)65 * 1024 * 256 * 2), o_btlru = take((size_t)16 * 256 * 128 * 2);
        const size_t o_h = take(RG * 1024 * 2);
        size_t pbytes = RG * PWID * 2; const size_t actrows = (size_t)7 * RG + 65 * 256; const size_t actbytes = align_up(actrows * 256 * 2, 256); if (pbytes < actbytes + actrows * 1024 * 2) pbytes = actbytes + actrows * 1024 * 2;
        const size_t o_p = take(pbytes), o_gates = take(RG * 16 * 4);
        const size_t o_ya = take(RG * 1024 * 2), o_yb = take(RG * 1024 * 2), o_yc = take(RG * 1024 * 2), o_hb = take(RG * 1024 * 2);
        const size_t o_lsum = take((size_t)G * 2 * 36 * 1024 * 8), o_xc1 = take((size_t)TCTX * 1024 * 4);
        const size_t o_z = take(RG * 3072 * 2), o_hb2 = take(RG * 1024 * 2), o_gp8 = take(RG * 3072);
        const size_t o_list = take(actrows * 4), o_listw = take(actrows * 4), o_cc = take(RG / 32 * 64 * 4), o_pe = take(RG * 6 * 4), o_pw = take(RG * 6 * 4), o_pos = take(RG * 6 * 4);
        if (o > ws_size && G > 1) { G >>= 1; continue; }
        p.bar = (unsigned*)(ws + o_bar); p.ecnt = (int*)(ws + o_ecnt); p.lamv = (float*)(ws + o_lam); p.mods_l = (float*)(ws + o_modsl); p.mods_c = (float*)(ws + o_modsc); p.rope = (float*)(ws + o_rope);
        p.bt_in = (bf16_t*)(ws + o_btin); p.bt_br = (bf16_t*)(ws + o_btbr); p.bt_out = (bf16_t*)(ws + o_btout); p.bt_eup = (bf16_t*)(ws + o_bteup); p.bt_edn = (bf16_t*)(ws + o_btedn); p.bt_lru = (bf16_t*)(ws + o_btlru);
        p.H8 = ws + o_h8; p.bt_in8 = ws + o_btin8; p.YB8 = ws + o_yb8; p.MO8 = ws + o_mo8;
        p.H = (bf16_t*)(ws + o_h); p.P = (bf16_t*)(ws + o_p); p.ACT = p.P; p.GATES = (float*)(ws + o_gates);
        p.YA = (bf16_t*)(ws + o_ya); p.YB = (bf16_t*)(ws + o_yb); p.HB = (bf16_t*)(ws + o_hb); p.YC = (bf16_t*)(ws + o_yc);
        p.LSUM = (float*)(ws + o_lsum); p.XC1 = (float*)(ws + o_xc1); p.H2 = p.YA; p.LIST = (int*)(ws + o_list); p.LISTW = (float*)(ws + o_listw);
        p.DBUF = (bf16_t*)(ws + o_p + actbytes); p.Z = (bf16_t*)(ws + o_z); p.HB2 = (bf16_t*)(ws + o_hb2); p.GP8 = ws + o_gp8; p.CC = (int*)(ws + o_cc); p.PE = (int*)(ws + o_pe); p.PW = (float*)(ws + o_pw); p.POS = (int*)(ws + o_pos);
        break;
    }
    p.G = G; p.ngroups = NBATCH / G;
#if MK_ONE_LAUNCH
    static int grid1 = 0;
    if (!grid1) {
        (void)hipFuncSetAttribute((const void*)k_fused, hipFuncAttributeMaxDynamicSharedMemorySize, LDS_BYTES);
        int dev = 0, cus = 0, per_cu = 0;
        (void)hipGetDevice(&dev);
        (void)hipDeviceGetAttribute(&cus, hipDeviceAttributeMultiprocessorCount, dev);
        (void)hipOccupancyMaxActiveBlocksPerMultiprocessor(&per_cu, k_fused, NTHREADS, LDS_BYTES);
        grid1 = (per_cu >= 1) ? cus : 0;
    }
    (void)hipMemsetAsync(p.bar, 0, 16384 + 1024, stream);
#if MK_CG_SYNC
    if (grid1 > 0) { void* args[] = {&p}; (void)hipLaunchCooperativeKernel((const void*)k_fused, dim3(grid1), dim3(NTHREADS), args, LDS_BYTES, stream); }
#else
    if (grid1 > 0) hipLaunchKernelGGL(k_fused, dim3(grid1), dim3(NTHREADS), LDS_BYTES, stream, p);
#endif
    return;
#endif
}
```

```cpp
#include <hip/hip_runtime.h>
#include <stdint.h>
#include <string.h>
#include <stdio.h>
#include <hip/hip_cooperative_groups.h>

#define LAS __attribute__((address_space(3)))
typedef unsigned short bf16_t;
typedef short bf16x8 __attribute__((ext_vector_type(8)));
typedef short s16x4 __attribute__((ext_vector_type(4)));
typedef float f32x4 __attribute__((ext_vector_type(4)));
typedef __bf16 bf2_t __attribute__((ext_vector_type(2)));
typedef unsigned u32x4 __attribute__((ext_vector_type(4)));
typedef unsigned u32x2 __attribute__((ext_vector_type(2)));
typedef float f32x2 __attribute__((ext_vector_type(2)));
__host__ __device__ __forceinline__ u32x4 mk4(unsigned a, unsigned b, unsigned c, unsigned d) { u32x4 r = {a, b, c, d}; return r; }
__host__ __device__ __forceinline__ u32x2 mk2(unsigned a, unsigned b) { u32x2 r = {a, b}; return r; }

#ifndef MK_ONE_LAUNCH
#define MK_ONE_LAUNCH 1
#define PROBE 0
#ifndef MK_CG_SYNC
#define MK_CG_SYNC 0
#endif
#endif

constexpr int DM = 1024, NBATCH = 32, SEQ = 2048, CTXL = 256, SALL = 2304;
constexpr int TLAT = NBATCH * SEQ, TCTX = NBATCH * CTXL, TALL = TLAT + TCTX;
constexpr int PWID = 11264;
constexpr int BTIN_ROWS = 11520;
constexpr int NT_IN = 45;
constexpr int PC_XA = 0, PC_GA = 1024, PC_MQ = 2048, PC_MK = 2560, PC_MV = 3072, PC_MO = 4096, PC_DQ = 5120, PC_DK = 6144, PC_DV = 7168, PC_GATE = 8192;
constexpr int NEXP = 64, TOPK = 6;
#ifndef IN_F8_MASK_V
#define IN_F8_MASK_V 0x1FFFFFFFFF01ull
#endif
constexpr unsigned long long IN_F8_MASK = IN_F8_MASK_V, IN_BF_MASK = ~IN_F8_MASK & ((1ull << 45) - 1);
constexpr int IN_N8 = __builtin_popcountll(IN_F8_MASK), IN_NBF = 45 - IN_N8;
constexpr bool DOWN_F8 = true;
constexpr float ACT_SC = 4.0f, DW_SC = 128.0f;
constexpr bool MERGE_F8 = true;
constexpr float D_SCALE = 4.0f, D_ISCALE = 1.0f / 4.0f;
constexpr int LDS_BYTES = 147456;
constexpr int NTHREADS = 512;

struct Params {
    const float *x, *c, *ctx, *c_ctx, *norm1_g, *norm2_g, *w_ada, *b_ada, *w_in, *conv_w, *conv_b, *lru_wa, *lru_ba, *lru_wx, *lru_bx, *lru_lam,
        *ml_gate_b, *ml_norm_g, *da_qnorm_g, *da_knorm_g, *da_lambda, *da_subln_g, *w_branch, *w_out, *w_router, *b_router, *w_e_gate, *w_e_up,
        *w_e_down, *w_s_gate, *w_s_up, *w_s_down;
    float* out;
    unsigned* bar; int* ecnt; float* lamv; float* mods_l; float* mods_c; float* rope;
    bf16_t *bt_in, *bt_br, *bt_out, *bt_eup, *bt_edn, *bt_lru;
    bf16_t *H, *P, *YA, *YB, *HB, *YC; float* GATES; float* LSUM; float* XC1;
    bf16_t* H2; int* LIST; float* LISTW; bf16_t* ACT; bf16_t* DBUF; bf16_t* HB2; unsigned char* GP8; int* CC; int* PE; float* PW; int* POS; bf16_t* Z;
    int G; int ngroups;
    unsigned char* MO8;
    unsigned char* YB8;
    unsigned char* H8; unsigned char* bt_in8;
};

typedef const Params __attribute__((address_space(4))) * CP;
__device__ __forceinline__ int ltid() { int t = threadIdx.x; asm volatile("" : "+v"(t)); return t; }
template <class T> __device__ __forceinline__ T* uni_ptr(T* q) {
    const unsigned long long v = (unsigned long long)q;
    return (T*)(((unsigned long long)(unsigned)__builtin_amdgcn_readfirstlane((int)(v >> 32)) << 32) | (unsigned)__builtin_amdgcn_readfirstlane((int)(unsigned)v));
}
__device__ __forceinline__ float bf2f(bf16_t b) { return __uint_as_float(((unsigned)b) << 16); }
__device__ __forceinline__ unsigned pk2(float lo, float hi) { bf2_t v = {(__bf16)lo, (__bf16)hi}; return __builtin_bit_cast(unsigned, v); }
__device__ __forceinline__ float lo_bf(unsigned u) { return __uint_as_float(u << 16); }
__device__ __forceinline__ float hi_bf(unsigned u) { return __uint_as_float(u & 0xffff0000u); }
__device__ __forceinline__ float sx_(float v, int mask) { return __builtin_bit_cast(float, __builtin_amdgcn_ds_bpermute(((ltid() & 63) ^ mask) << 2, __builtin_bit_cast(int, v))); }
__device__ __forceinline__ float sidx_(float v, int src) { return __builtin_bit_cast(float, __builtin_amdgcn_ds_bpermute(src << 2, __builtin_bit_cast(int, v))); }
__device__ __forceinline__ float sup_(float v, int o) { return __builtin_bit_cast(float, __builtin_amdgcn_ds_bpermute(((ltid() & 63) - o) << 2, __builtin_bit_cast(int, v))); }
template <int CTRL> __device__ __forceinline__ float dppf(float oldv, float v) { return __builtin_bit_cast(float, __builtin_amdgcn_update_dpp(__builtin_bit_cast(int, oldv), __builtin_bit_cast(int, v), CTRL, 0xf, 0xf, false)); }
__device__ __forceinline__ float wave_sum(float v) {
#pragma unroll
    for (int o = 32; o >= 1; o >>= 1) v += sx_(v, o);
    return v;
}
__device__ __forceinline__ float sigmoidf_(float x) { return __builtin_amdgcn_rcpf(1.0f + __expf(-x)); }
__device__ __forceinline__ float gelu_tanh(float x) {
    const float u = 0.7978845608028654f * (x + 0.044715f * x * x * x);
    const float e = __expf(2.0f * u);
    const float t = 1.0f - 2.0f * __builtin_amdgcn_rcpf(e + 1.0f);
    return 0.5f * x * (1.0f + t);
}

constexpr int GS_ROW = 144;
constexpr int GS_A = 128 * GS_ROW, GS_STAGE = 384 * GS_ROW;

template <class AF>
__device__ __forceinline__ void gemm_kloop(LAS unsigned char* lds, const AF& af, const bf16_t* __restrict__ Bt, int ldb, int K, f32x4 (&acc)[4][4]) {
    const int tid = ltid(), lane = tid & 63, wid = tid >> 6, wm = wid >> 2, wn = wid & 3;
    const int srow = tid >> 3, sch = tid & 7;
    const bf16_t* pa0 = af(srow) + sch * 8;
    const bf16_t* pa1 = af(srow + 64) + sch * 8;
    const bf16_t* pb0 = Bt + (size_t)(srow) * ldb + sch * 8;
    const bf16_t* pb1 = Bt + (size_t)(srow + 64) * ldb + sch * 8;
    const bf16_t* pb2 = Bt + (size_t)(srow + 128) * ldb + sch * 8;
    const bf16_t* pb3 = Bt + (size_t)(srow + 192) * ldb + sch * 8;
    const int wofs = srow * GS_ROW + sch * 16;
    const int nkt = K >> 6;
    u32x4 ra0 = *(const u32x4*)pa0, ra1 = *(const u32x4*)pa1, rb0 = *(const u32x4*)pb0, rb1 = *(const u32x4*)pb1, rb2 = *(const u32x4*)pb2, rb3 = *(const u32x4*)pb3;
    {
        LAS unsigned char* s = lds;
        *(LAS u32x4*)(s + wofs) = ra0; *(LAS u32x4*)(s + wofs + 64 * GS_ROW) = ra1;
        *(LAS u32x4*)(s + GS_A + wofs) = rb0; *(LAS u32x4*)(s + GS_A + wofs + 64 * GS_ROW) = rb1;
        *(LAS u32x4*)(s + GS_A + wofs + 128 * GS_ROW) = rb2; *(LAS u32x4*)(s + GS_A + wofs + 192 * GS_ROW) = rb3;
    }
    __syncthreads();
    const int aoff = (wm * 64 + (lane & 15)) * GS_ROW + (lane >> 4) * 16;
    const int boff = GS_A + (wn * 64 + (lane & 15)) * GS_ROW + (lane >> 4) * 16;
    for (int kt = 0; kt < nkt; ++kt) {
        LAS unsigned char* cur = lds + (kt & 1) * GS_STAGE;
        LAS unsigned char* nxt = lds + ((kt + 1) & 1) * GS_STAGE;
        const bool more = (kt + 1 < nkt);
        if (more) {
            const int ko = (kt + 1) * 64;
            ra0 = *(const u32x4*)(pa0 + ko); ra1 = *(const u32x4*)(pa1 + ko);
            rb0 = *(const u32x4*)(pb0 + ko); rb1 = *(const u32x4*)(pb1 + ko); rb2 = *(const u32x4*)(pb2 + ko); rb3 = *(const u32x4*)(pb3 + ko);
        }
#pragma unroll
        for (int ks = 0; ks < 2; ++ks) {
            bf16x8 a[4], b[4];
#pragma unroll
            for (int m = 0; m < 4; ++m) a[m] = *(LAS bf16x8*)(cur + aoff + m * 16 * GS_ROW + ks * 64);
#pragma unroll
            for (int n = 0; n < 4; ++n) b[n] = *(LAS bf16x8*)(cur + boff + n * 16 * GS_ROW + ks * 64);
#pragma unroll
            for (int m = 0; m < 4; ++m)
#pragma unroll
                for (int n = 0; n < 4; ++n) acc[m][n] = __builtin_amdgcn_mfma_f32_16x16x32_bf16(b[n], a[m], acc[m][n], 0, 0, 0);
        }
        if (more) {
            *(LAS u32x4*)(nxt + wofs) = ra0; *(LAS u32x4*)(nxt + wofs + 64 * GS_ROW) = ra1;
            *(LAS u32x4*)(nxt + GS_A + wofs) = rb0; *(LAS u32x4*)(nxt + GS_A + wofs + 64 * GS_ROW) = rb1;
            *(LAS u32x4*)(nxt + GS_A + wofs + 128 * GS_ROW) = rb2; *(LAS u32x4*)(nxt + GS_A + wofs + 192 * GS_ROW) = rb3;
        }
        __syncthreads();
    }
}
__device__ __forceinline__ void acc_zero(f32x4 (&acc)[4][4]) {
#pragma unroll
    for (int m = 0; m < 4; ++m)
#pragma unroll
        for (int n = 0; n < 4; ++n) acc[m][n] = (f32x4){0.f, 0.f, 0.f, 0.f};
}
struct ARowLinear { const bf16_t* base; int ld; __device__ __forceinline__ const bf16_t* operator()(int r) const { return base + (size_t)r * ld; } };

__device__ __forceinline__ bool dense_unit(int it, int bid, int nb, int MT, int NT, int& mt, int& nt) {
    if (nb == 256) {
        const int xcd = bid & 7, loc = bid >> 3, nmacN = (NT + 3) >> 2, nmacM = (MT + 7) >> 3;
        const int q = it * 8 + xcd;
        if (q >= nmacM * nmacN) { mt = -1; return false; }
        const int mm = q / nmacN, nn = q - mm * nmacN;
        mt = mm * 8 + (loc & 7); nt = nn * 4 + (loc >> 3);
        if (mt >= MT || nt >= NT) mt = -1;
        return true;
    }
    const int u = it * nb + bid;
    if (u >= MT * NT) { mt = -1; return false; }
    mt = u / NT; nt = u - mt * NT; return true;
}

namespace pg8 {
typedef unsigned short bf16_t;
constexpr float F8_WMUL = 64.0f, F8_WINV = 1.0f / 64.0f;
constexpr int BM = 256, BK = 64, HALF = 128, HTB = HALF * BK * 2, STAGE_BYTES = 8 * HTB, NXCD = 8, WGM = 8;
__host__ __device__ __forceinline__ int lds_byte(int r, int c) { const int st = (r >> 4) * 2 + (c >> 5), rr = r & 15, cc = c & 31, ob = rr * 64 + cc * 2; return st * 1024 + (ob ^ (((ob >> 9) & 1) << 5)); }
__host__ __device__ __forceinline__ void stage_rc(int b, int& R, int& C) { const int st = b / 1024, sb = b % 1024, swz = sb ^ (((sb >> 9) & 1) << 5); R = (st >> 1) * 16 + swz / 64; C = (st & 1) * 32 + (swz % 64) / 2; }
__host__ __device__ __forceinline__ int perm32(int rho) { const int n = rho >> 4, i = rho & 15; return 8 * (i >> 2) + 4 * n + (i & 3); }
struct Unit { const char* a; const char* b; const int* rows; int pm, pn, tag; };
__device__ __forceinline__ bool static_tile(int i, int G, int c, int nM, int nN, int& pm, int& pn) {
    const int nwg = nM * nN; const long L = (long)i * G + c; if (L >= nwg) return false;
    int wgid = (int)L; { const int q = nwg / NXCD, r = nwg % NXCD, xcd = wgid % NXCD, off = wgid / NXCD; wgid = (xcd < r ? xcd * (q + 1) : r * (q + 1) + (xcd - r) * q) + off; }
    const int nig = WGM * nN, gid = wgid / nig, fm = gid * WGM, gsz = (nM - fm) < WGM ? (nM - fm) : WGM;
    pm = fm + ((wgid % nig) % gsz); pn = (wgid % nig) / gsz; return true;
}
typedef int i32x8 __attribute__((ext_vector_type(8)));
typedef int i32x4 __attribute__((ext_vector_type(4)));
template <bool GATHER, bool F8, class Epi, class Sched>
__device__ __forceinline__ void gemm_phase(LAS unsigned char* lds, const int K, const Sched& S, const Epi& E) {
    const int tid = ltid(), wid = __builtin_amdgcn_readfirstlane(tid >> 6), lane = tid & 63, wr = wid >> 2, wc = wid & 3, fr = lane & 15, fq = lane >> 4;
    const int nt = K / BK;
    unsigned voffA[2], voffB[2];
#pragma unroll
    for (int i = 0; i < 2; ++i) { int R, C; stage_rc(tid * 16 + i * 8192, R, C); const int Rb = Epi::PERM ? ((R & ~31) + perm32(R & 31)) : R;
        voffA[i] = (unsigned)(R * K + C) * 2u; voffB[i] = (unsigned)(Rb * K + C) * 2u; }
    (void)voffA;
    const size_t kstep = (size_t)(BK * 2);
    const size_t hstep = (size_t)HALF * K * 2;
    const unsigned ldsw = (unsigned)wid * 1024u;
    const int aoff = lds_byte(wr * 64 + fr, fq * 8), boff = lds_byte(wc * 32 + fr, fq * 8);
#define PG8_SA(b, h) (((b) * 2 + (h)) * HTB)
#define PG8_SB(b, h) ((4 + (b) * 2 + (h)) * HTB)
#define PG8_STAGE(bufoff, gbase, voff) do { _Pragma("unroll") for (int _i = 0; _i < 2; ++_i) { unsigned vo_ = (voff)[_i]; asm volatile("" : "+v"(vo_));     \
        __builtin_amdgcn_global_load_lds((const unsigned*)((const char*)(gbase) + vo_), (LAS unsigned*)(lds + (bufoff) + ldsw + _i * 8192), 16, 0, 0); } } while (0)
#define PG8_LDA(dst, b, h) do { if constexpr (F8) { _Pragma("unroll") for (int m = 0; m < 4; ++m) { dst##8[m].lo = *(const LAS i32x4*)(lds + PG8_SA(b, h) + aoff + m * 2048); dst##8[m].hi = *(const LAS i32x4*)(lds + PG8_SA(b, h) + aoff + m * 2048 + 1024); } } \
        else { _Pragma("unroll") for (int m = 0; m < 4; ++m) _Pragma("unroll") for (int k = 0; k < 2; ++k) dst[m][k] = *(const LAS bf16x8*)(lds + PG8_SA(b, h) + aoff + m * 2048 + k * 1024); } } while (0)
#define PG8_LDB(dst, b, h) do { if constexpr (F8) { _Pragma("unroll") for (int n = 0; n < 2; ++n) { dst##8[n].lo = *(const LAS i32x4*)(lds + PG8_SB(b, h) + boff + n * 2048); dst##8[n].hi = *(const LAS i32x4*)(lds + PG8_SB(b, h) + boff + n * 2048 + 1024); } } \
        else { _Pragma("unroll") for (int n = 0; n < 2; ++n) _Pragma("unroll") for (int k = 0; k < 2; ++k) dst[n][k] = *(const LAS bf16x8*)(lds + PG8_SB(b, h) + boff + n * 2048 + k * 1024); } } while (0)
#define PG8_MMA(ai, bj, At, Bt) do { __builtin_amdgcn_s_setprio(1); _Pragma("unroll") for (int m = 0; m < 4; ++m) _Pragma("unroll") for (int n = 0; n < 2; ++n) { \
        if constexpr (F8) acc[ai][bj][m][n] = __builtin_amdgcn_mfma_scale_f32_16x16x128_f8f6f4(Bt##8[n], At##8[m], acc[ai][bj][m][n], 0, 0, 0, 0, 0, 0); \
        else { _Pragma("unroll") for (int k = 0; k < 2; ++k) acc[ai][bj][m][n] = __builtin_amdgcn_mfma_f32_16x16x32_bf16(Bt[n][k], At[m][k], acc[ai][bj][m][n], 0, 0, 0); } } \
        __builtin_amdgcn_s_setprio(0); } while (0)
#define PG8_WAIT_V(n) asm volatile("s_waitcnt vmcnt(" #n ")" ::: "memory")
#define PG8_WAIT_L(n) asm volatile("s_waitcnt lgkmcnt(" #n ")" ::: "memory")
#define PG8_BAR __builtin_amdgcn_s_barrier()
#define PG8_SCHED __builtin_amdgcn_sched_barrier(0)
    Unit cur, nxt; int ui = 0;
    if (!S.next(0, cur)) return;
    f32x4 acc[2][2][4][2];
#pragma unroll
    for (int a = 0; a < 2; ++a)
#pragma unroll
        for (int b = 0; b < 2; ++b)
#pragma unroll
            for (int m = 0; m < 4; ++m)
#pragma unroll
                for (int n = 0; n < 2; ++n) acc[a][b][m][n] = (f32x4){0.f, 0.f, 0.f, 0.f};
    bf16x8 At[4][2], B0[2][2], B1[2][2];
    i32x8 At8[4], B08[2], B18[2];
    (void)At; (void)B0; (void)B1; (void)At8; (void)B08; (void)B18;
    const char* cA = cur.a; const char* cB = cur.b;
    unsigned ca0[2], ca1[2], na0[2], na1[2];
#define PG8_AOFFS(u, o0, o1) do { _Pragma("unroll") for (int _i = 0; _i < 2; ++_i) { \
        if constexpr (GATHER) { int R_, C_; stage_rc(ltid() * 16 + _i * 8192, R_, C_); const int* rw_ = (u).rows + R_; \
            o0[_i] = (unsigned)rw_[0] * (unsigned)(K * 2) + (unsigned)C_ * 2u; o1[_i] = (unsigned)rw_[128] * (unsigned)(K * 2) + (unsigned)C_ * 2u; } \
        else { o0[_i] = voffA[_i]; o1[_i] = voffA[_i] + (unsigned)hstep; } } } while (0)
    PG8_AOFFS(cur, ca0, ca1);
#pragma unroll
    for (int i = 0; i < 2; ++i) { na0[i] = ca0[i]; na1[i] = ca1[i]; }
    (void)na0; (void)na1;
    PG8_STAGE(PG8_SB(0, 0), cB, voffB); PG8_STAGE(PG8_SA(0, 0), cA, ca0); PG8_STAGE(PG8_SB(0, 1), cB + hstep, voffB); PG8_STAGE(PG8_SA(0, 1), cA, ca1);
    if (wr == 1) PG8_BAR;
    PG8_WAIT_V(4); PG8_BAR;
    PG8_STAGE(PG8_SB(1, 0), cB + kstep, voffB); PG8_STAGE(PG8_SA(1, 0), cA + kstep, ca0); PG8_STAGE(PG8_SB(1, 1), cB + hstep + kstep, voffB);
    PG8_WAIT_V(6); PG8_BAR;
    for (;;) {
        const bool has_next = S.next(ui + 1, nxt);
        const char* nA = has_next ? nxt.a : cA; const char* nB = has_next ? nxt.b : cB;
        if constexpr (!GATHER) { if (has_next) PG8_AOFFS(nxt, na0, na1); }
#pragma nounroll
        for (int t = 0; t < nt; t += 2) {
            const bool last = (t == nt - 2);
            const char* a1 = cA + (size_t)(t + 1) * kstep;
            const char* a2 = last ? nA : cA + (size_t)(t + 2) * kstep; const char* b2 = last ? nB : cB + (size_t)(t + 2) * kstep;
            const char* a3 = a2 + kstep; const char* b3 = b2 + kstep;
            unsigned xa0[2] = {ca0[0], ca0[1]}, xa1[2] = {ca1[0], ca1[1]};
            if (last) {
                if constexpr (GATHER) { if (has_next) PG8_AOFFS(nxt, xa0, xa1); }
                else { xa0[0] = na0[0]; xa0[1] = na0[1]; xa1[0] = na1[0]; xa1[1] = na1[1]; }
            }
            PG8_LDB(B0, 0, 0); PG8_SCHED; PG8_LDA(At, 0, 0); PG8_STAGE(PG8_SA(1, 1), a1, ca1);
            PG8_WAIT_L(8); PG8_BAR; PG8_WAIT_L(0); PG8_MMA(0, 0, At, B0); PG8_BAR; PG8_SCHED;
            PG8_LDB(B1, 0, 1); PG8_STAGE(PG8_SB(0, 0), b2, voffB);
            PG8_BAR; PG8_WAIT_L(0); PG8_MMA(0, 1, At, B1); PG8_BAR;
            PG8_LDA(At, 0, 1); PG8_STAGE(PG8_SA(0, 0), a2, xa0);
            PG8_BAR; PG8_WAIT_L(0); PG8_MMA(1, 0, At, B0); PG8_BAR; PG8_SCHED;
            PG8_STAGE(PG8_SB(0, 1), b2 + hstep, voffB);
            PG8_WAIT_V(6); PG8_BAR; PG8_MMA(1, 1, At, B1); PG8_BAR;
            PG8_LDB(B0, 1, 0); PG8_SCHED; PG8_LDA(At, 1, 0); PG8_STAGE(PG8_SA(0, 1), a2, xa1);
            PG8_WAIT_L(8); PG8_BAR; PG8_WAIT_L(0); PG8_MMA(0, 0, At, B0); PG8_BAR; PG8_SCHED;
            PG8_LDB(B1, 1, 1); PG8_STAGE(PG8_SB(1, 0), b3, voffB);
            PG8_BAR; PG8_WAIT_L(0); PG8_MMA(0, 1, At, B1); PG8_BAR;
            PG8_LDA(At, 1, 1); PG8_STAGE(PG8_SA(1, 0), a3, xa0);
            PG8_BAR; PG8_WAIT_L(0); PG8_MMA(1, 0, At, B0); PG8_BAR; PG8_SCHED;
            PG8_STAGE(PG8_SB(1, 1), b3 + hstep, voffB);
            PG8_WAIT_V(6); PG8_BAR; PG8_MMA(1, 1, At, B1); PG8_BAR;
        }
        { const int le = ltid() & 63; E(acc, cur, wr, wc, le & 15, le >> 4); }
        if (!has_next) break;
#pragma unroll
        for (int a = 0; a < 2; ++a)
#pragma unroll
            for (int b = 0; b < 2; ++b)
#pragma unroll
                for (int m = 0; m < 4; ++m)
#pragma unroll
                    for (int n = 0; n < 2; ++n) acc[a][b][m][n] = (f32x4){0.f, 0.f, 0.f, 0.f};
        cur = nxt; cA = nA; cB = nB; ++ui;
        if constexpr (GATHER) PG8_AOFFS(cur, ca0, ca1);
        else {
#pragma unroll
            for (int i = 0; i < 2; ++i) { ca0[i] = na0[i]; ca1[i] = na1[i]; }
        }
    }
    PG8_WAIT_V(0);
    if (wr == 0) PG8_BAR;
    PG8_BAR;
#undef PG8_AOFFS
#undef PG8_SA
#undef PG8_SB
#undef PG8_STAGE
#undef PG8_LDA
#undef PG8_LDB
#undef PG8_MMA
#undef PG8_WAIT_V
#undef PG8_WAIT_L
#undef PG8_BAR
#undef PG8_SCHED
}
}

template <bool F8>
struct SchedInproj { const char* A; const char* B; int nM, G, c;
    __device__ __forceinline__ bool next(int i, pg8::Unit& u) const { int pm, j; if (!pg8::static_tile(i, G, c, nM, F8 ? IN_N8 : IN_NBF, pm, j)) return false;
        unsigned long long m = F8 ? IN_F8_MASK : IN_BF_MASK; for (int q = 0; q < j; ++q) m &= m - 1;
        const int pn = __builtin_ctzll(m);
        u.pm = pm; u.pn = pn; u.tag = 0; u.rows = nullptr; u.a = A + (size_t)pm * 256 * 1024 * (F8 ? 1 : 2); u.b = B + (size_t)pn * 256 * 1024 * (F8 ? 1 : 2); return true; } };
template <bool F8>
struct EpiInproj { static constexpr bool PERM = true; bf16_t* P; float* GATES; unsigned char* GP8; unsigned char* MO8;
    __device__ __forceinline__ void operator()(const f32x4 (&acc)[2][2][4][2], const pg8::Unit& u, int wr, int wc, int fr, int fq) const {
        const size_t row0 = (size_t)u.pm * 256 + wr * 64 + fr;
        constexpr float ASC = F8 ? pg8::F8_WINV : 1.0f;
        if (u.pn >= 16 && u.pn < 20) {
#pragma unroll
            for (int ai = 0; ai < 2; ++ai)
#pragma unroll
                for (int m = 0; m < 4; ++m) { unsigned char* rowp = MO8 + (row0 + ai * 128 + m * 16) * 1024 + (u.pn - 16) * 256 + wc * 32 + 8 * fq;
#pragma unroll
                    for (int bj = 0; bj < 2; ++bj) { const f32x4 v0 = acc[ai][bj][m][0] * ASC, v1 = acc[ai][bj][m][1] * ASC;
                        int w0 = 0, w1 = 0;
                        w0 = __builtin_amdgcn_cvt_pk_fp8_f32(v0[0], v0[1], w0, false); w0 = __builtin_amdgcn_cvt_pk_fp8_f32(v0[2], v0[3], w0, true);
                        w1 = __builtin_amdgcn_cvt_pk_fp8_f32(v1[0], v1[1], w1, false); w1 = __builtin_amdgcn_cvt_pk_fp8_f32(v1[2], v1[3], w1, true);
                        *(u32x2*)(rowp + bj * 128) = mk2((unsigned)w0, (unsigned)w1); } }
        } else if (u.pn < 32) {
#pragma unroll
            for (int ai = 0; ai < 2; ++ai)
#pragma unroll
                for (int m = 0; m < 4; ++m) { bf16_t* rowp = P + (row0 + ai * 128 + m * 16) * PWID + u.pn * 256 + wc * 32 + 8 * fq;
#pragma unroll
                    for (int bj = 0; bj < 2; ++bj) { const f32x4 v0 = acc[ai][bj][m][0] * ASC, v1 = acc[ai][bj][m][1] * ASC;
                        *(u32x4*)(rowp + bj * 128) = mk4(pk2(v0[0], v0[1]), pk2(v0[2], v0[3]), pk2(v1[0], v1[1]), pk2(v1[2], v1[3])); } }
        } else if (u.pn < 44) {
#pragma unroll
            for (int ai = 0; ai < 2; ++ai)
#pragma unroll
                for (int m = 0; m < 4; ++m) { unsigned char* rowp = GP8 + (row0 + ai * 128 + m * 16) * 3072 + (u.pn - 32) * 256 + wc * 32 + 8 * fq;
#pragma unroll
                    for (int bj = 0; bj < 2; ++bj) { const f32x4 v0 = acc[ai][bj][m][0] * ASC, v1 = acc[ai][bj][m][1] * ASC;
                        int w0 = 0, w1 = 0;
                        w0 = __builtin_amdgcn_cvt_pk_fp8_f32(v0[0], v0[1], w0, false); w0 = __builtin_amdgcn_cvt_pk_fp8_f32(v0[2], v0[3], w0, true);
                        w1 = __builtin_amdgcn_cvt_pk_fp8_f32(v1[0], v1[1], w1, false); w1 = __builtin_amdgcn_cvt_pk_fp8_f32(v1[2], v1[3], w1, true);
                        *(u32x2*)(rowp + bj * 128) = mk2((unsigned)w0, (unsigned)w1); } }
        } else if (wc == 0 && fq < 2) {
#pragma unroll
            for (int ai = 0; ai < 2; ++ai)
#pragma unroll
                for (int m = 0; m < 4; ++m) { float* g = GATES + (row0 + ai * 128 + m * 16) * 16 + 8 * fq; *(f32x4*)g = acc[ai][0][m][0] * ASC; *(f32x4*)(g + 4) = acc[ai][0][m][1] * ASC; }
        }
    } };
__device__ __forceinline__ void phase_inproj8(CP p, LAS unsigned char* lds, int bid, int nb) {
    if constexpr (IN_N8 > 0) {
        SchedInproj<true> S{(const char*)p->H8, (const char*)p->bt_in8, p->G * SALL / 256, nb, bid};
        EpiInproj<true> E{p->P, p->GATES, p->GP8, p->MO8};
        pg8::gemm_phase<false, true>(lds, 512, S, E);
    }
    if constexpr (IN_NBF > 0) {
        SchedInproj<false> S{(const char*)p->H, (const char*)p->bt_in, p->G * SALL / 256, nb, nb - 1 - bid};
        EpiInproj<false> E{p->P, p->GATES, p->GP8, p->MO8};
        pg8::gemm_phase<false, false>(lds, 1024, S, E);
    }
}

struct CvtItem { const float* src; int sld; bf16_t* dst; int dld; int zero; float scale; int f8; };
__device__ __forceinline__ CvtItem cvt_decode(CP p, int L, int item) {
    CvtItem c; c.zero = 0; c.scale = 1.0f; c.f8 = 0;
    if (item < 11520) {
        const int g = item >> 4, kb = item & 15; int sc = 0;
        if (g < 320) sc = 16 * g; else if (g < 704) sc = 16 * g + 16; else if (g == 704) sc = 5120; else c.zero = 1;
        c.src = p->w_in + (size_t)L * 1024 * 11280 + (size_t)kb * 64 * 11280 + sc; c.sld = 11280;
        if ((IN_F8_MASK >> (g >> 4)) & 1) { c.dst = (bf16_t*)(p->bt_in8 + (size_t)g * 16 * 1024 + kb * 64); c.dld = 1024; c.f8 = 1; c.scale = pg8::F8_WMUL; return c; }
        c.dst = p->bt_in + (size_t)g * 16 * 1024 + kb * 64; c.dld = 1024; return c;
    }
    item -= 11520;
    if (item < 3072) {
        const int j = item >> 10, r = item & 1023, g = r >> 4, kb = r & 15;
        c.src = p->w_branch + ((size_t)(L * 3 + j) * 1024 + kb * 64) * 1024 + g * 16; c.sld = 1024;
        if (MERGE_F8 && j > 0) { c.dst = (bf16_t*)((unsigned char*)p->bt_br + (size_t)j * 1024 * 1024 * 2 + (size_t)g * 16 * 1024 + kb * 64); c.dld = 1024; c.f8 = 1; c.scale = pg8::F8_WMUL; return c; }
        c.dst = p->bt_br + ((size_t)j * 1024 + g * 16) * 1024 + kb * 64; c.dld = 1024; return c;
    }
    item -= 3072;
    if (item < 1024) {
        const int g = item >> 4, kb = item & 15;
        c.src = p->w_out + ((size_t)L * 1024 + kb * 64) * 1024 + g * 16; c.sld = 1024;
        c.dst = p->bt_out + (size_t)g * 16 * 1024 + kb * 64; c.dld = 1024; return c;
    }
    item -= 1024;
    if (item < 33280) {
        const int e = item >> 9, r = item & 511, g = r >> 4, kb = r & 15;
        const int nt = g >> 4, n = ((g >> 3) & 1) * 2, f = nt * 128 + (g & 7) * 16;
        const float* base = (e < 64) ? ((n < 2 ? p->w_e_gate : p->w_e_up) + ((size_t)(L * 64 + e)) * 1024 * 256) : ((n < 2 ? p->w_s_gate : p->w_s_up) + (size_t)L * 1024 * 256);
        c.src = base + (size_t)kb * 64 * 256 + f; c.sld = 256;
        c.dst = (bf16_t*)((unsigned char*)p->bt_eup + ((size_t)e * 512 + g * 16) * 1024 + kb * 64); c.dld = 1024; c.f8 = 1; c.scale = 64.0f; return c;
    }
    item -= 33280;
    if (item < 16640) {
        const int e = item >> 8, r = item & 255, g = r >> 2, kb = r & 3;
        const float* base = (e < 64) ? (p->w_e_down + ((size_t)(L * 64 + e)) * 256 * 1024) : (p->w_s_down + (size_t)L * 256 * 1024);
        c.src = base + (size_t)kb * 64 * 1024 + g * 16; c.sld = 1024;
        if (DOWN_F8) { c.dst = (bf16_t*)((unsigned char*)p->bt_edn + ((size_t)e * 1024 + g * 16) * 256 + kb * 64); c.dld = 256; c.f8 = 1; c.scale = DW_SC; return c; }
        c.dst = p->bt_edn + ((size_t)e * 1024 + g * 16) * 256 + kb * 64; c.dld = 256; c.scale = D_SCALE; return c;
    }
    item -= 16640;
    {
        const int dh = item >> 5, r = item & 31, g = r >> 1, kb = r & 1;
        const int cq = g >> 2, n = g & 3, ch = cq * 32 + (n & 1) * 16;
        const float* base = (n < 2 ? p->lru_wa : p->lru_wx) + ((size_t)(L * 16 + dh)) * 128 * 128;
        c.src = base + (size_t)kb * 64 * 128 + ch; c.sld = 128;
        c.dst = p->bt_lru + ((size_t)dh * 256 + g * 16) * 128 + kb * 64; c.dld = 128; return c;
    }
}
constexpr int CVT_ITEMS = 11520 + 3072 + 1024 + 33280 + 16640 + 512;
__device__ __forceinline__ void phase_convert(CP p, int L, LAS unsigned char* lds, int bid, int nb) {
    const int tid = ltid(), sub = tid >> 7, t = tid & 127;
    for (int it = bid; it * 8 < CVT_ITEMS; it += nb) {
        CvtItem c[2]; bool valid[2];
        float4 v0[2], v1[2];
        const int kk = t >> 1, half = t & 1;
#pragma unroll
        for (int q = 0; q < 2; ++q) {
            const int item = it * 8 + sub * 2 + q;
            valid[q] = item < CVT_ITEMS;
            c[q].src = nullptr; c[q].dst = nullptr; c[q].sld = 0; c[q].dld = 0; c[q].zero = 1; c[q].scale = 1.0f; c[q].f8 = 0;
            if (valid[q]) c[q] = cvt_decode(p, L, item);
            v0[q] = make_float4(0.f, 0.f, 0.f, 0.f); v1[q] = v0[q];
            if (valid[q] && !c[q].zero) { const float* s2 = c[q].src + (size_t)kk * c[q].sld + half * 8; v0[q] = *(const float4*)s2; v1[q] = *(const float4*)(s2 + 4); }
        }
#pragma unroll
        for (int q = 0; q < 2; ++q) {
            LAS bf16_t* tile = (LAS bf16_t*)(lds + (sub * 2 + q) * (16 * 66 * 2));
            const float vv[8] = {v0[q].x, v0[q].y, v0[q].z, v0[q].w, v1[q].x, v1[q].y, v1[q].z, v1[q].w};
#pragma unroll
            for (int i = 0; i < 8; ++i) tile[(half * 8 + i) * 66 + kk] = (bf16_t)(pk2(vv[i] * c[q].scale, 0.f) & 0xffffu);
        }
        __syncthreads();
#pragma unroll
        for (int q = 0; q < 2; ++q) {
            if (valid[q]) {
                LAS bf16_t* tile = (LAS bf16_t*)(lds + (sub * 2 + q) * (16 * 66 * 2));
                const int i = t >> 3, seg = t & 7;
                unsigned w[4];
#pragma unroll
                for (int x = 0; x < 4; ++x) w[x] = (unsigned)tile[i * 66 + seg * 8 + 2 * x] | ((unsigned)tile[i * 66 + seg * 8 + 2 * x + 1] << 16);
                if (c[q].f8) { int f0 = 0, f1 = 0;
                    f0 = __builtin_amdgcn_cvt_pk_fp8_f32(lo_bf(w[0]), hi_bf(w[0]), f0, false); f0 = __builtin_amdgcn_cvt_pk_fp8_f32(lo_bf(w[1]), hi_bf(w[1]), f0, true);
                    f1 = __builtin_amdgcn_cvt_pk_fp8_f32(lo_bf(w[2]), hi_bf(w[2]), f1, false); f1 = __builtin_amdgcn_cvt_pk_fp8_f32(lo_bf(w[3]), hi_bf(w[3]), f1, true);
                    *(u32x2*)((unsigned char*)c[q].dst + (size_t)i * c[q].dld + seg * 8) = mk2((unsigned)f0, (unsigned)f1); }
                else *(u32x4*)(c[q].dst + (size_t)i * c[q].dld + seg * 8) = mk4(w[0], w[1], w[2], w[3]);
            }
        }
        __syncthreads();
    }
}

__device__ __forceinline__ void phase_mods(CP p, LAS unsigned char* lds, int bid, int nb) {
    const int tid = ltid();
    LAS float* sl = (LAS float*)lds;
    const int tcol = tid & 63, kp = tid >> 6;
    for (int item = bid; item < 192; item += nb) {
        const int L = item / 96, n0 = (item % 96) * 64;
        __syncthreads();
#pragma unroll 1
        for (int q0 = 0; q0 < 66; q0 += 22) {
            float cvv[22];
#pragma unroll
            for (int q = 0; q < 22; ++q) { const int e = tid + (q0 + q) * NTHREADS; cvv[q] = (q0 + q < 64) ? p->c[e] : p->c_ctx[e - 32768]; }
#pragma unroll
            for (int q = 0; q < 22; ++q) { const int e = tid + (q0 + q) * NTHREADS; sl[(e & 1023) * 33 + (e >> 10)] = cvv[q] * __builtin_amdgcn_rcpf(1.0f + __expf(-cvv[q])); }
        }
        __syncthreads();
        float acc[33];
#pragma unroll
        for (int r = 0; r < 33; ++r) acc[r] = 0.f;
        const float* w = p->w_ada + ((size_t)L * 1024 + kp * 128) * 6144 + n0 + tcol;
        for (int k0 = 0; k0 < 128; k0 += 16) {
            float wv[16];
#pragma unroll
            for (int k = 0; k < 16; ++k) wv[k] = w[(size_t)(k0 + k) * 6144];
            LAS float* sk = sl + (kp * 128 + k0) * 33;
#pragma unroll
            for (int k = 0; k < 16; ++k)
#pragma unroll
                for (int r = 0; r < 33; ++r) acc[r] += sk[k * 33 + r] * wv[k];
        }
        __syncthreads();
#pragma unroll
        for (int r = 0; r < 33; ++r) sl[(kp * 33 + r) * 64 + tcol] = acc[r];
        __syncthreads();
        const float bv = p->b_ada[L * 6144 + n0 + tcol];
        for (int r = kp; r < 33; r += 8) {
            float sum = 0.f;
#pragma unroll
            for (int q = 0; q < 8; ++q) sum += sl[(q * 33 + r) * 64 + tcol];
            if (r < 32) p->mods_l[((size_t)L * 32 + r) * 6144 + n0 + tcol] = sum + bv;
            else p->mods_c[(size_t)L * 6144 + n0 + tcol] = sum + bv;
        }
    }
    for (int e = bid * NTHREADS + tid; e < 2048 * 32; e += nb * NTHREADS) {
        const int s = e >> 5, a = (e >> 4) & 1, f = e & 15;
        const float pos = (float)(a == 0 ? (s >> 6) : (s & 63));
        const float fr = powf(10000.0f, -(float)f / 16.0f);
        float sn, cs; sincosf(pos * fr, &sn, &cs);
        p->rope[2 * e] = cs; p->rope[2 * e + 1] = sn;
    }
    if (bid == 0 && tid < 128) {
        const int L = tid >> 6, lane = tid & 63;
        const float* lv = p->da_lambda + L * 256;
        const float a = wave_sum(lv[lane] * lv[64 + lane]), b = wave_sum(lv[128 + lane] * lv[192 + lane]);
        const float lam_init = 0.8f - 0.6f * expf(-0.3f * (float)L);
        if (lane == 0) p->lamv[L] = expf(a) - expf(b) + lam_init;
        float gq = fabsf(p->da_qnorm_g[L * 64 + lane]), gk = fabsf(p->da_knorm_g[L * 64 + lane]);
#pragma unroll
        for (int o = 32; o >= 1; o >>= 1) { gq = fmaxf(gq, sx_(gq, o)); gk = fmaxf(gk, sx_(gk, o)); }
        if (lane == 0) p->lamv[2 + L] = 64.0f * gq * gk * 0.125f * 1.4426950408889634f * 1.001f + 0.01f;
    }
}

__device__ __forceinline__ void phase_prenorm(CP p, int L, int grp, int bid, int nb) {
    const int lane = ltid() & 63, wid = ltid() >> 6;
    const int RG = p->G * SALL;
    const float* g1 = p->norm1_g + L * 1024;
    for (int r = bid * 8 + wid; r < RG; r += nb * 8) {
        const int bl = r / SALL, pos = r - bl * SALL, b = grp * p->G + bl;
        const float* src; const float* md;
        if (pos < CTXL) { src = (L == 0 ? p->ctx : p->XC1) + ((size_t)b * CTXL + pos) * 1024; md = p->mods_c + (size_t)L * 6144; }
        else { src = (L == 0 ? p->x : p->out) + ((size_t)b * SEQ + (pos - CTXL)) * 1024; md = p->mods_l + ((size_t)L * 32 + b) * 6144; }
        float4 v[4]; float ss = 0.f;
#pragma unroll
        for (int i = 0; i < 4; ++i) { v[i] = *(const float4*)(src + i * 256 + lane * 4); ss += v[i].x * v[i].x + v[i].y * v[i].y + v[i].z * v[i].z + v[i].w * v[i].w; }
        ss = wave_sum(ss);
        const float rstd = rsqrtf(ss * (1.0f / 1024.0f) + 1e-6f);
#pragma unroll
        for (int i = 0; i < 4; ++i) {
            const int col = i * 256 + lane * 4;
            const float4 g = *(const float4*)(g1 + col), sh = *(const float4*)(md + col), sc = *(const float4*)(md + 1024 + col);
            const float o0 = v[i].x * rstd * g.x * (1.f + sc.x) + sh.x, o1 = v[i].y * rstd * g.y * (1.f + sc.y) + sh.y;
            const float o2 = v[i].z * rstd * g.z * (1.f + sc.z) + sh.z, o3 = v[i].w * rstd * g.w * (1.f + sc.w) + sh.w;
            if (IN_N8 > 0) { int w8 = 0; w8 = __builtin_amdgcn_cvt_pk_fp8_f32(o0, o1, w8, false); w8 = __builtin_amdgcn_cvt_pk_fp8_f32(o2, o3, w8, true); *(unsigned*)(p->H8 + (size_t)r * 1024 + col) = (unsigned)w8; }
            if (IN_NBF > 0) *(u32x2*)(p->H + (size_t)r * 1024 + col) = mk2(pk2(o0, o1), pk2(o2, o3));
        }
    }
}

__device__ __forceinline__ void phase_daprep(CP p, int L, int grp, int bid, int nb) {
    const int lane = ltid() & 63, wid = ltid() >> 6;
    const int RG = p->G * SALL;
    const float* qg = p->da_qnorm_g + L * 64; const float* kg = p->da_knorm_g + L * 64;
    const int d0 = (lane & 7) * 8;
    float gq[8], gk[8];
    const float qscale = 0.125f * 1.4426950408889634f;
#pragma unroll
    for (int j = 0; j < 8; ++j) { gq[j] = qg[d0 + j] * qscale; gk[j] = kg[d0 + j]; }
    const bool second = (lane & 2) != 0;
    for (int r = bid * 8 + wid; r < RG; r += nb * 8) {
        const int bl = r / SALL, pos = r - bl * SALL;
        bf16_t* row = p->P + (size_t)r * PWID + PC_DQ;
        const bool lat = pos >= CTXL;
        u32x4 u[4];
#pragma unroll
        for (int i = 0; i < 4; ++i) u[i] = *(const u32x4*)(row + (lane + 64 * i) * 8);
        f32x4 rt4[4];
#pragma unroll
        for (int q = 0; q < 4; ++q) rt4[q] = (f32x4){1.f, 0.f, 1.f, 0.f};
        if (lat) {
            const int s2 = pos - CTXL, ax = (lane >> 2) & 1, f0 = (lane & 1) * 8;
            const float* rt = p->rope + ((size_t)s2 * 32 + ax * 16 + f0) * 2;
#pragma unroll
            for (int q = 0; q < 4; ++q) rt4[q] = *(const f32x4*)(rt + 4 * q);
        }
#pragma unroll
        for (int i = 0; i < 4; ++i) {
            float v[8] = {lo_bf(u[i].x), hi_bf(u[i].x), lo_bf(u[i].y), hi_bf(u[i].y), lo_bf(u[i].z), hi_bf(u[i].z), lo_bf(u[i].w), hi_bf(u[i].w)};
            float ss = 0.f;
#pragma unroll
            for (int j = 0; j < 8; ++j) ss += v[j] * v[j];
            ss += dppf<0xB1>(0.f, ss); ss += dppf<0x4E>(0.f, ss); ss += dppf<0x141>(0.f, ss);
            const float rstd = rsqrtf(ss * (1.0f / 64.0f) + 1e-6f);
#pragma unroll
            for (int j = 0; j < 8; ++j) v[j] = v[j] * rstd * (i < 2 ? gq[j] : gk[j]);
            if (lat) {
#pragma unroll
                for (int j = 0; j < 8; ++j) {
                    const float cs = rt4[j >> 1][(j & 1) * 2], sn = rt4[j >> 1][(j & 1) * 2 + 1];
                    const float o = dppf<0x4E>(0.f, v[j]);
                    v[j] = second ? (v[j] * cs + o * sn) : (v[j] * cs - o * sn);
                }
            }
            u[i] = mk4(pk2(v[0], v[1]), pk2(v[2], v[3]), pk2(v[4], v[5]), pk2(v[6], v[7]));
        }
#pragma unroll
        for (int i = 0; i < 4; ++i) *(u32x4*)(row + (lane + 64 * i) * 8) = u[i];
    }
}

constexpr int AT_KROW = 272, AT_VROW = 288, AT_K = 64 * AT_KROW, AT_STAGE = 64 * AT_KROW + 64 * AT_VROW;
constexpr int A2_QROW = 272, A2_KV = 256 * A2_QROW, A3_STAGE_BYTES = 32768;
static_assert(A2_KV + 2 * AT_STAGE <= 147456 - 64, "attention LDS");
__device__ __forceinline__ void attn_unit2(CP p, int L, LAS unsigned char* lds, int bl, int hd, int qt) {
    const int tid = ltid(), lane = tid & 63, wid = tid >> 6, q4 = lane >> 4, l15 = lane & 15;
    const size_t rowbase = (size_t)bl * SALL;
    const int qpos0 = (qt < 8) ? (CTXL + qt * 256) : 0;
    const int nkt = (qt < 8) ? 36 : 4;
    LAS unsigned char* kv = lds + A2_KV;
    __syncthreads();
    {
#pragma unroll
        for (int i = 0; i < 8; ++i) {
            const int id = tid + NTHREADS * i, row = id >> 4, ch = id & 15;
            *(LAS u32x4*)(lds + row * A2_QROW + ch * 16) = *(const u32x4*)(p->P + (rowbase + qpos0 + row) * PWID + PC_DQ + hd * 128 + ch * 8);
        }
    }
    const bf16_t* kbase = p->P + rowbase * PWID + PC_DK + hd * 128;
    const bf16_t* vbase = kbase + (PC_DV - PC_DK);
    const int drow = wid * 8 + (lane >> 4);
    const unsigned dof0 = (unsigned)drow * PWID + (((lane & 15) ^ (drow & 15)) << 3);
    const unsigned dof1 = (unsigned)(drow + 4) * PWID + (((lane & 15) ^ ((drow + 4) & 15)) << 3);
#define A3_STAGE(stg, kt_) do { const bf16_t* kb_ = kbase + (size_t)(kt_) * 64 * PWID; const bf16_t* vb_ = kb_ + (PC_DV - PC_DK); LAS unsigned char* d_ = kv + (stg) * A3_STAGE_BYTES + wid * 2048; \
        __builtin_amdgcn_global_load_lds((const unsigned*)(kb_ + dof0), (LAS unsigned*)(d_), 16, 0, 0); __builtin_amdgcn_global_load_lds((const unsigned*)(kb_ + dof1), (LAS unsigned*)(d_ + 1024), 16, 0, 0); \
        __builtin_amdgcn_global_load_lds((const unsigned*)(vb_ + dof0), (LAS unsigned*)(d_ + 16384), 16, 0, 0); __builtin_amdgcn_global_load_lds((const unsigned*)(vb_ + dof1), (LAS unsigned*)(d_ + 16384 + 1024), 16, 0, 0); } while (0)
    A3_STAGE(0, 0);
    asm volatile("s_waitcnt vmcnt(0)" ::: "memory");
    __syncthreads();
    f32x4 o[2][2][8];
#pragma unroll
    for (int c = 0; c < 2; ++c)
#pragma unroll
        for (int mt = 0; mt < 2; ++mt)
#pragma unroll
            for (int d = 0; d < 8; ++d) o[c][mt][d] = (f32x4){0.f, 0.f, 0.f, 0.f};
    float ls[2][2] = {{0.f, 0.f}, {0.f, 0.f}};
    const float nbound = -p->lamv[2 + L];
    const int qro = (wid * 32 + l15) * A2_QROW + q4 * 16;
    bf16x8 qf[2][2];
#pragma unroll
    for (int mt = 0; mt < 2; ++mt)
#pragma unroll
        for (int ks = 0; ks < 2; ++ks) qf[mt][ks] = *(LAS bf16x8*)(lds + qro + mt * 16 * A2_QROW + ks * 64);
    for (int kt = 0; kt < nkt; ++kt) {
        LAS unsigned char* cur = kv + (kt & 1) * A3_STAGE_BYTES;
        const bool more = kt + 1 < nkt;
        int lz = l15; asm volatile("" : "+v"(lz));
        const int kro = lz * 256, vrow0 = 4 * q4 + (lz >> 2);
        if (more) A3_STAGE((kt + 1) & 1, kt + 1);
        bf16x8 pf[2][2][2];
        f32x4 sacc[2][2][4];
#define A3_QLOAD(c_) do { _Pragma("unroll") for (int mt = 0; mt < 2; ++mt) _Pragma("unroll") for (int ks = 0; ks < 2; ++ks) qf[mt][ks] = *(LAS bf16x8*)(lds + qro + mt * 16 * A2_QROW + (c_) * 128 + ks * 64); } while (0)
#define A3_SC(s_) ((((s_) >> 3) == 0) ? (((s_) & 7) >> 2) : (1 - (((s_) & 7) >> 2)))
#define A3_SN(s_) (2 * ((s_) >> 3) + ((((s_) & 7) >> 1) & 1))
#define A3_KLOAD(s_) kf[(s_) % 3] = *(LAS bf16x8*)(cur + kro + A3_SN(s_) * 4096 + (((A3_SC(s_) * 8 + ((s_) & 1) * 4 + q4) ^ lz) << 4))
#define A3_EXP4(c_, mt_, n_) do { _Pragma("unroll") for (int j = 0; j < 4; ++j) { sacc[c_][mt_][n_][j] = __builtin_amdgcn_exp2f(sacc[c_][mt_][n_][j]); ls[c_][mt_] += sacc[c_][mt_][n_][j]; } } while (0)
#define A3_PACK(c_, mt_, k2_) do { union { bf16x8 v; unsigned u[4]; } cv; \
            cv.u[0] = pk2(sacc[c_][mt_][2 * (k2_)][0], sacc[c_][mt_][2 * (k2_)][1]); cv.u[1] = pk2(sacc[c_][mt_][2 * (k2_)][2], sacc[c_][mt_][2 * (k2_)][3]); \
            cv.u[2] = pk2(sacc[c_][mt_][2 * (k2_) + 1][0], sacc[c_][mt_][2 * (k2_) + 1][1]); cv.u[3] = pk2(sacc[c_][mt_][2 * (k2_) + 1][2], sacc[c_][mt_][2 * (k2_) + 1][3]); pf[c_][mt_][k2_] = cv.v; } while (0)
#define A3_VREAD(v_) do { const int d_ = (v_) & 7, k2_ = (v_) >> 3; const int vr0 = 32 * k2_ + vrow0, vr1 = vr0 + 16; \
            const int vsw = (((d_ * 2 + ((lz & 3) >> 1)) ^ (vr0 & 15)) << 4) + (lz & 1) * 8; \
            const s16x4 v0 = __builtin_amdgcn_ds_read_tr16_b64_v4i16((LAS s16x4*)(cur + 16384 + vr0 * 256 + vsw)); \
            const s16x4 v1 = __builtin_amdgcn_ds_read_tr16_b64_v4i16((LAS s16x4*)(cur + 16384 + vr1 * 256 + vsw)); \
            vf[(v_) % 3] = (bf16x8){v0[0], v0[1], v0[2], v0[3], v1[0], v1[1], v1[2], v1[3]}; } while (0)
        bf16x8 kf[3], vf[3];
        A3_KLOAD(0); A3_KLOAD(1);
#pragma unroll
        for (int sq = 0; sq < 16; ++sq) {
            if (sq == 4) A3_QLOAD(1);
            if (sq == 12) A3_QLOAD(0);
            if (sq + 2 < 16) A3_KLOAD(sq + 2); else A3_VREAD(sq + 2 - 16);
            {
                const int c = A3_SC(sq), n = A3_SN(sq), ks = sq & 1;
                if (ks == 0) { sacc[c][0][n] = (f32x4){nbound, nbound, nbound, nbound}; sacc[c][1][n] = (f32x4){nbound, nbound, nbound, nbound}; }
                sacc[c][0][n] = __builtin_amdgcn_mfma_f32_16x16x32_bf16(kf[sq % 3], qf[0][ks], sacc[c][0][n], 0, 0, 0);
                sacc[c][1][n] = __builtin_amdgcn_mfma_f32_16x16x32_bf16(kf[sq % 3], qf[1][ks], sacc[c][1][n], 0, 0, 0);
            }
            if (sq >= 4) { const int e = sq - 4; A3_EXP4((e >> 2) ? 1 : 0, (e >> 1) & 1, ((e >> 3) ? 2 : 0) + (e & 1)); }
            if (sq == 7) { A3_PACK(0, 0, 0); A3_PACK(0, 1, 0); }
            if (sq == 11) { A3_PACK(1, 0, 0); A3_PACK(1, 1, 0); }
            if (sq == 15) { A3_PACK(1, 0, 1); A3_PACK(1, 1, 1); }
            __builtin_amdgcn_sched_barrier(0);
        }
#pragma unroll
        for (int v = 0; v < 16; ++v) {
            if (v + 2 < 16) A3_VREAD(v + 2);
            if (v == 8) { A3_PACK(0, 0, 1); A3_PACK(0, 1, 1); }
            {
                const int d = v & 7, k2 = v >> 3;
                o[0][0][d] = __builtin_amdgcn_mfma_f32_16x16x32_bf16(vf[v % 3], pf[0][0][k2], o[0][0][d], 0, 0, 0); o[0][1][d] = __builtin_amdgcn_mfma_f32_16x16x32_bf16(vf[v % 3], pf[0][1][k2], o[0][1][d], 0, 0, 0);
                o[1][0][d] = __builtin_amdgcn_mfma_f32_16x16x32_bf16(vf[v % 3], pf[1][0][k2], o[1][0][d], 0, 0, 0); o[1][1][d] = __builtin_amdgcn_mfma_f32_16x16x32_bf16(vf[v % 3], pf[1][1][k2], o[1][1][d], 0, 0, 0);
            }
            if (v < 8 && (v & 1) == 0) A3_EXP4(0, (v >> 2) & 1, 2 + ((v >> 1) & 1));
            __builtin_amdgcn_sched_barrier(0);
        }
#undef A3_VREAD
#undef A3_QLOAD
#undef A3_SC
#undef A3_SN
#undef A3_KLOAD
#undef A3_EXP4
#undef A3_PACK
        asm volatile("s_waitcnt vmcnt(0)" ::: "memory");
        __syncthreads();
    }
#undef A3_STAGE
    const float lam = p->lamv[L];
    const float lam_init = 0.8f - 0.6f * expf(-0.3f * (float)L);
    const float* sg = p->da_subln_g + L * 128;
#pragma unroll
    for (int mt = 0; mt < 2; ++mt) {
        float l0 = ls[0][mt], l1 = ls[1][mt];
        l0 += sx_(l0, 16); l0 += sx_(l0, 32); l1 += sx_(l1, 16); l1 += sx_(l1, 32);
        const float i0 = 1.0f / l0, i1 = lam / l1;
        float ss = 0.f;
#pragma unroll
        for (int d = 0; d < 8; ++d)
#pragma unroll
            for (int j = 0; j < 4; ++j) { const float v = o[0][mt][d][j] * i0 - o[1][mt][d][j] * i1; o[0][mt][d][j] = v; ss += v * v; }
        ss += sx_(ss, 16); ss += sx_(ss, 32);
        const float rstd = rsqrtf(ss * (1.0f / 128.0f) + 1e-6f) * (1.0f - lam_init);
        bf16_t* orow = p->YC + (rowbase + qpos0 + wid * 32 + mt * 16 + l15) * 1024 + hd * 128;
#pragma unroll
        for (int d = 0; d < 8; ++d) {
            const int dv = d * 16 + 4 * q4;
            const f32x4 g = *(const f32x4*)(sg + dv);
            if (MERGE_F8) { int w8 = 0; w8 = __builtin_amdgcn_cvt_pk_fp8_f32(o[0][mt][d][0] * rstd * g[0], o[0][mt][d][1] * rstd * g[1], w8, false); w8 = __builtin_amdgcn_cvt_pk_fp8_f32(o[0][mt][d][2] * rstd * g[2], o[0][mt][d][3] * rstd * g[3], w8, true);
                *(unsigned*)((unsigned char*)p->YC + (rowbase + qpos0 + wid * 32 + mt * 16 + l15) * 1024 + hd * 128 + dv) = (unsigned)w8; }
            else *(u32x2*)(orow + dv) = mk2(pk2(o[0][mt][d][0] * rstd * g[0], o[0][mt][d][1] * rstd * g[1]), pk2(o[0][mt][d][2] * rstd * g[2], o[0][mt][d][3] * rstd * g[3]));
        }
    }
}

constexpr int ML_QROW = 272, ML_KROW = 288, ML_VROW = 544, ML_SROW = 144;
constexpr int ML_Q = 0, ML_K = ML_Q + 64 * ML_QROW, ML_V = ML_K + 64 * ML_KROW, ML_S = ML_V + 64 * ML_VROW, ML_ARR = ML_S + 64 * ML_SROW, ML_N = ML_ARR + 4 * 256, ML_RD = ML_N + 2 * 512, ML_NP = ML_RD + 8 * 256, ML_H = ML_NP + 4 * 512, ML_HROW = 528, ML_SSP = ML_H + 64 * ML_HROW  , ML_QN = ML_SSP + 1024  , ML_END = ML_QN + 256;
static_assert(ML_END <= LDS_BYTES, "mlstm LDS");
__device__ __forceinline__ void mlstm_unit(CP p, int L, LAS unsigned char* lds, int bl, int hd, int dir) {
    const int tid = ltid(), lane = tid & 63, wid = tid >> 6, q4 = lane >> 4, l15 = lane & 15;
    const size_t rowbase = (size_t)bl * SALL;
    LAS float* carr = (LAS float*)(lds + ML_ARR);
    LAS float* Marr = carr + 64;
    LAS float* wsarr = carr + 128;
    LAS float* wiarr = carr + 192;
    LAS float* nbuf = (LAS float*)(lds + ML_N);
    LAS float* npart = (LAS float*)(lds + ML_NP);
    const float gbi = p->ml_gate_b[((L * 2 + dir) * 2 + 0) * 4 + hd], gbf = p->ml_gate_b[((L * 2 + dir) * 2 + 1) * 4 + hd];
    __syncthreads();
    if (tid < 128) nbuf[tid] = 0.f;
    f32x4 C[8][2];
#pragma unroll
    for (int a = 0; a < 8; ++a) { C[a][0] = (f32x4){0.f, 0.f, 0.f, 0.f}; C[a][1] = C[a][0]; }
    float mstate = 0.f;
    const int srow = tid >> 4, sch = tid & 15;
    const int vrow = tid >> 5, vch = tid & 31;
    u32x4 rq[2], rk[2], rv[4]; float rgi = 0.f, rgf = 0.f;
    auto chunk_pb = [&](int t) -> int { return dir == 0 ? t * 64 : (t < 4 ? (3 - t) * 64 : (39 - t) * 64); };
    auto grow_of = [&](int pb, int j) -> size_t { return rowbase + pb + (dir ? 63 - j : j); };
    auto issue = [&](int t) {
        const int pb = chunk_pb(t);
#pragma unroll
        for (int i = 0; i < 2; ++i) {
            const bf16_t* r = p->P + grow_of(pb, srow + 32 * i) * PWID;
            rq[i] = *(const u32x4*)(r + PC_MQ + hd * 128 + sch * 8);
            rk[i] = *(const u32x4*)(r + PC_MK + hd * 128 + sch * 8);
        }
#pragma unroll
        for (int i = 0; i < 4; ++i) rv[i] = *(const u32x4*)(p->P + grow_of(pb, vrow + 16 * i) * PWID + PC_MV + hd * 256 + vch * 8);
        { const float* gr = p->GATES + grow_of(pb, lane) * 16 + dir * 8 + hd; rgi = gr[0]; rgf = gr[4]; }
    };
    issue(0);
    for (int t = 0; t < 36; ++t) {
        const int pb = chunk_pb(t);
        const float gi = rgi + gbi, gf = rgf + gbf;
        const float lf = fminf(gf, 0.f) - __logf(1.0f + __expf(-fabsf(gf)));
        float bcs = lf;
        bcs += dppf<0x111>(0.f, bcs); bcs += dppf<0x112>(0.f, bcs); bcs += dppf<0x114>(0.f, bcs); bcs += dppf<0x118>(0.f, bcs);
        {
            const float t0 = __builtin_bit_cast(float, __builtin_amdgcn_readlane(__builtin_bit_cast(int, bcs), 15));
            const float t1 = __builtin_bit_cast(float, __builtin_amdgcn_readlane(__builtin_bit_cast(int, bcs), 31));
            const float t2 = __builtin_bit_cast(float, __builtin_amdgcn_readlane(__builtin_bit_cast(int, bcs), 47));
            bcs += (q4 == 0) ? 0.f : ((q4 == 1) ? t0 : ((q4 == 2) ? (t0 + t1) : (t0 + t1 + t2)));
        }
        const float cval = gi - bcs;
        float cm = cval;
        cm = fmaxf(cm, dppf<0x111>(-3.0e38f, cm)); cm = fmaxf(cm, dppf<0x112>(-3.0e38f, cm)); cm = fmaxf(cm, dppf<0x114>(-3.0e38f, cm)); cm = fmaxf(cm, dppf<0x118>(-3.0e38f, cm));
        {
            const float t0 = __builtin_bit_cast(float, __builtin_amdgcn_readlane(__builtin_bit_cast(int, cm), 15));
            const float t1 = __builtin_bit_cast(float, __builtin_amdgcn_readlane(__builtin_bit_cast(int, cm), 31));
            const float t2 = __builtin_bit_cast(float, __builtin_amdgcn_readlane(__builtin_bit_cast(int, cm), 47));
            const float pm = (q4 == 0) ? -3.0e38f : ((q4 == 1) ? t0 : ((q4 == 2) ? fmaxf(t0, t1) : fmaxf(fmaxf(t0, t1), t2)));
            cm = fmaxf(cm, pm);
        }
        const float Mj = fmaxf(mstate, cm);
        const float bL = __builtin_bit_cast(float, __builtin_amdgcn_readlane(__builtin_bit_cast(int, bcs), 63)), ML = __builtin_bit_cast(float, __builtin_amdgcn_readlane(__builtin_bit_cast(int, Mj), 63));
        const float w_inter = __expf(mstate - Mj);
        const float w_s = __expf(cval - ML);
        const float w_c = __expf(mstate - ML);
        const float floorj = __expf(-bcs - Mj);
        if (wid == 0) { carr[lane] = cval; Marr[lane] = Mj; wsarr[lane] = w_s; wiarr[lane] = w_inter; }
        {
            const float ksc = 0.08838834764831845f;
#pragma unroll
            for (int i = 0; i < 2; ++i) {
                *(LAS u32x4*)(lds + ML_Q + (srow + 32 * i) * ML_QROW + sch * 16) = rq[i];
                u32x4 u = rk[i];
                u.x = pk2(lo_bf(u.x) * ksc, hi_bf(u.x) * ksc); u.y = pk2(lo_bf(u.y) * ksc, hi_bf(u.y) * ksc);
                u.z = pk2(lo_bf(u.z) * ksc, hi_bf(u.z) * ksc); u.w = pk2(lo_bf(u.w) * ksc, hi_bf(u.w) * ksc);
                *(LAS u32x4*)(lds + ML_K + (srow + 32 * i) * ML_KROW + sch * 16) = u;
            }
#pragma unroll
            for (int i = 0; i < 4; ++i) *(LAS u32x4*)(lds + ML_V + (vrow + 16 * i) * ML_VROW + vch * 16) = rv[i];
        }
        __syncthreads();
#pragma unroll
        for (int ti = 0; ti < 2; ++ti) {
            const int idx = wid * 2 + ti, jt = idx >> 2, st = idx & 3;
            f32x4 s = (f32x4){0.f, 0.f, 0.f, 0.f};
            if (st <= jt) {
#pragma unroll
                for (int ks = 0; ks < 4; ++ks) {
                    const bf16x8 kf = *(LAS bf16x8*)(lds + ML_K + (st * 16 + l15) * ML_KROW + ks * 64 + q4 * 16);
                    const bf16x8 qf = *(LAS bf16x8*)(lds + ML_Q + (jt * 16 + l15) * ML_QROW + ks * 64 + q4 * 16);
                    s = __builtin_amdgcn_mfma_f32_16x16x32_bf16(kf, qf, s, 0, 0, 0);
                }
                const int j = jt * 16 + l15;
                const float Mv = Marr[j];
#pragma unroll
                for (int r = 0; r < 4; ++r) { const int sidx = st * 16 + 4 * q4 + r; s[r] = (sidx <= j) ? s[r] * __expf(carr[sidx] - Mv) : 0.f; }
            }
            const unsigned p01 = pk2(s[0], s[1]), p23 = pk2(s[2], s[3]);
            *(LAS u32x2*)(lds + ML_S + (jt * 16 + l15) * ML_SROW + (st * 16 + 4 * q4) * 2) = mk2(p01, p23);
            {
                float rs = (lo_bf(p01) + hi_bf(p01)) + (lo_bf(p23) + hi_bf(p23));
                rs += sx_(rs, 16); rs += sx_(rs, 32);
                if (q4 == 0) ((LAS float*)(lds + ML_SSP))[st * 64 + jt * 16 + l15] = rs;
            }
        }
        {
            const int row = tid >> 3, part = tid & 7;
            LAS unsigned char* qp = lds + ML_Q + row * ML_QROW + part * 32;
            const u32x4 u0 = *(LAS u32x4*)qp, u1 = *(LAS u32x4*)(qp + 16);
            LAS float* nv = nbuf + (t & 1) * 128 + part * 16;
            const f32x4 n0 = *(LAS f32x4*)nv, n1 = *(LAS f32x4*)(nv + 4), n2 = *(LAS f32x4*)(nv + 8), n3 = *(LAS f32x4*)(nv + 12);
            float a = lo_bf(u0.x) * n0[0] + hi_bf(u0.x) * n0[1] + lo_bf(u0.y) * n0[2] + hi_bf(u0.y) * n0[3] + lo_bf(u0.z) * n1[0] + hi_bf(u0.z) * n1[1] + lo_bf(u0.w) * n1[2] + hi_bf(u0.w) * n1[3]
                    + lo_bf(u1.x) * n2[0] + hi_bf(u1.x) * n2[1] + lo_bf(u1.y) * n2[2] + hi_bf(u1.y) * n2[3] + lo_bf(u1.z) * n3[0] + hi_bf(u1.z) * n3[1] + lo_bf(u1.w) * n3[2] + hi_bf(u1.w) * n3[3];
            a += dppf<0xB1>(0.f, a); a += dppf<0x4E>(0.f, a); a += dppf<0x141>(0.f, a);
            if (part == 0) ((LAS float*)(lds + ML_QN))[row] = a;
        }
        {
            const int dk = tid & 127, part = tid >> 7;
            float a = 0.f;
#pragma unroll
            for (int s2 = 0; s2 < 16; ++s2) a += wsarr[part * 16 + s2] * bf2f(*(LAS bf16_t*)(lds + ML_K + (part * 16 + s2) * ML_KROW + dk * 2));
            npart[part * 128 + dk] = a;
        }
        __syncthreads();
        if (tid < 128) nbuf[((t + 1) & 1) * 128 + tid] = w_c * nbuf[(t & 1) * 128 + tid] + (npart[tid] + npart[128 + tid]) + (npart[256 + tid] + npart[384 + tid]);
        float rden;
        {
            LAS float* ssp = (LAS float*)(lds + ML_SSP);
            const float ssum = (ssp[lane] + ssp[64 + lane]) + (ssp[128 + lane] + ssp[192 + lane]);
            const float den = ssum + w_inter * ((LAS float*)(lds + ML_QN))[lane];
            rden = __builtin_amdgcn_rcpf(fmaxf(fabsf(den), floorj));
        }
        f32x4 acc[4][2];
#pragma unroll
        for (int m = 0; m < 4; ++m) { acc[m][0] = (f32x4){0.f, 0.f, 0.f, 0.f}; acc[m][1] = acc[m][0]; }
#pragma unroll
        for (int tt = 0; tt < 4; ++tt) {
            bf16x8 cb[2];
#pragma unroll
            for (int nn = 0; nn < 2; ++nn) {
                union { bf16x8 v; unsigned u[4]; } cv;
                cv.u[0] = pk2(C[2 * tt][nn][0], C[2 * tt][nn][1]); cv.u[1] = pk2(C[2 * tt][nn][2], C[2 * tt][nn][3]);
                cv.u[2] = pk2(C[2 * tt + 1][nn][0], C[2 * tt + 1][nn][1]); cv.u[3] = pk2(C[2 * tt + 1][nn][2], C[2 * tt + 1][nn][3]);
                cb[nn] = cv.v;
            }
#pragma unroll
            for (int m = 0; m < 4; ++m) {
                LAS unsigned char* qp = lds + ML_Q + (m * 16 + l15) * ML_QROW + (32 * tt + 4 * q4) * 2;
                const u32x2 a0 = *(LAS u32x2*)qp, a1 = *(LAS u32x2*)(qp + 32);
                union { bf16x8 v; unsigned u[4]; } av; av.u[0] = a0.x; av.u[1] = a0.y; av.u[2] = a1.x; av.u[3] = a1.y;
                acc[m][0] = __builtin_amdgcn_mfma_f32_16x16x32_bf16(av.v, cb[0], acc[m][0], 0, 0, 0);
                acc[m][1] = __builtin_amdgcn_mfma_f32_16x16x32_bf16(av.v, cb[1], acc[m][1], 0, 0, 0);
            }
        }
#pragma unroll
        for (int m = 0; m < 4; ++m) {
            const f32x4 wi = *(LAS f32x4*)(wiarr + m * 16 + 4 * q4);
#pragma unroll
            for (int r = 0; r < 4; ++r) { acc[m][0][r] *= wi[r]; acc[m][1][r] *= wi[r]; }
        }
        bf16x8 vfr[2][2];
#pragma unroll
        for (int nn = 0; nn < 2; ++nn)
#pragma unroll
            for (int ks = 0; ks < 2; ++ks) {
                LAS unsigned char* vp2 = lds + ML_V + (32 * ks + 8 * q4 + (l15 >> 2)) * ML_VROW + ((2 * wid + nn) * 16 + (l15 & 3) * 4) * 2;
                const s16x4 v0 = __builtin_amdgcn_ds_read_tr16_b64_v4i16((LAS s16x4*)vp2);
                const s16x4 v1 = __builtin_amdgcn_ds_read_tr16_b64_v4i16((LAS s16x4*)(vp2 + 4 * ML_VROW));
                vfr[nn][ks] = (bf16x8){v0[0], v0[1], v0[2], v0[3], v1[0], v1[1], v1[2], v1[3]};
            }
#pragma unroll
        for (int m = 0; m < 4; ++m)
#pragma unroll
            for (int ks = 0; ks < 2; ++ks) {
                const bf16x8 sf = *(LAS bf16x8*)(lds + ML_S + (m * 16 + l15) * ML_SROW + ks * 64 + q4 * 16);
                acc[m][0] = __builtin_amdgcn_mfma_f32_16x16x32_bf16(sf, vfr[0][ks], acc[m][0], 0, 0, 0);
                acc[m][1] = __builtin_amdgcn_mfma_f32_16x16x32_bf16(sf, vfr[1][ks], acc[m][1], 0, 0, 0);
            }
        {
            LAS float* rdw = (LAS float*)(lds + ML_RD) + wid * 64;
            rdw[lane] = rden;
#pragma unroll
            for (int m = 0; m < 4; ++m) {
                const f32x4 rd = *(LAS f32x4*)(rdw + m * 16 + 4 * q4);
#pragma unroll
                for (int r = 0; r < 4; ++r) {
                    LAS bf16_t* hp = (LAS bf16_t*)(lds + ML_H + (m * 16 + 4 * q4 + r) * ML_HROW) + (2 * wid) * 16 + l15;
                    hp[0] = (bf16_t)(pk2(acc[m][0][r] * rd[r], 0.f) & 0xffffu);
                    hp[16] = (bf16_t)(pk2(acc[m][1][r] * rd[r], 0.f) & 0xffffu);
                }
            }
        }
        if (t + 1 < 36) issue(t + 1);
        {
            bf16x8 vw[2][2];
#pragma unroll
            for (int ks = 0; ks < 2; ++ks) {
                const f32x4 w0 = *(LAS f32x4*)(wsarr + 32 * ks + 8 * q4), w1 = *(LAS f32x4*)(wsarr + 32 * ks + 8 * q4 + 4);
#pragma unroll
                for (int nn = 0; nn < 2; ++nn) {
                    union { bf16x8 v; unsigned u[4]; } x; x.v = vfr[nn][ks];
                    x.u[0] = pk2(lo_bf(x.u[0]) * w0[0], hi_bf(x.u[0]) * w0[1]); x.u[1] = pk2(lo_bf(x.u[1]) * w0[2], hi_bf(x.u[1]) * w0[3]);
                    x.u[2] = pk2(lo_bf(x.u[2]) * w1[0], hi_bf(x.u[2]) * w1[1]); x.u[3] = pk2(lo_bf(x.u[3]) * w1[2], hi_bf(x.u[3]) * w1[3]);
                    vw[nn][ks] = x.v;
                }
            }
#pragma unroll
            for (int dk = 0; dk < 8; ++dk) {
                C[dk][0] *= w_c; C[dk][1] *= w_c;
#pragma unroll
                for (int ks = 0; ks < 2; ++ks) {
                    LAS unsigned char* kp2 = lds + ML_K + (32 * ks + 8 * q4 + (l15 >> 2)) * ML_KROW + (dk * 16 + (l15 & 3) * 4) * 2;
                    const s16x4 k0 = __builtin_amdgcn_ds_read_tr16_b64_v4i16((LAS s16x4*)kp2);
                    const s16x4 k1 = __builtin_amdgcn_ds_read_tr16_b64_v4i16((LAS s16x4*)(kp2 + 4 * ML_KROW));
                    const bf16x8 kf = {k0[0], k0[1], k0[2], k0[3], k1[0], k1[1], k1[2], k1[3]};
                    C[dk][0] = __builtin_amdgcn_mfma_f32_16x16x32_bf16(kf, vw[0][ks], C[dk][0], 0, 0, 0);
                    C[dk][1] = __builtin_amdgcn_mfma_f32_16x16x32_bf16(kf, vw[1][ks], C[dk][1], 0, 0, 0);
                }
            }
        }
        mstate = bL + ML;
        __syncthreads();
        {
            bf16_t* hb = (dir == 0 ? p->YB : p->HB);
#pragma unroll
            for (int i = 0; i < 4; ++i) {
                const int j = vrow + 16 * i;
                const u32x4 v = *(LAS u32x4*)(lds + ML_H + j * ML_HROW + vch * 16);
                *(u32x4*)(hb + grow_of(pb, j) * 1024 + hd * 256 + vch * 8) = v;
            }
        }
    }
}

__device__ __forceinline__ void phase_mlfinish(CP p, int L, int bid, int nb) {
    const int lane = ltid() & 63, wid = ltid() >> 6;
    const int RG = p->G * SALL;
    const float* ng = p->ml_norm_g + L * 1024;
    for (int r = bid * 8 + wid; r < RG; r += nb * 8) {
        if (L == 1 && (r % SALL) < CTXL) continue;
        u32x2 a[4], b2[4], ov[4];
#pragma unroll
        for (int hh = 0; hh < 4; ++hh) {
            const int col = hh * 256 + lane * 4;
            a[hh] = *(const u32x2*)(p->YB + (size_t)r * 1024 + col); b2[hh] = *(const u32x2*)(p->HB + (size_t)r * 1024 + col); ov[hh] = mk2(*(const unsigned*)(p->MO8 + (size_t)r * 1024 + col), 0u);
        }
#pragma unroll
        for (int hh = 0; hh < 4; ++hh) {
            const int col = hh * 256 + lane * 4;
            float v[4] = {lo_bf(a[hh].x) + lo_bf(b2[hh].x), hi_bf(a[hh].x) + hi_bf(b2[hh].x), lo_bf(a[hh].y) + lo_bf(b2[hh].y), hi_bf(a[hh].y) + hi_bf(b2[hh].y)};
            const float ss = wave_sum(v[0] * v[0] + v[1] * v[1] + v[2] * v[2] + v[3] * v[3]);
            const float rstd = rsqrtf(ss * (1.0f / 256.0f) + 1e-6f);
            const float4 g = *(const float4*)(ng + col);
            const f32x2 q0 = __builtin_amdgcn_cvt_pk_f32_fp8((int)ov[hh].x, false), q1 = __builtin_amdgcn_cvt_pk_f32_fp8((int)ov[hh].x, true);
            const float o0 = sigmoidf_(q0[0]), o1 = sigmoidf_(q0[1]), o2 = sigmoidf_(q1[0]), o3 = sigmoidf_(q1[1]);
            if (MERGE_F8) { int w8 = 0; w8 = __builtin_amdgcn_cvt_pk_fp8_f32(v[0] * rstd * g.x * o0, v[1] * rstd * g.y * o1, w8, false); w8 = __builtin_amdgcn_cvt_pk_fp8_f32(v[2] * rstd * g.z * o2, v[3] * rstd * g.w * o3, w8, true); *(unsigned*)(p->YB8 + (size_t)r * 1024 + col) = (unsigned)w8; }
            else *(u32x2*)(p->YB + (size_t)r * 1024 + col) = mk2(pk2(v[0] * rstd * g.x * o0, v[1] * rstd * g.y * o1), pk2(v[2] * rstd * g.z * o2, v[3] * rstd * g.w * o3));
        }
    }
}

constexpr int LSEG = 128, LNSEG = SALL / LSEG, LCTXSEG = CTXL / LSEG, LMT = LSEG / 16;
constexpr int LC_XA = 0, LC_ROW = 272, LC_UB = LC_XA + (LSEG + 4) * LC_ROW, LC_HB = LC_UB + LSEG * LC_ROW, LC_CW = LC_HB + LSEG * LC_ROW, LC_END = LC_CW + 5 * 128 * 4;
static_assert(LC_END <= 131072, "LRU LDS");
template <int D>
__device__ __forceinline__ void lru_scan16(float (&a)[LMT][4], float (&b)[LMT][4]) {
#pragma unroll
    for (int m = 0; m < LMT; ++m)
#pragma unroll
        for (int j = 0; j < 4; ++j) {
            float av = a[m][j], bv = b[m][j], ap, bp;
            if (D == 0) { ap = dppf<0x111>(1.0f, av); bp = dppf<0x111>(0.0f, bv); } else { ap = dppf<0x101>(1.0f, av); bp = dppf<0x101>(0.0f, bv); }
            bv = av * bp + bv; av = av * ap;
            if (D == 0) { ap = dppf<0x112>(1.0f, av); bp = dppf<0x112>(0.0f, bv); } else { ap = dppf<0x102>(1.0f, av); bp = dppf<0x102>(0.0f, bv); }
            bv = av * bp + bv; av = av * ap;
            if (D == 0) { ap = dppf<0x114>(1.0f, av); bp = dppf<0x114>(0.0f, bv); } else { ap = dppf<0x104>(1.0f, av); bp = dppf<0x104>(0.0f, bv); }
            bv = av * bp + bv; av = av * ap;
            if (D == 0) { ap = dppf<0x118>(1.0f, av); bp = dppf<0x118>(0.0f, bv); } else { ap = dppf<0x108>(1.0f, av); bp = dppf<0x108>(0.0f, bv); }
            bv = av * bp + bv; av = av * ap;
            a[m][j] = av; b[m][j] = bv;
        }
}
template <int D>
__device__ __forceinline__ void lru_chain_dir(CP p, int L, LAS unsigned char* lds, int bl, int hb) {
    const int tid = ltid(), lane = tid & 63, wid = tid >> 6, q4 = lane >> 4, l15 = lane & 15;
    const size_t rowbase = (size_t)bl * SALL;
    LAS float* cwl = (LAS float*)(lds + LC_CW);
    __syncthreads();
    for (int e = tid; e < 5 * 128; e += NTHREADS) { const int j = e >> 7, ch = e & 127; cwl[e] = (j < 4) ? p->conv_w[((size_t)L * 4 + j) * 1024 + hb * 128 + ch] : p->conv_b[L * 1024 + hb * 128 + ch]; }
    bf16x8 wf[2][4];
    {
        const int cq = wid >> 1, n0 = wid & 1;
        const bf16_t* wb = p->bt_lru + ((size_t)(D * 8 + hb) * 256 + cq * 64 + n0 * 16 + l15) * 128 + q4 * 8;
#pragma unroll
        for (int g = 0; g < 2; ++g)
#pragma unroll
            for (int ks = 0; ks < 4; ++ks) wf[g][ks] = *(const bf16x8*)(wb + (size_t)g * 32 * 128 + ks * 32);
    }
    const int chb = wid * 16 + 4 * q4, gch = hb * 128 + chb;
    const f32x4 ba = *(const f32x4*)(p->lru_ba + (L * 2 + D) * 1024 + gch), bx = *(const f32x4*)(p->lru_bx + (L * 2 + D) * 1024 + gch);
    f32x4 sp;
    { const f32x4 lam = *(const f32x4*)(p->lru_lam + (L * 2 + D) * 1024 + gch);
#pragma unroll
      for (int j = 0; j < 4; ++j) { const float z = -lam[j]; sp[j] = -8.0f * (fmaxf(z, 0.f) + log1pf(__expf(-fabsf(z)))); } }
    float carry[4] = {0.f, 0.f, 0.f, 0.f};
    const int t = tid >> 3, c8 = tid & 7;
    const bf16_t* pbase = p->P + rowbase * PWID + PC_XA + hb * 128;
    bf16_t* obase = (D == 0 ? p->YA : p->HB2) + rowbase * 1024 + hb * 128;
    pbase = uni_ptr(pbase); obase = uni_ptr(obase);
    u32x4 x0[2], x1[2], h0, h1;
    auto seg_of = [&](int s) -> int { return D == 0 ? s : (s < LCTXSEG ? LCTXSEG - 1 - s : LNSEG + LCTXSEG - 1 - s); };
    auto issue = [&](int s) {
        const int seg = seg_of(s), pb = seg * LSEG, lo = (seg < LCTXSEG) ? 0 : CTXL, hi = (seg < LCTXSEG) ? CTXL : SALL;
        const int tid = ltid(), t = tid >> 3, c8 = tid & 7;
#pragma unroll
        for (int i = 0; i < 2; ++i) { const bf16_t* xr = (const bf16_t*)((const char*)pbase + (unsigned)(((pb + t + 64 * i) * PWID + c8 * 16) * 2)); x0[i] = *(const u32x4*)xr; x1[i] = *(const u32x4*)(xr + 8); }
        h0 = mk4(0u, 0u, 0u, 0u); h1 = h0;
        if (tid < 24) {
            const int pos = (t < 2) ? (pb - 2 + t) : (pb + LSEG);
            if (pos >= lo && pos < hi) { const bf16_t* hr = (const bf16_t*)((const char*)pbase + (unsigned)((pos * PWID + c8 * 16) * 2)); h0 = *(const u32x4*)hr; h1 = *(const u32x4*)(hr + 8); }
        }
    };
    issue(0);
    for (int s = 0; s < LNSEG; ++s) {
        const int seg = seg_of(s), pb = seg * LSEG;
        const int tid = ltid(), lane = tid & 63, q4 = lane >> 4, l15 = lane & 15, t = tid >> 3, c8 = tid & 7, chb = wid * 16 + 4 * q4;
        (void)lane;
#pragma unroll
        for (int i = 0; i < 2; ++i) { *(LAS u32x4*)(lds + LC_XA + (t + 64 * i + 2) * LC_ROW + c8 * 32) = x0[i]; *(LAS u32x4*)(lds + LC_XA + (t + 64 * i + 2) * LC_ROW + c8 * 32 + 16) = x1[i]; }
        if (tid < 24) { const int lr = (t < 2) ? t : (LSEG + 2); *(LAS u32x4*)(lds + LC_XA + lr * LC_ROW + c8 * 32) = h0; *(LAS u32x4*)(lds + LC_XA + lr * LC_ROW + c8 * 32 + 16) = h1; }
        if (s + 1 < LNSEG) issue(s + 1);
        __syncthreads();
        {
            const int cg = tid & 31, r0c = (tid >> 5) * 8;
            f32x4 cwr[5];
#pragma unroll
            for (int j = 0; j < 5; ++j) cwr[j] = *(LAS f32x4*)(cwl + j * 128 + cg * 4);
            float xw[4][4];
#pragma unroll
            for (int k = 0; k < 3; ++k) { const u32x2 a = *(LAS u32x2*)(lds + LC_XA + (r0c + k) * LC_ROW + cg * 8); xw[k][0] = lo_bf(a.x); xw[k][1] = hi_bf(a.x); xw[k][2] = lo_bf(a.y); xw[k][3] = hi_bf(a.y); }
#pragma unroll
            for (int k = 0; k < 8; ++k) {
                { const u32x2 a = *(LAS u32x2*)(lds + LC_XA + (r0c + k + 3) * LC_ROW + cg * 8); xw[(k + 3) & 3][0] = lo_bf(a.x); xw[(k + 3) & 3][1] = hi_bf(a.x); xw[(k + 3) & 3][2] = lo_bf(a.y); xw[(k + 3) & 3][3] = hi_bf(a.y); }
                float u[4];
#pragma unroll
                for (int i = 0; i < 4; ++i) u[i] = cwr[4][i] + cwr[0][i] * xw[k & 3][i] + cwr[1][i] * xw[(k + 1) & 3][i] + cwr[2][i] * xw[(k + 2) & 3][i] + cwr[3][i] * xw[(k + 3) & 3][i];
                *(LAS u32x2*)(lds + LC_UB + (r0c + k) * LC_ROW + cg * 8) = mk2(pk2(u[0], u[1]), pk2(u[2], u[3]));
            }
        }
        __syncthreads();
        float a[LMT][4], b[LMT][4];
#pragma unroll
        for (int m = 0; m < LMT; ++m) {
            f32x4 acc0 = (f32x4){0.f, 0.f, 0.f, 0.f}, acc1 = acc0;
#pragma unroll
            for (int ks = 0; ks < 4; ++ks) {
                const bf16x8 uu = *(LAS bf16x8*)(lds + LC_UB + (m * 16 + l15) * LC_ROW + ks * 64 + q4 * 16);
                acc0 = __builtin_amdgcn_mfma_f32_16x16x32_bf16(wf[0][ks], uu, acc0, 0, 0, 0);
                acc1 = __builtin_amdgcn_mfma_f32_16x16x32_bf16(wf[1][ks], uu, acc1, 0, 0, 0);
            }
            const u32x2 uv = *(LAS u32x2*)(lds + LC_UB + (m * 16 + l15) * LC_ROW + chb * 2);
            const float uf4[4] = {lo_bf(uv.x), hi_bf(uv.x), lo_bf(uv.y), hi_bf(uv.y)};
#pragma unroll
            for (int j = 0; j < 4; ++j) {
                const float rr = __builtin_amdgcn_rcpf(1.0f + __expf(-(acc0[j] + ba[j]))), ii = __builtin_amdgcn_rcpf(1.0f + __expf(-(acc1[j] + bx[j])));
                const float av = __expf(rr * sp[j]);
                a[m][j] = av; b[m][j] = __builtin_amdgcn_sqrtf(fmaxf(1.0f - av * av, 0.f)) * ii * uf4[j];
            }
        }
        lru_scan16<D>(a, b);
#pragma unroll
        for (int j = 0; j < 4; ++j) {
            float h = carry[j];
#pragma unroll
            for (int mi = 0; mi < LMT; ++mi) {
                const int m = (D == 0) ? mi : LMT - 1 - mi;
                const float hv = a[m][j] * h + b[m][j];
                b[m][j] = hv;
                h = (D == 0) ? dppf<0x15F>(0.f, hv) : dppf<0x150>(0.f, hv);
            }
            carry[j] = h;
        }
#pragma unroll
        for (int m = 0; m < LMT; ++m) *(u32x2*)((char*)obase + (unsigned)(((pb + m * 16 + l15) * 1024 + chb) * 2)) = mk2(pk2(b[m][0], b[m][1]), pk2(b[m][2], b[m][3]));
    }
}
__device__ __forceinline__ void lru_chain_unit(CP p, int L, LAS unsigned char* lds, int bl, int hb, int d) {
    if (d == 0) lru_chain_dir<0>(p, L, lds, bl, hb); else lru_chain_dir<1>(p, L, lds, bl, hb);
}
__device__ __forceinline__ void phase_lrufinish(CP p, int L, int bid, int nb) {
    const int tid = ltid();
    const int nv = (L == 0) ? p->G * SALL : p->G * SEQ;
    const long total = (long)nv * 128, stride = (long)nb * NTHREADS;
    for (long e0 = (long)bid * NTHREADS + tid; e0 < total; e0 += 2 * stride) {
        u32x4 hf[2], hb[2], ga[2]; size_t off[2]; bool ok[2];
#pragma unroll
        for (int k = 0; k < 2; ++k) {
            const long e = e0 + k * stride; ok[k] = e < total;
            const int i = (int)((ok[k] ? e : e0) >> 7), c = (int)((ok[k] ? e : e0) & 127) * 8;
            const int r = (L == 0) ? i : ((i >> 11) * SALL + CTXL + (i & 2047));
            off[k] = (size_t)r * 1024 + c;
            hf[k] = *(const u32x4*)(p->YA + off[k]); hb[k] = *(const u32x4*)(p->HB2 + off[k]); ga[k] = *(const u32x4*)(p->P + (size_t)r * PWID + PC_GA + c);
        }
#pragma unroll
        for (int k = 0; k < 2; ++k) {
            if (!ok[k]) continue;
            u32x4 o;
            o.x = pk2(gelu_tanh(lo_bf(ga[k].x)) * (lo_bf(hf[k].x) + lo_bf(hb[k].x)), gelu_tanh(hi_bf(ga[k].x)) * (hi_bf(hf[k].x) + hi_bf(hb[k].x)));
            o.y = pk2(gelu_tanh(lo_bf(ga[k].y)) * (lo_bf(hf[k].y) + lo_bf(hb[k].y)), gelu_tanh(hi_bf(ga[k].y)) * (hi_bf(hf[k].y) + hi_bf(hb[k].y)));
            o.z = pk2(gelu_tanh(lo_bf(ga[k].z)) * (lo_bf(hf[k].z) + lo_bf(hb[k].z)), gelu_tanh(hi_bf(ga[k].z)) * (hi_bf(hf[k].z) + hi_bf(hb[k].z)));
            o.w = pk2(gelu_tanh(lo_bf(ga[k].w)) * (lo_bf(hf[k].w) + lo_bf(hb[k].w)), gelu_tanh(hi_bf(ga[k].w)) * (hi_bf(hf[k].w) + hi_bf(hb[k].w)));
            *(u32x4*)(p->YA + off[k]) = o;
        }
    }
}

__device__ __forceinline__ int next_unit(unsigned* ctr, LAS unsigned char* lds) {
    LAS int* slot = (LAS int*)(lds + LDS_BYTES - 32);
    __syncthreads();
    if (ltid() == 0) *slot = (int)__hip_atomic_fetch_add(ctr, 1u, __ATOMIC_RELAXED, __HIP_MEMORY_SCOPE_AGENT);
    __syncthreads();
    return __builtin_amdgcn_readfirstlane(*slot);
}
__device__ __forceinline__ void phase_probe_at(CP p, int L, LAS unsigned char* lds, int bid, int nb) {
    const int nqt = (L == 0) ? 9 : 8, nat = p->G * 8 * nqt;
    for (int u = bid; u < nat; u += nb) { const int qt = u % nqt, bh = u / nqt; attn_unit2(p, L, lds, bh >> 3, bh & 7, qt); }
}
__device__ __forceinline__ void phase_probe_lru(CP p, int L, LAS unsigned char* lds, int bid, int nb) {
    for (int v = bid; v < p->G * 16; v += nb) lru_chain_unit(p, L, lds, v >> 4, (v >> 1) & 7, v & 1);
}
__device__ __forceinline__ void phase_probe_ml(CP p, int L, LAS unsigned char* lds, int bid, int nb) {
    for (int u = bid; u < p->G * 8; u += nb) mlstm_unit(p, L, lds, u >> 3, (u >> 1) & 3, u & 1);
}
__device__ __forceinline__ void phase_mix_dyn(CP p, int L, int grp, LAS unsigned char* lds, int cofs = 0) {
    unsigned* ctr = (unsigned*)p->ecnt + 128 + (L * 8 + grp) * 4 + cofs;
    const int nml = p->G * 8, nqt = (L == 0) ? 9 : 8, nat = p->G * 8 * nqt, nlr = p->G * 16;
    int u = next_unit(ctr, lds);
    while (u < nml) { mlstm_unit(p, L, lds, u >> 3, (u >> 1) & 3, u & 1); u = next_unit(ctr, lds); }
    while (u < nml + nlr) { const int v = u - nml; lru_chain_unit(p, L, lds, v >> 4, (v >> 1) & 7, v & 1); u = next_unit(ctr, lds); }
    while (u < nml + nlr + nat) { const int v = u - nml - nlr; const int nlat = p->G * 64; const int qt = (v < nlat) ? (v & 7) : 8, bh = (v < nlat) ? (v >> 3) : (v - nlat);
        attn_unit2(p, L, lds, bh >> 3, bh & 7, qt); u = next_unit(ctr, lds); }
}
__device__ __forceinline__ int vidx_to_r(int L, int i) { return L == 0 ? i : ((i >> 11) * SALL + CTXL + (i & 2047)); }
__device__ __forceinline__ float* xrow_ptr(CP p, int grp, int r, int L, const float*& md) {
    const int bl = r / SALL, pos = r - bl * SALL, b = grp * p->G + bl;
    if (pos < CTXL) { md = p->mods_c + (size_t)L * 6144; return p->XC1 + ((size_t)b * CTXL + pos) * 1024; }
    md = p->mods_l + ((size_t)L * 32 + b) * 6144; return p->out + ((size_t)b * SEQ + (pos - CTXL)) * 1024;
}
constexpr int RCH = 32, RPICK = RCH * 6;
constexpr int RT_H = 0, RT_HROW = 1028, RT_PART = 16 * RT_HROW * 4, RT_PICK = RT_PART + 8 * 16 * 64 * 4, RT_END = RT_PICK + RPICK * 12;
__device__ __forceinline__ void split_bf(float a0, float a1, unsigned& hi, unsigned& lo) { hi = pk2(a0, a1); lo = pk2(a0 - lo_bf(hi), a1 - hi_bf(hi)); }
__device__ __forceinline__ void phase_route1(CP p, int L, int grp, LAS unsigned char* lds, int bid, int nb) {
    const int tid = ltid(), lane = tid & 63, wid = tid >> 6, q4 = lane >> 4, l15 = lane & 15;
    LAS float* hs = (LAS float*)(lds + RT_H);
    LAS float* part = (LAS float*)(lds + RT_PART);
    LAS int* pick_e = (LAS int*)(lds + RT_PICK);
    LAS float* pick_w = (LAS float*)(pick_e + RPICK);
    LAS int* pick_r = (LAS int*)(pick_e + 2 * RPICK);
    const float* g2 = p->norm2_g + L * 1024;
    const float brv = p->b_router[L * 64 + lane];
    const float* wr = p->w_router + (size_t)L * 1024 * 64;
    const int nchunks = p->G * SALL / RCH;
    bf16x8 whi[4][4], wlo[4][4];
#pragma unroll
    for (int ks = 0; ks < 4; ++ks)
#pragma unroll
        for (int n = 0; n < 4; ++n) { unsigned h[4], l[4];
#pragma unroll
            for (int jj = 0; jj < 4; ++jj) { const float* wp = wr + (size_t)(wid * 128 + ks * 32 + q4 * 8 + 2 * jj) * 64 + n * 16 + l15; split_bf(wp[0], wp[64], h[jj], l[jj]); }
            whi[ks][n] = __builtin_bit_cast(bf16x8, mk4(h[0], h[1], h[2], h[3])); wlo[ks][n] = __builtin_bit_cast(bf16x8, mk4(l[0], l[1], l[2], l[3])); }
    const int cpb = SALL / RCH, cctx = CTXL / RCH;
#define RT_NEXT_VALID(cv) do { while ((cv) < nchunks && L == 1 && ((cv) % cpb) < cctx) { if (tid < 64) p->CC[(cv) * 64 + tid] = 0; (cv) += nb; } } while (0)
#define RT_LOAD(rbase) do { _Pragma("unroll") for (int rr = 0; rr < 2; ++rr) { const float* md_; const float* src_ = xrow_ptr(p, grp, (rbase) + rr, L, md_); \
        _Pragma("unroll") for (int i = 0; i < 4; ++i) v[rr][i] = *(const float4*)(src_ + i * 256 + lane * 4); } } while (0)
    int chunk = bid; RT_NEXT_VALID(chunk);
    float4 v[2][4];
    if (chunk < nchunks) RT_LOAD(chunk * RCH + wid * 2);
    while (chunk < nchunks) {
        int nchunk = chunk + nb; RT_NEXT_VALID(nchunk);
#pragma nounroll
        for (int sub = 0; sub < RCH / 16; ++sub) {
            const int r0 = chunk * RCH + sub * 16;
            __syncthreads();
            {
                float ss[2] = {0.f, 0.f};
#pragma unroll
                for (int rr = 0; rr < 2; ++rr)
#pragma unroll
                    for (int i = 0; i < 4; ++i) ss[rr] += v[rr][i].x * v[rr][i].x + v[rr][i].y * v[rr][i].y + v[rr][i].z * v[rr][i].z + v[rr][i].w * v[rr][i].w;
#pragma unroll
                for (int o = 32; o >= 1; o >>= 1) { ss[0] += sx_(ss[0], o); ss[1] += sx_(ss[1], o); }
#pragma unroll
                for (int rr = 0; rr < 2; ++rr) {
                    const int tl = wid * 2 + rr, r = r0 + tl;
                    const float* md; (void)xrow_ptr(p, grp, r, L, md);
                    const float rstd = rsqrtf(ss[rr] * (1.0f / 1024.0f) + 1e-6f);
#pragma unroll
                    for (int i = 0; i < 4; ++i) {
                        const int col = i * 256 + lane * 4;
                        const float4 g = *(const float4*)(g2 + col), sh = *(const float4*)(md + 3072 + col), sc = *(const float4*)(md + 4096 + col);
                        const float o0 = v[rr][i].x * rstd * g.x * (1.f + sc.x) + sh.x, o1 = v[rr][i].y * rstd * g.y * (1.f + sc.y) + sh.y;
                        const float o2 = v[rr][i].z * rstd * g.z * (1.f + sc.z) + sh.z, o3 = v[rr][i].w * rstd * g.w * (1.f + sc.w) + sh.w;
                        { int w8 = 0; w8 = __builtin_amdgcn_cvt_pk_fp8_f32(o0, o1, w8, false); w8 = __builtin_amdgcn_cvt_pk_fp8_f32(o2, o3, w8, true); *(unsigned*)((unsigned char*)p->H2 + (size_t)r * 1024 + col) = (unsigned)w8; }
                        *(LAS f32x4*)(hs + tl * RT_HROW + col) = (f32x4){o0, o1, o2, o3};
                    }
                }
                if (sub == 0) RT_LOAD(r0 + 16 + wid * 2); else if (nchunk < nchunks) RT_LOAD(nchunk * RCH + wid * 2);
            }
            __syncthreads();
            {
                f32x4 lg[4];
#pragma unroll
                for (int n = 0; n < 4; ++n) lg[n] = (f32x4){0.f, 0.f, 0.f, 0.f};
#pragma unroll
                for (int ks = 0; ks < 4; ++ks) {
                    const LAS float* hp = hs + l15 * RT_HROW + wid * 128 + ks * 32 + q4 * 8;
                    const f32x4 x0 = *(const LAS f32x4*)hp, x1 = *(const LAS f32x4*)(hp + 4);
                    unsigned h[4], l[4];
                    split_bf(x0[0], x0[1], h[0], l[0]); split_bf(x0[2], x0[3], h[1], l[1]); split_bf(x1[0], x1[1], h[2], l[2]); split_bf(x1[2], x1[3], h[3], l[3]);
                    const bf16x8 ah = __builtin_bit_cast(bf16x8, mk4(h[0], h[1], h[2], h[3])), al = __builtin_bit_cast(bf16x8, mk4(l[0], l[1], l[2], l[3]));
#pragma unroll
                    for (int n = 0; n < 4; ++n) {
                        lg[n] = __builtin_amdgcn_mfma_f32_16x16x32_bf16(al, whi[ks][n], lg[n], 0, 0, 0);
                        lg[n] = __builtin_amdgcn_mfma_f32_16x16x32_bf16(ah, wlo[ks][n], lg[n], 0, 0, 0);
                        lg[n] = __builtin_amdgcn_mfma_f32_16x16x32_bf16(ah, whi[ks][n], lg[n], 0, 0, 0);
                    }
                }
#pragma unroll
                for (int n = 0; n < 4; ++n)
#pragma unroll
                    for (int r = 0; r < 4; ++r) part[(wid * 16 + 4 * q4 + r) * 64 + n * 16 + l15] = lg[n][r];
            }
            __syncthreads();
            {
                float score[2], sel[2], ssum[2] = {0.f, 0.f}; int myrank[2] = {-1, -1};
#pragma unroll
                for (int rr = 0; rr < 2; ++rr) {
                    const int tl = wid * 2 + rr; float lgt = 0.f;
#pragma unroll
                    for (int w8 = 0; w8 < 8; ++w8) lgt += part[(w8 * 16 + tl) * 64 + lane];
                    score[rr] = 1.0f / (1.0f + expf(-lgt)); sel[rr] = score[rr] + brv;
                }
#pragma unroll
                for (int k = 0; k < TOPK; ++k) {
#pragma unroll
                    for (int rr = 0; rr < 2; ++rr) {
                        float mv = sel[rr];
                        mv = fmaxf(mv, dppf<0x111>(-3.0e38f, mv)); mv = fmaxf(mv, dppf<0x112>(-3.0e38f, mv)); mv = fmaxf(mv, dppf<0x114>(-3.0e38f, mv)); mv = fmaxf(mv, dppf<0x118>(-3.0e38f, mv));
                        const float m0 = __builtin_bit_cast(float, __builtin_amdgcn_readlane(__builtin_bit_cast(int, mv), 15)), m1 = __builtin_bit_cast(float, __builtin_amdgcn_readlane(__builtin_bit_cast(int, mv), 31));
                        const float m2 = __builtin_bit_cast(float, __builtin_amdgcn_readlane(__builtin_bit_cast(int, mv), 47)), m3 = __builtin_bit_cast(float, __builtin_amdgcn_readlane(__builtin_bit_cast(int, mv), 63));
                        const float wm = fmaxf(fmaxf(m0, m1), fmaxf(m2, m3));
                        const unsigned long long bal = __ballot(sel[rr] == wm);
                        const int win = __ffsll((long long)bal) - 1;
                        ssum[rr] += __builtin_bit_cast(float, __builtin_amdgcn_readlane(__builtin_bit_cast(int, score[rr]), win));
                        if (lane == win) { myrank[rr] = k; sel[rr] = -1e30f; }
                    }
                }
#pragma unroll
                for (int rr = 0; rr < 2; ++rr)
                    if (myrank[rr] >= 0) { const int slot = (sub * 16 + wid * 2 + rr) * 6 + myrank[rr]; pick_e[slot] = lane; pick_w[slot] = score[rr] / ssum[rr] * 2.5f; }
            }
        }
        __syncthreads();
        {
            const int lane = ltid() & 63;
            const int e0 = pick_e[lane], e1 = pick_e[64 + lane], e2 = pick_e[128 + lane];
            int rk0 = 0, rk1 = 0, rk2 = 0, mycnt = 0;
#pragma unroll
            for (int x = 0; x < 8; ++x) {
                const int ex = wid * 8 + x;
                const unsigned long long m0 = __ballot(e0 == ex), m1 = __ballot(e1 == ex), m2 = __ballot(e2 == ex);
                const int c0 = __builtin_popcountll(m0), c1 = __builtin_popcountll(m1), c2 = __builtin_popcountll(m2);
                if (e0 == ex) rk0 = __builtin_amdgcn_mbcnt_hi((unsigned)(m0 >> 32), __builtin_amdgcn_mbcnt_lo((unsigned)m0, 0));
                if (e1 == ex) rk1 = c0 + __builtin_amdgcn_mbcnt_hi((unsigned)(m1 >> 32), __builtin_amdgcn_mbcnt_lo((unsigned)m1, 0));
                if (e2 == ex) rk2 = c0 + c1 + __builtin_amdgcn_mbcnt_hi((unsigned)(m2 >> 32), __builtin_amdgcn_mbcnt_lo((unsigned)m2, 0));
                if (lane == x) mycnt = c0 + c1 + c2;
            }
            if ((e0 >> 3) == wid) pick_r[lane] = rk0;
            if ((e1 >> 3) == wid) pick_r[64 + lane] = rk1;
            if ((e2 >> 3) == wid) pick_r[128 + lane] = rk2;
            if (lane < 8) p->CC[chunk * 64 + wid * 8 + lane] = mycnt;
        }
        __syncthreads();
        { const int s2 = ltid(); if (s2 < RPICK) { p->PE[(size_t)chunk * RPICK + s2] = pick_e[s2] | (pick_r[s2] << 8); p->PW[(size_t)chunk * RPICK + s2] = pick_w[s2]; } }
        chunk = nchunk;
    }
#undef RT_NEXT_VALID
#undef RT_LOAD
}
__device__ __forceinline__ void phase_route2(CP p, int L, LAS unsigned char* lds, int bid, int nb) {
    const int tid = ltid();
    LAS int* basel = (LAS int*)lds; LAS int* totl = basel + 256; LAS int* tabl = totl + 64; LAS int* pb = tabl + 128; LAS int* pt = pb + 4 * 512;
    const int nchunks = p->G * SALL / RCH;
    const int e = tid & 63, part = tid >> 6, per = (nchunks + 7) >> 3;
    __syncthreads();
    {
        int t = 0, b0 = 0, b1 = 0, b2 = 0, b3 = 0;
        const int k0 = bid, k1 = bid + nb, k2 = bid + 2 * nb, k3 = bid + 3 * nb;
        const int c0 = part * per, c1 = (c0 + per < nchunks) ? c0 + per : nchunks;
#pragma unroll 12
        for (int c = c0; c < c1; ++c) { const int v = p->CC[c * 64 + e]; t += v; b0 += (c < k0) ? v : 0; b1 += (c < k1) ? v : 0; b2 += (c < k2) ? v : 0; b3 += (c < k3) ? v : 0; }
        pt[part * 64 + e] = t; pb[part * 64 + e] = b0; pb[512 + part * 64 + e] = b1; pb[1024 + part * 64 + e] = b2; pb[1536 + part * 64 + e] = b3;
    }
    __syncthreads();
    if (tid < 64) {
        int t = 0, b[4] = {0, 0, 0, 0};
#pragma unroll
        for (int q = 0; q < 8; ++q) { t += pt[q * 64 + tid];
#pragma unroll
            for (int k = 0; k < 4; ++k) b[k] += pb[k * 512 + q * 64 + tid]; }
        totl[tid] = t;
#pragma unroll
        for (int k = 0; k < 4; ++k) basel[k * 64 + tid] = b[k];
        if (bid == 0) p->ecnt[tid] = t;
    }
    __syncthreads();
    if (tid == 0) { int acc = 0; for (int x = 0; x < 64; ++x) { tabl[x] = acc; acc += (totl[x] + 255) >> 8; } tabl[64] = acc; }
    __syncthreads();
    if (bid == 0) {
        const int dummy = (L == 0) ? 0 : CTXL;
        for (int x = tid; x < 64 * 256; x += NTHREADS) { const int ee = x >> 8, i = totl[ee] + (x & 255); if (i < (((totl[ee] + 255) >> 8) << 8)) { p->LIST[(size_t)tabl[ee] * 256 + i] = dummy; p->LISTW[(size_t)tabl[ee] * 256 + i] = 0.f; } }
    }
    {
        const int nv = (L == 0) ? p->G * SALL : p->G * SEQ; int* idl = p->LIST + (size_t)tabl[64] * 256;
        for (int i = bid * NTHREADS + tid; i < nv; i += nb * NTHREADS) idl[i] = vidx_to_r(L, i);
    }
    int kq = 0;
    for (int chunk = bid; chunk < nchunks; chunk += nb, ++kq) {
        if (L == 1 && (chunk % (SALL / RCH)) < (CTXL / RCH)) continue;
        for (int s2 = tid; s2 < RPICK; s2 += NTHREADS) {
            const int pe = p->PE[(size_t)chunk * RPICK + s2], ee = pe & 255, lr = pe >> 8;
            const int r = chunk * RCH + s2 / 6, pos = tabl[ee] * 256 + basel[kq * 64 + ee] + lr;
            p->LIST[pos] = r; p->LISTW[pos] = p->PW[(size_t)chunk * RPICK + s2];
            p->POS[(size_t)chunk * RPICK + s2] = pos;
        }
    }
}

constexpr int MOE_TAB = 131072;
__device__ __forceinline__ int moe_nshared(CP p, int L) { return L == 0 ? p->G * SALL : p->G * SEQ; }
__device__ __forceinline__ int moe_find(LAS int* tab, int tile) { int e = 0; for (int s = 64; s >= 1; s >>= 1) if (e + s <= 64 && tab[e + s] <= tile) e += s; return e; }
__device__ __forceinline__ void moe_table8(CP p, int L, LAS unsigned char* lds) {
    LAS int* tab = (LAS int*)(lds + MOE_TAB);
    __syncthreads();
    if (ltid() == 0) {
        int acc = 0;
        for (int e = 0; e < 65; ++e) { tab[e] = acc; const int c = (e < 64) ? p->ecnt[e] : moe_nshared(p, L); acc += (c + 255) >> 8; }
        tab[65] = acc;
    }
    __syncthreads();
}
__device__ __forceinline__ void phase_moe_combine(CP p, int L, int grp, LAS unsigned char* lds, int bid, int nb) {
    const int lane = ltid() & 63, wid = ltid() >> 6;
    moe_table8(p, L, lds);
    LAS int* tab = (LAS int*)(lds + MOE_TAB);
    const int nv = moe_nshared(p, L);
    const size_t sbase = (size_t)tab[64] * 256;
    const unsigned char* D8 = (const unsigned char*)p->DBUF;
    for (int i = bid * 8 + wid; i < nv; i += nb * 8) {
        const int r = vidx_to_r(L, i);
        const float* md; float* xr = xrow_ptr(p, grp, r, L, md);
        float a[16];
        u32x4 dv[7];
        int pos6[6];
#pragma unroll
        for (int k = 0; k < 6; ++k) pos6[k] = p->POS[(size_t)r * 6 + k];
        dv[0] = *(const u32x4*)(D8 + (sbase + i) * 1024 + lane * 16);
        f32x4 xv4[4], g4[4];
#pragma unroll
        for (int q = 0; q < 4; ++q) { xv4[q] = *(const f32x4*)(xr + lane * 16 + q * 4); g4[q] = *(const f32x4*)(md + 5120 + lane * 16 + q * 4); }
#pragma unroll
        for (int k = 0; k < 6; ++k) dv[k + 1] = *(const u32x4*)(D8 + (size_t)pos6[k] * 1024 + lane * 16);
#pragma unroll
        for (int q = 0; q < 16; ++q) a[q] = 0.f;
#pragma unroll
        for (int k = 0; k < 7; ++k)
#pragma unroll
            for (int w = 0; w < 4; ++w) {
                const f32x2 lo = __builtin_amdgcn_cvt_pk_f32_fp8((int)dv[k][w], false), hi = __builtin_amdgcn_cvt_pk_f32_fp8((int)dv[k][w], true);
                a[4 * w] += lo[0]; a[4 * w + 1] += lo[1]; a[4 * w + 2] += hi[0]; a[4 * w + 3] += hi[1];
            }
#pragma unroll
        for (int q = 0; q < 4; ++q) {
            const int col = lane * 16 + q * 4;
            const f32x4 g = g4[q];
            f32x4 xv = xv4[q];
            xv[0] += g[0] * a[4 * q] * D_ISCALE; xv[1] += g[1] * a[4 * q + 1] * D_ISCALE; xv[2] += g[2] * a[4 * q + 2] * D_ISCALE; xv[3] += g[3] * a[4 * q + 3] * D_ISCALE;
            *(f32x4*)(xr + col) = xv;
        }
    }
}

__device__ __forceinline__ int valid_tile(int L, int pmv) { return L == 0 ? pmv : ((pmv >> 3) * 9 + 1 + (pmv & 7)); }
struct SchedMerge { const char *Y, *B; size_t ystride; int nMv, L, G, c;
    __device__ __forceinline__ bool next(int i, pg8::Unit& u) const { int pmv, pn; if (!pg8::static_tile(i, G, c, nMv, 12, pmv, pn)) return false; const int pm = valid_tile(L, pmv), j = pn >> 2;
        u.pm = pm; u.pn = pn; u.tag = 0; u.rows = nullptr; u.a = Y + (size_t)j * ystride + (size_t)pm * 256 * 1024 * 2; u.b = B + (size_t)pn * 256 * 1024 * 2; return true; } };
struct SchedMerge8 { const char *YB8, *YC8, *B; int nMv, L, G, c;
    __device__ __forceinline__ bool next(int i, pg8::Unit& u) const { int pmv, q; if (!pg8::static_tile(i, G, c, nMv, 8, pmv, q)) return false; const int pm = valid_tile(L, pmv), pn = 4 + q, j = pn >> 2;
        u.pm = pm; u.pn = pn; u.tag = 0; u.rows = nullptr; u.a = (j == 1 ? YB8 : YC8) + (size_t)pm * 256 * 1024; u.b = B + (size_t)j * 1024 * 1024 * 2 + (size_t)(pn & 3) * 256 * 1024; return true; } };
struct SchedMerge0 { const char *Y, *B; int nMv, L, G, c;
    __device__ __forceinline__ bool next(int i, pg8::Unit& u) const { int pmv, pn; if (!pg8::static_tile(i, G, c, nMv, 4, pmv, pn)) return false; const int pm = valid_tile(L, pmv);
        u.pm = pm; u.pn = pn; u.tag = 0; u.rows = nullptr; u.a = Y + (size_t)pm * 256 * 1024 * 2; u.b = B + (size_t)pn * 256 * 1024 * 2; return true; } };
struct EpiBf16RowsS { static constexpr bool PERM = true; bf16_t* O; int ldo; float sc;
    __device__ __forceinline__ void operator()(const f32x4 (&acc)[2][2][4][2], const pg8::Unit& u, int wr, int wc, int fr, int fq) const {
        const size_t row0 = (size_t)u.pm * 256 + wr * 64 + fr;
#pragma unroll
        for (int ai = 0; ai < 2; ++ai)
#pragma unroll
            for (int m = 0; m < 4; ++m) { bf16_t* rowp = O + (row0 + ai * 128 + m * 16) * ldo + u.pn * 256 + wc * 32 + 8 * fq;
#pragma unroll
                for (int bj = 0; bj < 2; ++bj) { const f32x4 v0 = acc[ai][bj][m][0] * sc, v1 = acc[ai][bj][m][1] * sc;
                    *(u32x4*)(rowp + bj * 128) = mk4(pk2(v0[0], v0[1]), pk2(v0[2], v0[3]), pk2(v1[0], v1[1]), pk2(v1[2], v1[3])); } }
    } };
struct EpiBf16Rows { static constexpr bool PERM = true; bf16_t* O; int ldo;
    __device__ __forceinline__ void operator()(const f32x4 (&acc)[2][2][4][2], const pg8::Unit& u, int wr, int wc, int fr, int fq) const {
        const size_t row0 = (size_t)u.pm * 256 + wr * 64 + fr;
#pragma unroll
        for (int ai = 0; ai < 2; ++ai)
#pragma unroll
            for (int m = 0; m < 4; ++m) { bf16_t* rowp = O + (row0 + ai * 128 + m * 16) * ldo + u.pn * 256 + wc * 32 + 8 * fq;
#pragma unroll
                for (int bj = 0; bj < 2; ++bj) { const f32x4 v0 = acc[ai][bj][m][0], v1 = acc[ai][bj][m][1];
                    *(u32x4*)(rowp + bj * 128) = mk4(pk2(v0[0], v0[1]), pk2(v0[2], v0[3]), pk2(v1[0], v1[1]), pk2(v1[2], v1[3])); } }
    } };
template <int SCALED>
struct EpiFp8RowsT { static constexpr bool PERM = true; unsigned char* O; int ldo;
    __device__ __forceinline__ void operator()(const f32x4 (&acc)[2][2][4][2], const pg8::Unit& u, int wr, int wc, int fr, int fq) const {
        constexpr float SC = SCALED == 1 ? pg8::F8_WINV : (SCALED == 2 ? D_SCALE / (ACT_SC * DW_SC) : 1.0f);
        unsigned char* tb = O + ((size_t)u.pm * 256) * ldo + u.pn * 256;
        const unsigned lo0 = (unsigned)(wr * 64 + fr) * (unsigned)ldo + wc * 32 + 8 * fq;
#pragma unroll
        for (int ai = 0; ai < 2; ++ai)
#pragma unroll
            for (int m = 0; m < 4; ++m) { unsigned char* rowp = tb + (lo0 + (unsigned)(ai * 128 + m * 16) * (unsigned)ldo);
#pragma unroll
                for (int bj = 0; bj < 2; ++bj) { const f32x4 v0 = acc[ai][bj][m][0] * SC, v1 = acc[ai][bj][m][1] * SC;
                    int w0 = 0, w1 = 0;
                    w0 = __builtin_amdgcn_cvt_pk_fp8_f32(v0[0], v0[1], w0, false); w0 = __builtin_amdgcn_cvt_pk_fp8_f32(v0[2], v0[3], w0, true);
                    w1 = __builtin_amdgcn_cvt_pk_fp8_f32(v1[0], v1[1], w1, false); w1 = __builtin_amdgcn_cvt_pk_fp8_f32(v1[2], v1[3], w1, true);
                    *(u32x2*)(rowp + bj * 128) = mk2((unsigned)w0, (unsigned)w1); } }
    } };
typedef EpiFp8RowsT<0> EpiFp8Rows;
__device__ __forceinline__ void phase_merge8(CP p, int L, LAS unsigned char* lds, int bid, int nb) {
    if constexpr (MERGE_F8) {
        { SchedMerge8 S{(const char*)p->YB8, (const char*)p->YC, (const char*)p->bt_br, (L == 0 ? p->G * 9 : p->G * 8), L, nb, bid};
          EpiFp8RowsT<1> E{(unsigned char*)p->Z + 2048 - 4 * 256, 6144};
          pg8::gemm_phase<false, true>(lds, 512, S, E); }
        { SchedMerge0 S{(const char*)p->YA, (const char*)p->bt_br, (L == 0 ? p->G * 9 : p->G * 8), L, nb, nb - 1 - bid};
          EpiBf16Rows E{p->Z, 3072};
          pg8::gemm_phase<false, false>(lds, 1024, S, E); }
        return;
    }
    SchedMerge S{(const char*)p->YA, (const char*)p->bt_br, (size_t)((const char*)p->YB - (const char*)p->YA), (L == 0 ? p->G * 9 : p->G * 8), L, nb, bid};
    EpiBf16Rows E{p->Z, 3072};
    pg8::gemm_phase<false, false>(lds, 1024, S, E);
}
__device__ __forceinline__ void phase_gate(CP p, int L, int bid, int nb) {
    const int lane = ltid() & 63, wid = ltid() >> 6;
    const int nv = (L == 0) ? p->G * SALL : p->G * SEQ;
    for (int i = bid * 8 + wid; i < nv; i += nb * 8) {
        const int r = (L == 0) ? i : ((i >> 11) * SALL + CTXL + (i & 2047));
        const bf16_t* z = p->Z + (size_t)r * 3072; const unsigned char* g = p->GP8 + (size_t)r * 3072;
        u32x4 zv[2][3]; u32x2 gv[2][3];
#pragma unroll
        for (int q = 0; q < 2; ++q)
#pragma unroll
            for (int j = 0; j < 3; ++j) { const int col = q * 512 + lane * 8; gv[q][j] = *(const u32x2*)(g + j * 1024 + col);
                if (MERGE_F8 && j > 0) { const u32x2 t8 = *(const u32x2*)((const unsigned char*)z + 2048 + (j - 1) * 1024 + col); zv[q][j] = mk4(t8.x, t8.y, 0u, 0u); }
                else zv[q][j] = *(const u32x4*)(z + j * 1024 + col); }
#pragma unroll
        for (int q = 0; q < 2; ++q) {
            const int col = q * 512 + lane * 8;
            float a[8] = {0.f, 0.f, 0.f, 0.f, 0.f, 0.f, 0.f, 0.f};
#pragma unroll
            for (int j = 0; j < 3; ++j) {
                const f32x2 g0 = __builtin_amdgcn_cvt_pk_f32_fp8((int)gv[q][j].x, false), g1 = __builtin_amdgcn_cvt_pk_f32_fp8((int)gv[q][j].x, true), g2 = __builtin_amdgcn_cvt_pk_f32_fp8((int)gv[q][j].y, false), g3 = __builtin_amdgcn_cvt_pk_f32_fp8((int)gv[q][j].y, true);
                float zf[8];
                if (MERGE_F8 && j > 0) { const f32x2 z0 = __builtin_amdgcn_cvt_pk_f32_fp8((int)zv[q][j].x, false), z1 = __builtin_amdgcn_cvt_pk_f32_fp8((int)zv[q][j].x, true), z2 = __builtin_amdgcn_cvt_pk_f32_fp8((int)zv[q][j].y, false), z3 = __builtin_amdgcn_cvt_pk_f32_fp8((int)zv[q][j].y, true);
                    zf[0] = z0[0]; zf[1] = z0[1]; zf[2] = z1[0]; zf[3] = z1[1]; zf[4] = z2[0]; zf[5] = z2[1]; zf[6] = z3[0]; zf[7] = z3[1]; }
                else { zf[0] = lo_bf(zv[q][j].x); zf[1] = hi_bf(zv[q][j].x); zf[2] = lo_bf(zv[q][j].y); zf[3] = hi_bf(zv[q][j].y); zf[4] = lo_bf(zv[q][j].z); zf[5] = hi_bf(zv[q][j].z); zf[6] = lo_bf(zv[q][j].w); zf[7] = hi_bf(zv[q][j].w); }
                a[0] += sigmoidf_(g0[0]) * zf[0]; a[1] += sigmoidf_(g0[1]) * zf[1]; a[2] += sigmoidf_(g1[0]) * zf[2]; a[3] += sigmoidf_(g1[1]) * zf[3];
                a[4] += sigmoidf_(g2[0]) * zf[4]; a[5] += sigmoidf_(g2[1]) * zf[5]; a[6] += sigmoidf_(g3[0]) * zf[6]; a[7] += sigmoidf_(g3[1]) * zf[7];
            }
            *(u32x4*)(p->H + (size_t)r * 1024 + col) = mk4(pk2(a[0], a[1]), pk2(a[2], a[3]), pk2(a[4], a[5]), pk2(a[6], a[7]));
        }
    }
}
struct SchedOut { const char *A, *B; int nMv, L, G, c;
    __device__ __forceinline__ bool next(int i, pg8::Unit& u) const { int pmv, pn; if (!pg8::static_tile(i, G, c, nMv, 4, pmv, pn)) return false; const int pm = valid_tile(L, pmv);
        u.pm = pm; u.pn = pn; u.tag = 0; u.rows = nullptr; u.a = A + (size_t)pm * 256 * 1024 * 2; u.b = B + (size_t)pn * 256 * 1024 * 2; return true; } };
struct EpiOut { static constexpr bool PERM = false; CP p; int L, grp;
    __device__ __forceinline__ void operator()(const f32x4 (&acc)[2][2][4][2], const pg8::Unit& u, int wr, int wc, int fr, int fq) const {
        const int bl = u.pm / 9, mloc = u.pm - bl * 9, b = grp * p->G + bl;
        const bool isctx = mloc == 0;
        const float* md = isctx ? (p->mods_c + (size_t)L * 6144 + 2048) : (p->mods_l + ((size_t)L * 32 + b) * 6144 + 2048);
        const int col0 = u.pn * 256 + wc * 32 + 4 * fq;
#pragma unroll
        for (int ai = 0; ai < 2; ++ai)
#pragma unroll
            for (int m = 0; m < 4; ++m) {
                const int pos = mloc * 256 + ai * 128 + wr * 64 + m * 16 + fr;
                const float* src; float* dst;
                if (isctx) { src = p->ctx + ((size_t)b * CTXL + pos) * 1024; dst = p->XC1 + ((size_t)b * CTXL + pos) * 1024; }
                else { const size_t o = ((size_t)b * SEQ + pos - CTXL) * 1024; src = (L == 0 ? p->x : p->out) + o; dst = p->out + o; }
#pragma unroll
                for (int bj = 0; bj < 2; ++bj)
#pragma unroll
                    for (int n = 0; n < 2; ++n) { const int col = col0 + bj * 128 + n * 16; const f32x4 xv = *(const f32x4*)(src + col), g = *(const f32x4*)(md + col); *(f32x4*)(dst + col) = xv + g * acc[ai][bj][m][n]; }
            }
    } };
__device__ __forceinline__ void phase_outproj8(CP p, int L, int grp, LAS unsigned char* lds, int bid, int nb) {
    SchedOut S{(const char*)p->H, (const char*)p->bt_out, (L == 0 ? p->G * 9 : p->G * 8), L, nb, bid};
    EpiOut E{p, L, grp};
    pg8::gemm_phase<false, false>(lds, 1024, S, E);
}
struct SchedMoeUp { CP p; LAS int* tab; int L, G, c;
    __device__ __forceinline__ bool next(int i, pg8::Unit& u) const { const int x = i * G + c, tile = (x >> 4) * 8 + (x & 7), nt = (x >> 3) & 1; if (tile >= __builtin_amdgcn_readfirstlane(tab[65])) return false;
        const int e = __builtin_amdgcn_readfirstlane(moe_find(tab, tile));
        u.pm = tile; u.pn = nt; u.tag = e;
        u.rows = p->LIST + (size_t)tile * 256; u.a = (const char*)p->H2;
        u.b = (const char*)p->bt_eup + ((size_t)e * 512 + nt * 256) * 1024; return true; } };
struct EpiMoeUp { static constexpr bool PERM = true; bf16_t* ACT; const float* W;
    __device__ __forceinline__ void operator()(const f32x4 (&acc)[2][2][4][2], const pg8::Unit& u, int wr, int wc, int fr, int fq) const {
        const size_t pos0 = (size_t)u.pm * 256 + wr * 64 + fr;
#pragma unroll
        for (int ai = 0; ai < 2; ++ai)
#pragma unroll
            for (int m = 0; m < 4; ++m) { const size_t pos = pos0 + ai * 128 + m * 16; const float w = ((u.tag < 64) ? W[pos] : 1.0f) * pg8::F8_WINV;
                float v[8];
#pragma unroll
                for (int n = 0; n < 2; ++n)
#pragma unroll
                    for (int j = 0; j < 4; ++j) { const float g = acc[ai][0][m][n][j] * pg8::F8_WINV; v[n * 4 + j] = g * __builtin_amdgcn_rcpf(1.0f + __expf(-g)) * acc[ai][1][m][n][j] * w; }
                if (DOWN_F8) { int w0 = 0, w1 = 0;
                    w0 = __builtin_amdgcn_cvt_pk_fp8_f32(v[0] * ACT_SC, v[1] * ACT_SC, w0, false); w0 = __builtin_amdgcn_cvt_pk_fp8_f32(v[2] * ACT_SC, v[3] * ACT_SC, w0, true);
                    w1 = __builtin_amdgcn_cvt_pk_fp8_f32(v[4] * ACT_SC, v[5] * ACT_SC, w1, false); w1 = __builtin_amdgcn_cvt_pk_fp8_f32(v[6] * ACT_SC, v[7] * ACT_SC, w1, true);
                    *(u32x2*)((unsigned char*)ACT + pos * 256 + u.pn * 128 + wc * 32 + 8 * fq) = mk2((unsigned)w0, (unsigned)w1); }
                else *(u32x4*)(ACT + pos * 256 + u.pn * 128 + wc * 32 + 8 * fq) = mk4(pk2(v[0], v[1]), pk2(v[2], v[3]), pk2(v[4], v[5]), pk2(v[6], v[7])); }
    } };
__device__ __forceinline__ void phase_moe_up8(CP p, int L, LAS unsigned char* lds, int bid, int nb) {
    moe_table8(p, L, lds);
    SchedMoeUp S{p, (LAS int*)(lds + MOE_TAB), L, nb, bid};
    EpiMoeUp E{p->ACT, p->LISTW};
    pg8::gemm_phase<true, true>(lds, 512, S, E);
}
struct SchedMoeDown { CP p; LAS int* tab; int G, c;
    __device__ __forceinline__ bool next(int i, pg8::Unit& u) const { const int x = i * G + c, tile = (x >> 5) * 8 + (x & 7), nt = (x >> 3) & 3; if (tile >= __builtin_amdgcn_readfirstlane(tab[65])) return false;
        const int e = __builtin_amdgcn_readfirstlane(moe_find(tab, tile));
        u.pm = tile; u.pn = nt; u.tag = e; u.rows = nullptr; u.a = (const char*)p->ACT + (size_t)tile * 256 * 256 * (DOWN_F8 ? 1 : 2); u.b = (const char*)p->bt_edn + ((size_t)e * 1024 + nt * 256) * 256 * (DOWN_F8 ? 1 : 2); return true; } };
__device__ __forceinline__ void phase_moe_down8(CP p, int L, LAS unsigned char* lds, int bid, int nb) {
    moe_table8(p, L, lds);
    SchedMoeDown S{p, (LAS int*)(lds + MOE_TAB), nb, bid};
    if constexpr (DOWN_F8) { EpiFp8RowsT<2> E{(unsigned char*)p->DBUF, 1024}; pg8::gemm_phase<false, true>(lds, 128, S, E); return; }
    EpiFp8Rows E{(unsigned char*)p->DBUF, 1024};
    pg8::gemm_phase<false, false>(lds, 256, S, E);
}

extern __shared__ __attribute__((aligned(16))) unsigned char smem_raw[];
#define XB_TMO      128
#define XB_XCNT(j)  (256  + 64 * (j))
#define XB_XSUB(j)  (1280 + 64 * (j))
#define XB_XGEN(j)  (2304 + 64 * (j))
#define XB_TOP      3328
#define XB_TOPGEN   3392
#define XCD_BAR_WORDS 3456
#define XB_SPIN_CAP (1u << 18)

__device__ __forceinline__ unsigned xb_ld(unsigned* p)              { return __hip_atomic_load(p, __ATOMIC_RELAXED, __HIP_MEMORY_SCOPE_AGENT); }
__device__ __forceinline__ unsigned xb_add(unsigned* p, unsigned v) { return __hip_atomic_fetch_add(p, v, __ATOMIC_RELAXED, __HIP_MEMORY_SCOPE_AGENT); }
__device__ __forceinline__ unsigned xb_xcc_id() { return (unsigned)__builtin_amdgcn_s_getreg((3 << 11) | 20) & 0xFu; }
#define XB_SPIN(cond, bar) do { unsigned _sp = 0; while (cond) { __builtin_amdgcn_s_sleep(1); \
    if ((++_sp & 255u) == 0u) { if (xb_ld(&(bar)[XB_TMO])) break; if (_sp > XB_SPIN_CAP) { atomicAdd(&(bar)[XB_TMO], 1u); break; } } } } while (0)

struct XcdBarrier {
    unsigned* bar; unsigned x;
    volatile LAS unsigned* st;
};

__device__ __forceinline__ XcdBarrier xcd_barrier_post(unsigned* bar, volatile LAS unsigned* st) {
    XcdBarrier b; b.bar = bar; b.x = xb_xcc_id(); b.st = st;
    if (threadIdx.x == 0) (void)xb_add(&bar[XB_XCNT(b.x)], 1u);
    return b;
}
__device__ __forceinline__ void xcd_barrier_complete(unsigned* bar, unsigned x, unsigned& nloc, unsigned& nx) {
    const unsigned G = gridDim.x * gridDim.y * gridDim.z;
    unsigned sum, cnt, mine, sp = 0u;
    for (;;) {
        sum = 0u; cnt = 0u; mine = 0u;
#pragma unroll
        for (unsigned j = 0; j < 16; ++j) { const unsigned c = xb_ld(&bar[XB_XCNT(j)]); sum += c; cnt += (c > 0u) ? 1u : 0u; mine = (j == x) ? c : mine; }
        if (sum == G) break;
        __builtin_amdgcn_s_sleep(1);
        if ((++sp & 255u) == 0u) { if (xb_ld(&bar[XB_TMO])) break; if (sp > XB_SPIN_CAP) { atomicAdd(&bar[XB_TMO], 1u); break; } }
    }
    nloc = mine > 0u ? mine : 1u; nx = cnt > 0u ? cnt : 1u;
}

__device__ __forceinline__ void xcd_barrier(const XcdBarrier& b) {
    asm volatile("s_waitcnt vmcnt(0)" ::: "memory");
    __syncthreads();
    if (threadIdx.x == 0) {
        unsigned* bar = b.bar;
        __builtin_amdgcn_s_waitcnt(0);
        unsigned nloc = b.st[0], nx = b.st[1];
        if (nloc == 0u) { xcd_barrier_complete(bar, b.x, nloc, nx); b.st[0] = nloc; b.st[1] = nx; }
        const unsigned old = xb_add(&bar[XB_XSUB(b.x)], 1u);
        const unsigned gen = old / nloc;
        if (old + 1u == (gen + 1u) * nloc) {
            __builtin_amdgcn_fence(__ATOMIC_RELEASE, "agent");
            asm volatile("s_waitcnt vmcnt(0)" ::: "memory");
            const unsigned og = xb_add(&bar[XB_TOP], 1u);
            const unsigned tg = og / nx;
            if (og + 1u == (tg + 1u) * nx) xb_add(&bar[XB_TOPGEN], 1u);
            else XB_SPIN(xb_ld(&bar[XB_TOPGEN]) == tg, bar);
            __builtin_amdgcn_fence(__ATOMIC_ACQUIRE, "agent");
            xb_add(&bar[XB_XGEN(b.x)], 1u);
            asm volatile("s_waitcnt vmcnt(0)" ::: "memory");
        } else {
            XB_SPIN(xb_ld(&bar[XB_XGEN(b.x)]) == gen, bar);
            __builtin_amdgcn_fence(__ATOMIC_ACQUIRE, "agent");
            asm volatile("s_waitcnt vmcnt(0)" ::: "memory");
        }
    }
    __syncthreads();
}


constexpr int XB_LDS_OFF = LDS_BYTES - 16;
#if MK_CG_SYNC
#define GBAR() cooperative_groups::this_grid().sync()
#else
#define GBAR() do { XcdBarrier b2_ = bar; asm volatile("" : "+s"(b2_.bar), "+s"(b2_.x)); xcd_barrier(b2_); } while (0)
#endif
#define PH(call) do { CP p = pk; int bid = bid0, nb = nb0, L = L0v, grp = grp0v; LAS unsigned char* lds = lds0; asm volatile("" : "+s"(p), "+s"(bid), "+s"(nb), "+s"(lds), "+s"(L), "+s"(grp)); (void)L; (void)grp; (void)bid; (void)nb; (void)lds; __syncthreads(); call; } while (0)
__global__ void __launch_bounds__(NTHREADS, 2) k_fused(Params p_) {
    CP pk = (CP)__builtin_amdgcn_kernarg_segment_ptr();
    LAS unsigned char* lds0 = (LAS unsigned char*)smem_raw;
    asm volatile("s_setreg_imm32_b32 hwreg(HW_REG_MODE, 23, 1), 1");
    const int bid0 = blockIdx.x, nb0 = gridDim.x;
    if (ltid() == 0) *(LAS u32x4*)(lds0 + XB_LDS_OFF) = mk4(0u, 0u, 0u, 0u);
    __syncthreads();
    XcdBarrier bar = xcd_barrier_post(pk->bar, (volatile LAS unsigned*)(lds0 + XB_LDS_OFF));
    int L0v = 0, grp0v = 0;
    PH(phase_mods(p, lds, bid, nb));
    for (L0v = 0; L0v < 2; ++L0v) {
        PH(phase_convert(p, L, lds, bid, nb));
        GBAR();
        const int ngroups = pk->ngroups;
        for (grp0v = 0; grp0v < ngroups; ++grp0v) {
            PH(phase_prenorm(p, L, grp, bid, nb));          GBAR();
            if (PROBE & 128) { PH(phase_prenorm(p, L, grp, bid, nb)); GBAR(); }
            PH(phase_inproj8(p, lds, bid, nb));             GBAR();
            if (PROBE & 1) { PH(phase_inproj8(p, lds, bid, nb)); GBAR(); }
            PH(phase_daprep(p, L, grp, bid, nb));           GBAR();
            PH(phase_mix_dyn(p, L, grp, lds));              GBAR();
            if (PROBE & 2) { PH(phase_mix_dyn(p, L, grp, lds, 1)); GBAR(); }
            if (PROBE & 4) { PH(phase_probe_at(p, L, lds, bid, nb)); GBAR(); }
            if (PROBE & 8) { PH(phase_probe_lru(p, L, lds, bid, nb)); GBAR(); }
            if (PROBE & 512) { PH(phase_probe_ml(p, L, lds, bid, nb)); GBAR(); }
            PH(phase_lrufinish(p, L, bid, nb));
            PH(phase_mlfinish(p, L, bid, nb));              GBAR();
            PH(phase_merge8(p, L, lds, bid, nb));           GBAR();
            PH(phase_gate(p, L, bid, nb));                  GBAR();
            if (PROBE & 64) { PH(phase_merge8(p, L, lds, bid, nb)); GBAR(); PH(phase_gate(p, L, bid, nb)); GBAR(); }
            PH(phase_outproj8(p, L, grp, lds, bid, nb));    GBAR();
            PH(phase_route1(p, L, grp, lds, bid, nb));      GBAR();
            PH(phase_route2(p, L, lds, bid, nb));           GBAR();
            if (PROBE & 16384) { PH(phase_route1(p, L, grp, lds, bid, nb)); GBAR(); }
            if (PROBE & 32768) { PH(phase_route2(p, L, lds, bid, nb)); GBAR(); }
            if (PROBE & 16) { PH(phase_route1(p, L, grp, lds, bid, nb)); GBAR(); PH(phase_route2(p, L, lds, bid, nb)); GBAR(); }
            PH(phase_moe_up8(p, L, lds, bid, nb));          GBAR();
            PH(phase_moe_down8(p, L, lds, bid, nb));        GBAR();
            if (PROBE & 32) { PH(phase_moe_up8(p, L, lds, bid, nb)); GBAR(); PH(phase_moe_down8(p, L, lds, bid, nb)); GBAR(); }
            if (PROBE & 2048) { PH(phase_moe_up8(p, L, lds, bid, nb)); GBAR(); }
            if (PROBE & 4096) { PH(phase_moe_down8(p, L, lds, bid, nb)); GBAR(); }
            if (PROBE & 256) { for (int z = 0; z < 12; ++z) GBAR(); }
            PH(phase_moe_combine(p, L, grp, lds, bid, nb)); GBAR();
        }
    }
}

static inline size_t align_up(size_t v, size_t a) { return (v + a - 1) / a * a; }

extern "C" void kernel_launch(void* const* d_in, const int* in_sizes, int n_in, void* d_out, int out_size, void* d_ws, size_t ws_size, hipStream_t stream) {
    (void)in_sizes; (void)n_in; (void)out_size;
    Params p; memset(&p, 0, sizeof(p));
    const float** f = (const float**)&p;
    for (int i = 0; i < 32; ++i) f[i] = (const float*)d_in[i];
    p.out = (float*)d_out;
    unsigned char* ws = (unsigned char*)d_ws;
    int G = 8;
    for (;;) {
        size_t o = 0;
        auto take = [&](size_t bytes) { size_t r = o; o = align_up(o + bytes, 256); return r; };
        const size_t RG = (size_t)G * SALL;
        const size_t o_bar = take(16384), o_ecnt = take(1024), o_lam = take(256), o_modsl = take((size_t)2 * 32 * 6144 * 4), o_modsc = take((size_t)2 * 6144 * 4), o_rope = take((size_t)2048 * 32 * 2 * 4);
        const size_t o_btin = take((size_t)BTIN_ROWS * 1024 * 2), o_btbr = take((size_t)3 * 1024 * 1024 * 2), o_btout = take((size_t)1024 * 1024 * 2);
        const size_t o_bteup = take((size_t)65 * 512 * 1024), o_btin8 = take((size_t)BTIN_ROWS * 1024), o_h8 = take(RG * 1024), o_yb8 = take(RG * 1024), o_mo8 = take(RG * 1024), o_btedn = take((size_t)65 * 1024 * 256 * 2), o_btlru = take((size_t)16 * 256 * 128 * 2);
        const size_t o_h = take(RG * 1024 * 2);
        size_t pbytes = RG * PWID * 2; const size_t actrows = (size_t)7 * RG + 65 * 256; const size_t actbytes = align_up(actrows * 256 * 2, 256); if (pbytes < actbytes + actrows * 1024 * 2) pbytes = actbytes + actrows * 1024 * 2;
        const size_t o_p = take(pbytes), o_gates = take(RG * 16 * 4);
        const size_t o_ya = take(RG * 1024 * 2), o_yb = take(RG * 1024 * 2), o_yc = take(RG * 1024 * 2), o_hb = take(RG * 1024 * 2);
        const size_t o_lsum = take((size_t)G * 2 * 36 * 1024 * 8), o_xc1 = take((size_t)TCTX * 1024 * 4);
        const size_t o_z = take(RG * 3072 * 2), o_hb2 = take(RG * 1024 * 2), o_gp8 = take(RG * 3072);
        const size_t o_list = take(actrows * 4), o_listw = take(actrows * 4), o_cc = take(RG / 32 * 64 * 4), o_pe = take(RG * 6 * 4), o_pw = take(RG * 6 * 4), o_pos = take(RG * 6 * 4);
        if (o > ws_size && G > 1) { G >>= 1; continue; }
        p.bar = (unsigned*)(ws + o_bar); p.ecnt = (int*)(ws + o_ecnt); p.lamv = (float*)(ws + o_lam); p.mods_l = (float*)(ws + o_modsl); p.mods_c = (float*)(ws + o_modsc); p.rope = (float*)(ws + o_rope);
        p.bt_in = (bf16_t*)(ws + o_btin); p.bt_br = (bf16_t*)(ws + o_btbr); p.bt_out = (bf16_t*)(ws + o_btout); p.bt_eup = (bf16_t*)(ws + o_bteup); p.bt_edn = (bf16_t*)(ws + o_btedn); p.bt_lru = (bf16_t*)(ws + o_btlru);
        p.H8 = ws + o_h8; p.bt_in8 = ws + o_btin8; p.YB8 = ws + o_yb8; p.MO8 = ws + o_mo8;
        p.H = (bf16_t*)(ws + o_h); p.P = (bf16_t*)(ws + o_p); p.ACT = p.P; p.GATES = (float*)(ws + o_gates);
        p.YA = (bf16_t*)(ws + o_ya); p.YB = (bf16_t*)(ws + o_yb); p.HB = (bf16_t*)(ws + o_hb); p.YC = (bf16_t*)(ws + o_yc);
        p.LSUM = (float*)(ws + o_lsum); p.XC1 = (float*)(ws + o_xc1); p.H2 = p.YA; p.LIST = (int*)(ws + o_list); p.LISTW = (float*)(ws + o_listw);
        p.DBUF = (bf16_t*)(ws + o_p + actbytes); p.Z = (bf16_t*)(ws + o_z); p.HB2 = (bf16_t*)(ws + o_hb2); p.GP8 = ws + o_gp8; p.CC = (int*)(ws + o_cc); p.PE = (int*)(ws + o_pe); p.PW = (float*)(ws + o_pw); p.POS = (int*)(ws + o_pos);
        break;
    }
    p.G = G; p.ngroups = NBATCH / G;
#if MK_ONE_LAUNCH
    static int grid1 = 0;
    if (!grid1) {
        (void)hipFuncSetAttribute((const void*)k_fused, hipFuncAttributeMaxDynamicSharedMemorySize, LDS_BYTES);
        int dev = 0, cus = 0, per_cu = 0;
        (void)hipGetDevice(&dev);
        (void)hipDeviceGetAttribute(&cus, hipDeviceAttributeMultiprocessorCount, dev);
        (void)hipOccupancyMaxActiveBlocksPerMultiprocessor(&per_cu, k_fused, NTHREADS, LDS_BYTES);
        grid1 = (per_cu >= 1) ? cus : 0;
    }
    (void)hipMemsetAsync(p.bar, 0, 16384 + 1024, stream);
#if MK_CG_SYNC
    if (grid1 > 0) { void* args[] = {&p}; (void)hipLaunchCooperativeKernel((const void*)k_fused, dim3(grid1), dim3(NTHREADS), args, LDS_BYTES, stream); }
#else
    if (grid1 > 0) hipLaunchKernelGGL(k_fused, dim3(grid1), dim3(NTHREADS), LDS_BYTES, stream, p);
#endif
    return;
#endif
}
```

```cpp
#include <hip/hip_runtime.h>
#include <stdint.h>
#include <string.h>
#include <stdio.h>
#include <hip/hip_cooperative_groups.h>

#define LAS __attribute__((address_space(3)))
typedef unsigned short bf16_t;
typedef short bf16x8 __attribute__((ext_vector_type(8)));
typedef short s16x4 __attribute__((ext_vector_type(4)));
typedef float f32x4 __attribute__((ext_vector_type(4)));
typedef __bf16 bf2_t __attribute__((ext_vector_type(2)));
typedef unsigned u32x4 __attribute__((ext_vector_type(4)));
typedef unsigned u32x2 __attribute__((ext_vector_type(2)));
typedef float f32x2 __attribute__((ext_vector_type(2)));
__host__ __device__ __forceinline__ u32x4 mk4(unsigned a, unsigned b, unsigned c, unsigned d) { u32x4 r = {a, b, c, d}; return r; }
__host__ __device__ __forceinline__ u32x2 mk2(unsigned a, unsigned b) { u32x2 r = {a, b}; return r; }

#ifndef MK_ONE_LAUNCH
#define MK_ONE_LAUNCH 1
#define PROBE 0
#ifndef MK_CG_SYNC
#define MK_CG_SYNC 0
#endif
#endif

constexpr int DM = 1024, NBATCH = 32, SEQ = 2048, CTXL = 256, SALL = 2304;
constexpr int TLAT = NBATCH * SEQ, TCTX = NBATCH * CTXL, TALL = TLAT + TCTX;
constexpr int PWID = 11264;
constexpr int BTIN_ROWS = 11520;
constexpr int NT_IN = 45;
constexpr int PC_XA = 0, PC_GA = 1024, PC_MQ = 2048, PC_MK = 2560, PC_MV = 3072, PC_MO = 4096, PC_DQ = 5120, PC_DK = 6144, PC_DV = 7168, PC_GATE = 8192;
constexpr int NEXP = 64, TOPK = 6;
#ifndef IN_F8_MASK_V
#define IN_F8_MASK_V 0x1FFFFFFFFF01ull
#endif
constexpr unsigned long long IN_F8_MASK = IN_F8_MASK_V, IN_BF_MASK = ~IN_F8_MASK & ((1ull << 45) - 1);
constexpr int IN_N8 = __builtin_popcountll(IN_F8_MASK), IN_NBF = 45 - IN_N8;
constexpr bool DOWN_F8 = true;
constexpr float ACT_SC = 4.0f, DW_SC = 128.0f;
constexpr bool MERGE_F8 = true;
constexpr float D_SCALE = 4.0f, D_ISCALE = 1.0f / 4.0f;
constexpr int LDS_BYTES = 147456;
constexpr int NTHREADS = 512;

struct Params {
    const float *x, *c, *ctx, *c_ctx, *norm1_g, *norm2_g, *w_ada, *b_ada, *w_in, *conv_w, *conv_b, *lru_wa, *lru_ba, *lru_wx, *lru_bx, *lru_lam,
        *ml_gate_b, *ml_norm_g, *da_qnorm_g, *da_knorm_g, *da_lambda, *da_subln_g, *w_branch, *w_out, *w_router, *b_router, *w_e_gate, *w_e_up,
        *w_e_down, *w_s_gate, *w_s_up, *w_s_down;
    float* out;
    unsigned* bar; int* ecnt; float* lamv; float* mods_l; float* mods_c; float* rope;
    bf16_t *bt_in, *bt_br, *bt_out, *bt_eup, *bt_edn, *bt_lru;
    bf16_t *H, *P, *YA, *YB, *HB, *YC; float* GATES; float* LSUM; float* XC1;
    bf16_t* H2; int* LIST; float* LISTW; bf16_t* ACT; bf16_t* DBUF; bf16_t* HB2; unsigned char* GP8; int* CC; int* PE; float* PW; int* POS; bf16_t* Z;
    int G; int ngroups;
    unsigned char* MO8;
    unsigned char* YB8;
    unsigned char* H8; unsigned char* bt_in8;
};

typedef const Params __attribute__((address_space(4))) * CP;
__device__ __forceinline__ int ltid() { int t = threadIdx.x; asm volatile("" : "+v"(t)); return t; }
__device__ __forceinline__ float bf2f(bf16_t b) { return __uint_as_float(((unsigned)b) << 16); }
__device__ __forceinline__ unsigned pk2(float lo, float hi) { bf2_t v = {(__bf16)lo, (__bf16)hi}; return __builtin_bit_cast(unsigned, v); }
__device__ __forceinline__ float lo_bf(unsigned u) { return __uint_as_float(u << 16); }
__device__ __forceinline__ float hi_bf(unsigned u) { return __uint_as_float(u & 0xffff0000u); }
__device__ __forceinline__ float sx_(float v, int mask) { return __builtin_bit_cast(float, __builtin_amdgcn_ds_bpermute(((ltid() & 63) ^ mask) << 2, __builtin_bit_cast(int, v))); }
__device__ __forceinline__ float sidx_(float v, int src) { return __builtin_bit_cast(float, __builtin_amdgcn_ds_bpermute(src << 2, __builtin_bit_cast(int, v))); }
__device__ __forceinline__ float sup_(float v, int o) { return __builtin_bit_cast(float, __builtin_amdgcn_ds_bpermute(((ltid() & 63) - o) << 2, __builtin_bit_cast(int, v))); }
template <int CTRL> __device__ __forceinline__ float dppf(float oldv, float v) { return __builtin_bit_cast(float, __builtin_amdgcn_update_dpp(__builtin_bit_cast(int, oldv), __builtin_bit_cast(int, v), CTRL, 0xf, 0xf, false)); }
__device__ __forceinline__ float wave_sum(float v) {
#pragma unroll
    for (int o = 32; o >= 1; o >>= 1) v += sx_(v, o);
    return v;
}
__device__ __forceinline__ float sigmoidf_(float x) { return __builtin_amdgcn_rcpf(1.0f + __expf(-x)); }
__device__ __forceinline__ float gelu_tanh(float x) {
    const float u = 0.7978845608028654f * (x + 0.044715f * x * x * x);
    const float e = __expf(2.0f * u);
    const float t = 1.0f - 2.0f * __builtin_amdgcn_rcpf(e + 1.0f);
    return 0.5f * x * (1.0f + t);
}

constexpr int GS_ROW = 144;
constexpr int GS_A = 128 * GS_ROW, GS_STAGE = 384 * GS_ROW;

template <class AF>
__device__ __forceinline__ void gemm_kloop(LAS unsigned char* lds, const AF& af, const bf16_t* __restrict__ Bt, int ldb, int K, f32x4 (&acc)[4][4]) {
    const int tid = ltid(), lane = tid & 63, wid = tid >> 6, wm = wid >> 2, wn = wid & 3;
    const int srow = tid >> 3, sch = tid & 7;
    const bf16_t* pa0 = af(srow) + sch * 8;
    const bf16_t* pa1 = af(srow + 64) + sch * 8;
    const bf16_t* pb0 = Bt + (size_t)(srow) * ldb + sch * 8;
    const bf16_t* pb1 = Bt + (size_t)(srow + 64) * ldb + sch * 8;
    const bf16_t* pb2 = Bt + (size_t)(srow + 128) * ldb + sch * 8;
    const bf16_t* pb3 = Bt + (size_t)(srow + 192) * ldb + sch * 8;
    const int wofs = srow * GS_ROW + sch * 16;
    const int nkt = K >> 6;
    u32x4 ra0 = *(const u32x4*)pa0, ra1 = *(const u32x4*)pa1, rb0 = *(const u32x4*)pb0, rb1 = *(const u32x4*)pb1, rb2 = *(const u32x4*)pb2, rb3 = *(const u32x4*)pb3;
    {
        LAS unsigned char* s = lds;
        *(LAS u32x4*)(s + wofs) = ra0; *(LAS u32x4*)(s + wofs + 64 * GS_ROW) = ra1;
        *(LAS u32x4*)(s + GS_A + wofs) = rb0; *(LAS u32x4*)(s + GS_A + wofs + 64 * GS_ROW) = rb1;
        *(LAS u32x4*)(s + GS_A + wofs + 128 * GS_ROW) = rb2; *(LAS u32x4*)(s + GS_A + wofs + 192 * GS_ROW) = rb3;
    }
    __syncthreads();
    const int aoff = (wm * 64 + (lane & 15)) * GS_ROW + (lane >> 4) * 16;
    const int boff = GS_A + (wn * 64 + (lane & 15)) * GS_ROW + (lane >> 4) * 16;
    for (int kt = 0; kt < nkt; ++kt) {
        LAS unsigned char* cur = lds + (kt & 1) * GS_STAGE;
        LAS unsigned char* nxt = lds + ((kt + 1) & 1) * GS_STAGE;
        const bool more = (kt + 1 < nkt);
        if (more) {
            const int ko = (kt + 1) * 64;
            ra0 = *(const u32x4*)(pa0 + ko); ra1 = *(const u32x4*)(pa1 + ko);
            rb0 = *(const u32x4*)(pb0 + ko); rb1 = *(const u32x4*)(pb1 + ko); rb2 = *(const u32x4*)(pb2 + ko); rb3 = *(const u32x4*)(pb3 + ko);
        }
#pragma unroll
        for (int ks = 0; ks < 2; ++ks) {
            bf16x8 a[4], b[4];
#pragma unroll
            for (int m = 0; m < 4; ++m) a[m] = *(LAS bf16x8*)(cur + aoff + m * 16 * GS_ROW + ks * 64);
#pragma unroll
            for (int n = 0; n < 4; ++n) b[n] = *(LAS bf16x8*)(cur + boff + n * 16 * GS_ROW + ks * 64);
#pragma unroll
            for (int m = 0; m < 4; ++m)
#pragma unroll
                for (int n = 0; n < 4; ++n) acc[m][n] = __builtin_amdgcn_mfma_f32_16x16x32_bf16(b[n], a[m], acc[m][n], 0, 0, 0);
        }
        if (more) {
            *(LAS u32x4*)(nxt + wofs) = ra0; *(LAS u32x4*)(nxt + wofs + 64 * GS_ROW) = ra1;
            *(LAS u32x4*)(nxt + GS_A + wofs) = rb0; *(LAS u32x4*)(nxt + GS_A + wofs + 64 * GS_ROW) = rb1;
            *(LAS u32x4*)(nxt + GS_A + wofs + 128 * GS_ROW) = rb2; *(LAS u32x4*)(nxt + GS_A + wofs + 192 * GS_ROW) = rb3;
        }
        __syncthreads();
    }
}
__device__ __forceinline__ void acc_zero(f32x4 (&acc)[4][4]) {
#pragma unroll
    for (int m = 0; m < 4; ++m)
#pragma unroll
        for (int n = 0; n < 4; ++n) acc[m][n] = (f32x4){0.f, 0.f, 0.f, 0.f};
}
struct ARowLinear { const bf16_t* base; int ld; __device__ __forceinline__ const bf16_t* operator()(int r) const { return base + (size_t)r * ld; } };

__device__ __forceinline__ bool dense_unit(int it, int bid, int nb, int MT, int NT, int& mt, int& nt) {
    if (nb == 256) {
        const int xcd = bid & 7, loc = bid >> 3, nmacN = (NT + 3) >> 2, nmacM = (MT + 7) >> 3;
        const int q = it * 8 + xcd;
        if (q >= nmacM * nmacN) { mt = -1; return false; }
        const int mm = q / nmacN, nn = q - mm * nmacN;
        mt = mm * 8 + (loc & 7); nt = nn * 4 + (loc >> 3);
        if (mt >= MT || nt >= NT) mt = -1;
        return true;
    }
    const int u = it * nb + bid;
    if (u >= MT * NT) { mt = -1; return false; }
    mt = u / NT; nt = u - mt * NT; return true;
}

namespace pg8 {
typedef unsigned short bf16_t;
constexpr float F8_WMUL = 64.0f, F8_WINV = 1.0f / 64.0f;
constexpr int BM = 256, BK = 64, HALF = 128, HTB = HALF * BK * 2, STAGE_BYTES = 8 * HTB, NXCD = 8, WGM = 8;
__host__ __device__ __forceinline__ int lds_byte(int r, int c) { const int st = (r >> 4) * 2 + (c >> 5), rr = r & 15, cc = c & 31, ob = rr * 64 + cc * 2; return st * 1024 + (ob ^ (((ob >> 9) & 1) << 5)); }
__host__ __device__ __forceinline__ void stage_rc(int b, int& R, int& C) { const int st = b / 1024, sb = b % 1024, swz = sb ^ (((sb >> 9) & 1) << 5); R = (st >> 1) * 16 + swz / 64; C = (st & 1) * 32 + (swz % 64) / 2; }
__host__ __device__ __forceinline__ int perm32(int rho) { const int n = rho >> 4, i = rho & 15; return 8 * (i >> 2) + 4 * n + (i & 3); }
struct Unit { const char* a; const char* b; const int* rows; int pm, pn, tag; };
__device__ __forceinline__ bool static_tile(int i, int G, int c, int nM, int nN, int& pm, int& pn) {
    const int nwg = nM * nN; const long L = (long)i * G + c; if (L >= nwg) return false;
    int wgid = (int)L; { const int q = nwg / NXCD, r = nwg % NXCD, xcd = wgid % NXCD, off = wgid / NXCD; wgid = (xcd < r ? xcd * (q + 1) : r * (q + 1) + (xcd - r) * q) + off; }
    const int nig = WGM * nN, gid = wgid / nig, fm = gid * WGM, gsz = (nM - fm) < WGM ? (nM - fm) : WGM;
    pm = fm + ((wgid % nig) % gsz); pn = (wgid % nig) / gsz; return true;
}
typedef int i32x8 __attribute__((ext_vector_type(8)));
typedef int i32x4 __attribute__((ext_vector_type(4)));
template <bool GATHER, bool F8, class Epi, class Sched>
__device__ __forceinline__ void gemm_phase(LAS unsigned char* lds, const int K, const Sched& S, const Epi& E) {
    const int tid = ltid(), wid = __builtin_amdgcn_readfirstlane(tid >> 6), lane = tid & 63, wr = wid >> 2, wc = wid & 3, fr = lane & 15, fq = lane >> 4;
    const int nt = K / BK;
    unsigned voffA[2], voffB[2];
#pragma unroll
    for (int i = 0; i < 2; ++i) { int R, C; stage_rc(tid * 16 + i * 8192, R, C); const int Rb = Epi::PERM ? ((R & ~31) + perm32(R & 31)) : R;
        voffA[i] = (unsigned)(R * K + C) * 2u; voffB[i] = (unsigned)(Rb * K + C) * 2u; }
    (void)voffA;
    const size_t kstep = (size_t)(BK * 2);
    const size_t hstep = (size_t)HALF * K * 2;
    const unsigned ldsw = (unsigned)wid * 1024u;
    const int aoff = lds_byte(wr * 64 + fr, fq * 8), boff = lds_byte(wc * 32 + fr, fq * 8);
#define PG8_SA(b, h) (((b) * 2 + (h)) * HTB)
#define PG8_SB(b, h) ((4 + (b) * 2 + (h)) * HTB)
#define PG8_STAGE(bufoff, gbase, voff) do { _Pragma("unroll") for (int _i = 0; _i < 2; ++_i) { unsigned vo_ = (voff)[_i]; asm volatile("" : "+v"(vo_));     \
        __builtin_amdgcn_global_load_lds((const unsigned*)((const char*)(gbase) + vo_), (LAS unsigned*)(lds + (bufoff) + ldsw + _i * 8192), 16, 0, 0); } } while (0)
#define PG8_LDA(dst, b, h) do { if constexpr (F8) { _Pragma("unroll") for (int m = 0; m < 4; ++m) { dst##8[m].lo = *(const LAS i32x4*)(lds + PG8_SA(b, h) + aoff + m * 2048); dst##8[m].hi = *(const LAS i32x4*)(lds + PG8_SA(b, h) + aoff + m * 2048 + 1024); } } \
        else { _Pragma("unroll") for (int m = 0; m < 4; ++m) _Pragma("unroll") for (int k = 0; k < 2; ++k) dst[m][k] = *(const LAS bf16x8*)(lds + PG8_SA(b, h) + aoff + m * 2048 + k * 1024); } } while (0)
#define PG8_LDB(dst, b, h) do { if constexpr (F8) { _Pragma("unroll") for (int n = 0; n < 2; ++n) { dst##8[n].lo = *(const LAS i32x4*)(lds + PG8_SB(b, h) + boff + n * 2048); dst##8[n].hi = *(const LAS i32x4*)(lds + PG8_SB(b, h) + boff + n * 2048 + 1024); } } \
        else { _Pragma("unroll") for (int n = 0; n < 2; ++n) _Pragma("unroll") for (int k = 0; k < 2; ++k) dst[n][k] = *(const LAS bf16x8*)(lds + PG8_SB(b, h) + boff + n * 2048 + k * 1024); } } while (0)
#define PG8_MMA(ai, bj, At, Bt) do { __builtin_amdgcn_s_setprio(1); _Pragma("unroll") for (int m = 0; m < 4; ++m) _Pragma("unroll") for (int n = 0; n < 2; ++n) { \
        if constexpr (F8) acc[ai][bj][m][n] = __builtin_amdgcn_mfma_scale_f32_16x16x128_f8f6f4(Bt##8[n], At##8[m], acc[ai][bj][m][n], 0, 0, 0, 0, 0, 0); \
        else { _Pragma("unroll") for (int k = 0; k < 2; ++k) acc[ai][bj][m][n] = __builtin_amdgcn_mfma_f32_16x16x32_bf16(Bt[n][k], At[m][k], acc[ai][bj][m][n], 0, 0, 0); } } \
        __builtin_amdgcn_s_setprio(0); } while (0)
#define PG8_WAIT_V(n) asm volatile("s_waitcnt vmcnt(" #n ")" ::: "memory")
#define PG8_WAIT_L(n) asm volatile("s_waitcnt lgkmcnt(" #n ")" ::: "memory")
#define PG8_BAR __builtin_amdgcn_s_barrier()
#define PG8_SCHED __builtin_amdgcn_sched_barrier(0)
    Unit cur, nxt; int ui = 0;
    if (!S.next(0, cur)) return;
    f32x4 acc[2][2][4][2];
#pragma unroll
    for (int a = 0; a < 2; ++a)
#pragma unroll
        for (int b = 0; b < 2; ++b)
#pragma unroll
            for (int m = 0; m < 4; ++m)
#pragma unroll
                for (int n = 0; n < 2; ++n) acc[a][b][m][n] = (f32x4){0.f, 0.f, 0.f, 0.f};
    bf16x8 At[4][2], B0[2][2], B1[2][2];
    i32x8 At8[4], B08[2], B18[2];
    (void)At; (void)B0; (void)B1; (void)At8; (void)B08; (void)B18;
    const char* cA = cur.a; const char* cB = cur.b;
    unsigned ca0[2], ca1[2], na0[2], na1[2];
#define PG8_AOFFS(u, o0, o1) do { _Pragma("unroll") for (int _i = 0; _i < 2; ++_i) { \
        if constexpr (GATHER) { int R_, C_; stage_rc(ltid() * 16 + _i * 8192, R_, C_); const int* rw_ = (u).rows + R_; \
            o0[_i] = (unsigned)rw_[0] * (unsigned)(K * 2) + (unsigned)C_ * 2u; o1[_i] = (unsigned)rw_[128] * (unsigned)(K * 2) + (unsigned)C_ * 2u; } \
        else { o0[_i] = voffA[_i]; o1[_i] = voffA[_i] + (unsigned)hstep; } } } while (0)
    PG8_AOFFS(cur, ca0, ca1);
#pragma unroll
    for (int i = 0; i < 2; ++i) { na0[i] = ca0[i]; na1[i] = ca1[i]; }
    (void)na0; (void)na1;
    PG8_STAGE(PG8_SB(0, 0), cB, voffB); PG8_STAGE(PG8_SA(0, 0), cA, ca0); PG8_STAGE(PG8_SB(0, 1), cB + hstep, voffB); PG8_STAGE(PG8_SA(0, 1), cA, ca1);
    if (wr == 1) PG8_BAR;
    PG8_WAIT_V(4); PG8_BAR;
    PG8_STAGE(PG8_SB(1, 0), cB + kstep, voffB); PG8_STAGE(PG8_SA(1, 0), cA + kstep, ca0); PG8_STAGE(PG8_SB(1, 1), cB + hstep + kstep, voffB);
    PG8_WAIT_V(6); PG8_BAR;
    for (;;) {
        const bool has_next = S.next(ui + 1, nxt);
        const char* nA = has_next ? nxt.a : cA; const char* nB = has_next ? nxt.b : cB;
        if constexpr (!GATHER) { if (has_next) PG8_AOFFS(nxt, na0, na1); }
#pragma nounroll
        for (int t = 0; t < nt; t += 2) {
            const bool last = (t == nt - 2);
            const char* a1 = cA + (size_t)(t + 1) * kstep;
            const char* a2 = last ? nA : cA + (size_t)(t + 2) * kstep; const char* b2 = last ? nB : cB + (size_t)(t + 2) * kstep;
            const char* a3 = a2 + kstep; const char* b3 = b2 + kstep;
            unsigned xa0[2] = {ca0[0], ca0[1]}, xa1[2] = {ca1[0], ca1[1]};
            if (last) {
                if constexpr (GATHER) { if (has_next) PG8_AOFFS(nxt, xa0, xa1); }
                else { xa0[0] = na0[0]; xa0[1] = na0[1]; xa1[0] = na1[0]; xa1[1] = na1[1]; }
            }
            PG8_LDB(B0, 0, 0); PG8_SCHED; PG8_LDA(At, 0, 0); PG8_STAGE(PG8_SA(1, 1), a1, ca1);
            PG8_WAIT_L(8); PG8_BAR; PG8_WAIT_L(0); PG8_MMA(0, 0, At, B0); PG8_BAR; PG8_SCHED;
            PG8_LDB(B1, 0, 1); PG8_STAGE(PG8_SB(0, 0), b2, voffB);
            PG8_BAR; PG8_WAIT_L(0); PG8_MMA(0, 1, At, B1); PG8_BAR;
            PG8_LDA(At, 0, 1); PG8_STAGE(PG8_SA(0, 0), a2, xa0);
            PG8_BAR; PG8_WAIT_L(0); PG8_MMA(1, 0, At, B0); PG8_BAR; PG8_SCHED;
            PG8_STAGE(PG8_SB(0, 1), b2 + hstep, voffB);
            PG8_WAIT_V(6); PG8_BAR; PG8_MMA(1, 1, At, B1); PG8_BAR;
            PG8_LDB(B0, 1, 0); PG8_SCHED; PG8_LDA(At, 1, 0); PG8_STAGE(PG8_SA(0, 1), a2, xa1);
            PG8_WAIT_L(8); PG8_BAR; PG8_WAIT_L(0); PG8_MMA(0, 0, At, B0); PG8_BAR; PG8_SCHED;
            PG8_LDB(B1, 1, 1); PG8_STAGE(PG8_SB(1, 0), b3, voffB);
            PG8_BAR; PG8_WAIT_L(0); PG8_MMA(0, 1, At, B1); PG8_BAR;
            PG8_LDA(At, 1, 1); PG8_STAGE(PG8_SA(1, 0), a3, xa0);
            PG8_BAR; PG8_WAIT_L(0); PG8_MMA(1, 0, At, B0); PG8_BAR; PG8_SCHED;
            PG8_STAGE(PG8_SB(1, 1), b3 + hstep, voffB);
            PG8_WAIT_V(6); PG8_BAR; PG8_MMA(1, 1, At, B1); PG8_BAR;
        }
        { const int le = ltid() & 63; E(acc, cur, wr, wc, le & 15, le >> 4); }
        if (!has_next) break;
#pragma unroll
        for (int a = 0; a < 2; ++a)
#pragma unroll
            for (int b = 0; b < 2; ++b)
#pragma unroll
                for (int m = 0; m < 4; ++m)
#pragma unroll
                    for (int n = 0; n < 2; ++n) acc[a][b][m][n] = (f32x4){0.f, 0.f, 0.f, 0.f};
        cur = nxt; cA = nA; cB = nB; ++ui;
        if constexpr (GATHER) PG8_AOFFS(cur, ca0, ca1);
        else {
#pragma unroll
            for (int i = 0; i < 2; ++i) { ca0[i] = na0[i]; ca1[i] = na1[i]; }
        }
    }
    PG8_WAIT_V(0);
    if (wr == 0) PG8_BAR;
    PG8_BAR;
#undef PG8_AOFFS
#undef PG8_SA
#undef PG8_SB
#undef PG8_STAGE
#undef PG8_LDA
#undef PG8_LDB
#undef PG8_MMA
#undef PG8_WAIT_V
#undef PG8_WAIT_L
#undef PG8_BAR
#undef PG8_SCHED
}
}

template <bool F8>
struct SchedInproj { const char* A; const char* B; int nM, G, c;
    __device__ __forceinline__ bool next(int i, pg8::Unit& u) const { int pm, j; if (!pg8::static_tile(i, G, c, nM, F8 ? IN_N8 : IN_NBF, pm, j)) return false;
        unsigned long long m = F8 ? IN_F8_MASK : IN_BF_MASK; for (int q = 0; q < j; ++q) m &= m - 1;
        const int pn = __builtin_ctzll(m);
        u.pm = pm; u.pn = pn; u.tag = 0; u.rows = nullptr; u.a = A + (size_t)pm * 256 * 1024 * (F8 ? 1 : 2); u.b = B + (size_t)pn * 256 * 1024 * (F8 ? 1 : 2); return true; } };
template <bool F8>
struct EpiInproj { static constexpr bool PERM = true; bf16_t* P; float* GATES; unsigned char* GP8; unsigned char* MO8;
    __device__ __forceinline__ void operator()(const f32x4 (&acc)[2][2][4][2], const pg8::Unit& u, int wr, int wc, int fr, int fq) const {
        const size_t row0 = (size_t)u.pm * 256 + wr * 64 + fr;
        constexpr float ASC = F8 ? pg8::F8_WINV : 1.0f;
        if (u.pn >= 16 && u.pn < 20) {
#pragma unroll
            for (int ai = 0; ai < 2; ++ai)
#pragma unroll
                for (int m = 0; m < 4; ++m) { unsigned char* rowp = MO8 + (row0 + ai * 128 + m * 16) * 1024 + (u.pn - 16) * 256 + wc * 32 + 8 * fq;
#pragma unroll
                    for (int bj = 0; bj < 2; ++bj) { const f32x4 v0 = acc[ai][bj][m][0] * ASC, v1 = acc[ai][bj][m][1] * ASC;
                        int w0 = 0, w1 = 0;
                        w0 = __builtin_amdgcn_cvt_pk_fp8_f32(v0[0], v0[1], w0, false); w0 = __builtin_amdgcn_cvt_pk_fp8_f32(v0[2], v0[3], w0, true);
                        w1 = __builtin_amdgcn_cvt_pk_fp8_f32(v1[0], v1[1], w1, false); w1 = __builtin_amdgcn_cvt_pk_fp8_f32(v1[2], v1[3], w1, true);
                        *(u32x2*)(rowp + bj * 128) = mk2((unsigned)w0, (unsigned)w1); } }
        } else if (u.pn < 32) {
#pragma unroll
            for (int ai = 0; ai < 2; ++ai)
#pragma unroll
                for (int m = 0; m < 4; ++m) { bf16_t* rowp = P + (row0 + ai * 128 + m * 16) * PWID + u.pn * 256 + wc * 32 + 8 * fq;
#pragma unroll
                    for (int bj = 0; bj < 2; ++bj) { const f32x4 v0 = acc[ai][bj][m][0] * ASC, v1 = acc[ai][bj][m][1] * ASC;
                        *(u32x4*)(rowp + bj * 128) = mk4(pk2(v0[0], v0[1]), pk2(v0[2], v0[3]), pk2(v1[0], v1[1]), pk2(v1[2], v1[3])); } }
        } else if (u.pn < 44) {
#pragma unroll
            for (int ai = 0; ai < 2; ++ai)
#pragma unroll
                for (int m = 0; m < 4; ++m) { unsigned char* rowp = GP8 + (row0 + ai * 128 + m * 16) * 3072 + (u.pn - 32) * 256 + wc * 32 + 8 * fq;
#pragma unroll
                    for (int bj = 0; bj < 2; ++bj) { const f32x4 v0 = acc[ai][bj][m][0] * ASC, v1 = acc[ai][bj][m][1] * ASC;
                        int w0 = 0, w1 = 0;
                        w0 = __builtin_amdgcn_cvt_pk_fp8_f32(v0[0], v0[1], w0, false); w0 = __builtin_amdgcn_cvt_pk_fp8_f32(v0[2], v0[3], w0, true);
                        w1 = __builtin_amdgcn_cvt_pk_fp8_f32(v1[0], v1[1], w1, false); w1 = __builtin_amdgcn_cvt_pk_fp8_f32(v1[2], v1[3], w1, true);
                        *(u32x2*)(rowp + bj * 128) = mk2((unsigned)w0, (unsigned)w1); } }
        } else if (wc == 0 && fq < 2) {
#pragma unroll
            for (int ai = 0; ai < 2; ++ai)
#pragma unroll
                for (int m = 0; m < 4; ++m) { float* g = GATES + (row0 + ai * 128 + m * 16) * 16 + 8 * fq; *(f32x4*)g = acc[ai][0][m][0] * ASC; *(f32x4*)(g + 4) = acc[ai][0][m][1] * ASC; }
        }
    } };
__device__ __forceinline__ void phase_inproj8(CP p, LAS unsigned char* lds, int bid, int nb) {
    if constexpr (IN_N8 > 0) {
        SchedInproj<true> S{(const char*)p->H8, (const char*)p->bt_in8, p->G * SALL / 256, nb, bid};
        EpiInproj<true> E{p->P, p->GATES, p->GP8, p->MO8};
        pg8::gemm_phase<false, true>(lds, 512, S, E);
    }
    if constexpr (IN_NBF > 0) {
        SchedInproj<false> S{(const char*)p->H, (const char*)p->bt_in, p->G * SALL / 256, nb, nb - 1 - bid};
        EpiInproj<false> E{p->P, p->GATES, p->GP8, p->MO8};
        pg8::gemm_phase<false, false>(lds, 1024, S, E);
    }
}

struct CvtItem { const float* src; int sld; bf16_t* dst; int dld; int zero; float scale; int f8; };
__device__ __forceinline__ CvtItem cvt_decode(CP p, int L, int item) {
    CvtItem c; c.zero = 0; c.scale = 1.0f; c.f8 = 0;
    if (item < 11520) {
        const int g = item >> 4, kb = item & 15; int sc = 0;
        if (g < 320) sc = 16 * g; else if (g < 704) sc = 16 * g + 16; else if (g == 704) sc = 5120; else c.zero = 1;
        c.src = p->w_in + (size_t)L * 1024 * 11280 + (size_t)kb * 64 * 11280 + sc; c.sld = 11280;
        if ((IN_F8_MASK >> (g >> 4)) & 1) { c.dst = (bf16_t*)(p->bt_in8 + (size_t)g * 16 * 1024 + kb * 64); c.dld = 1024; c.f8 = 1; c.scale = pg8::F8_WMUL; return c; }
        c.dst = p->bt_in + (size_t)g * 16 * 1024 + kb * 64; c.dld = 1024; return c;
    }
    item -= 11520;
    if (item < 3072) {
        const int j = item >> 10, r = item & 1023, g = r >> 4, kb = r & 15;
        c.src = p->w_branch + ((size_t)(L * 3 + j) * 1024 + kb * 64) * 1024 + g * 16; c.sld = 1024;
        if (MERGE_F8 && j > 0) { c.dst = (bf16_t*)((unsigned char*)p->bt_br + (size_t)j * 1024 * 1024 * 2 + (size_t)g * 16 * 1024 + kb * 64); c.dld = 1024; c.f8 = 1; c.scale = pg8::F8_WMUL; return c; }
        c.dst = p->bt_br + ((size_t)j * 1024 + g * 16) * 1024 + kb * 64; c.dld = 1024; return c;
    }
    item -= 3072;
    if (item < 1024) {
        const int g = item >> 4, kb = item & 15;
        c.src = p->w_out + ((size_t)L * 1024 + kb * 64) * 1024 + g * 16; c.sld = 1024;
        c.dst = p->bt_out + (size_t)g * 16 * 1024 + kb * 64; c.dld = 1024; return c;
    }
    item -= 1024;
    if (item < 33280) {
        const int e = item >> 9, r = item & 511, g = r >> 4, kb = r & 15;
        const int nt = g >> 4, n = ((g >> 3) & 1) * 2, f = nt * 128 + (g & 7) * 16;
        const float* base = (e < 64) ? ((n < 2 ? p->w_e_gate : p->w_e_up) + ((size_t)(L * 64 + e)) * 1024 * 256) : ((n < 2 ? p->w_s_gate : p->w_s_up) + (size_t)L * 1024 * 256);
        c.src = base + (size_t)kb * 64 * 256 + f; c.sld = 256;
        c.dst = (bf16_t*)((unsigned char*)p->bt_eup + ((size_t)e * 512 + g * 16) * 1024 + kb * 64); c.dld = 1024; c.f8 = 1; c.scale = 64.0f; return c;
    }
    item -= 33280;
    if (item < 16640) {
        const int e = item >> 8, r = item & 255, g = r >> 2, kb = r & 3;
        const float* base = (e < 64) ? (p->w_e_down + ((size_t)(L * 64 + e)) * 256 * 1024) : (p->w_s_down + (size_t)L * 256 * 1024);
        c.src = base + (size_t)kb * 64 * 1024 + g * 16; c.sld = 1024;
        if (DOWN_F8) { c.dst = (bf16_t*)((unsigned char*)p->bt_edn + ((size_t)e * 1024 + g * 16) * 256 + kb * 64); c.dld = 256; c.f8 = 1; c.scale = DW_SC; return c; }
        c.dst = p->bt_edn + ((size_t)e * 1024 + g * 16) * 256 + kb * 64; c.dld = 256; c.scale = D_SCALE; return c;
    }
    item -= 16640;
    {
        const int dh = item >> 5, r = item & 31, g = r >> 1, kb = r & 1;
        const int cq = g >> 2, n = g & 3, ch = cq * 32 + (n & 1) * 16;
        const float* base = (n < 2 ? p->lru_wa : p->lru_wx) + ((size_t)(L * 16 + dh)) * 128 * 128;
        c.src = base + (size_t)kb * 64 * 128 + ch; c.sld = 128;
        c.dst = p->bt_lru + ((size_t)dh * 256 + g * 16) * 128 + kb * 64; c.dld = 128; return c;
    }
}
constexpr int CVT_ITEMS = 11520 + 3072 + 1024 + 33280 + 16640 + 512;
__device__ __forceinline__ void phase_convert(CP p, int L, LAS unsigned char* lds, int bid, int nb) {
    const int tid = ltid(), sub = tid >> 7, t = tid & 127;
    for (int it = bid; it * 8 < CVT_ITEMS; it += nb) {
        CvtItem c[2]; bool valid[2];
        float4 v0[2], v1[2];
        const int kk = t >> 1, half = t & 1;
#pragma unroll
        for (int q = 0; q < 2; ++q) {
            const int item = it * 8 + sub * 2 + q;
            valid[q] = item < CVT_ITEMS;
            c[q].src = nullptr; c[q].dst = nullptr; c[q].sld = 0; c[q].dld = 0; c[q].zero = 1; c[q].scale = 1.0f; c[q].f8 = 0;
            if (valid[q]) c[q] = cvt_decode(p, L, item);
            v0[q] = make_float4(0.f, 0.f, 0.f, 0.f); v1[q] = v0[q];
            if (valid[q] && !c[q].zero) { const float* s2 = c[q].src + (size_t)kk * c[q].sld + half * 8; v0[q] = *(const float4*)s2; v1[q] = *(const float4*)(s2 + 4); }
        }
#pragma unroll
        for (int q = 0; q < 2; ++q) {
            LAS bf16_t* tile = (LAS bf16_t*)(lds + (sub * 2 + q) * (16 * 66 * 2));
            const float vv[8] = {v0[q].x, v0[q].y, v0[q].z, v0[q].w, v1[q].x, v1[q].y, v1[q].z, v1[q].w};
#pragma unroll
            for (int i = 0; i < 8; ++i) tile[(half * 8 + i) * 66 + kk] = (bf16_t)(pk2(vv[i] * c[q].scale, 0.f) & 0xffffu);
        }
        __syncthreads();
#pragma unroll
        for (int q = 0; q < 2; ++q) {
            if (valid[q]) {
                LAS bf16_t* tile = (LAS bf16_t*)(lds + (sub * 2 + q) * (16 * 66 * 2));
                const int i = t >> 3, seg = t & 7;
                unsigned w[4];
#pragma unroll
                for (int x = 0; x < 4; ++x) w[x] = (unsigned)tile[i * 66 + seg * 8 + 2 * x] | ((unsigned)tile[i * 66 + seg * 8 + 2 * x + 1] << 16);
                if (c[q].f8) { int f0 = 0, f1 = 0;
                    f0 = __builtin_amdgcn_cvt_pk_fp8_f32(lo_bf(w[0]), hi_bf(w[0]), f0, false); f0 = __builtin_amdgcn_cvt_pk_fp8_f32(lo_bf(w[1]), hi_bf(w[1]), f0, true);
                    f1 = __builtin_amdgcn_cvt_pk_fp8_f32(lo_bf(w[2]), hi_bf(w[2]), f1, false); f1 = __builtin_amdgcn_cvt_pk_fp8_f32(lo_bf(w[3]), hi_bf(w[3]), f1, true);
                    *(u32x2*)((unsigned char*)c[q].dst + (size_t)i * c[q].dld + seg * 8) = mk2((unsigned)f0, (unsigned)f1); }
                else *(u32x4*)(c[q].dst + (size_t)i * c[q].dld + seg * 8) = mk4(w[0], w[1], w[2], w[3]);
            }
        }
        __syncthreads();
    }
}

__device__ __forceinline__ void phase_mods(CP p, LAS unsigned char* lds, int bid, int nb) {
    const int tid = ltid();
    LAS float* sl = (LAS float*)lds;
    const int tcol = tid & 63, kp = tid >> 6;
    for (int item = bid; item < 192; item += nb) {
        const int L = item / 96, n0 = (item % 96) * 64;
        __syncthreads();
#pragma unroll 1
        for (int q0 = 0; q0 < 66; q0 += 22) {
            float cvv[22];
#pragma unroll
            for (int q = 0; q < 22; ++q) { const int e = tid + (q0 + q) * NTHREADS; cvv[q] = (q0 + q < 64) ? p->c[e] : p->c_ctx[e - 32768]; }
#pragma unroll
            for (int q = 0; q < 22; ++q) { const int e = tid + (q0 + q) * NTHREADS; sl[(e & 1023) * 33 + (e >> 10)] = cvv[q] * __builtin_amdgcn_rcpf(1.0f + __expf(-cvv[q])); }
        }
        __syncthreads();
        float acc[33];
#pragma unroll
        for (int r = 0; r < 33; ++r) acc[r] = 0.f;
        const float* w = p->w_ada + ((size_t)L * 1024 + kp * 128) * 6144 + n0 + tcol;
        for (int k0 = 0; k0 < 128; k0 += 16) {
            float wv[16];
#pragma unroll
            for (int k = 0; k < 16; ++k) wv[k] = w[(size_t)(k0 + k) * 6144];
            LAS float* sk = sl + (kp * 128 + k0) * 33;
#pragma unroll
            for (int k = 0; k < 16; ++k)
#pragma unroll
                for (int r = 0; r < 33; ++r) acc[r] += sk[k * 33 + r] * wv[k];
        }
        __syncthreads();
#pragma unroll
        for (int r = 0; r < 33; ++r) sl[(kp * 33 + r) * 64 + tcol] = acc[r];
        __syncthreads();
        const float bv = p->b_ada[L * 6144 + n0 + tcol];
        for (int r = kp; r < 33; r += 8) {
            float sum = 0.f;
#pragma unroll
            for (int q = 0; q < 8; ++q) sum += sl[(q * 33 + r) * 64 + tcol];
            if (r < 32) p->mods_l[((size_t)L * 32 + r) * 6144 + n0 + tcol] = sum + bv;
            else p->mods_c[(size_t)L * 6144 + n0 + tcol] = sum + bv;
        }
    }
    for (int e = bid * NTHREADS + tid; e < 2048 * 32; e += nb * NTHREADS) {
        const int s = e >> 5, a = (e >> 4) & 1, f = e & 15;
        const float pos = (float)(a == 0 ? (s >> 6) : (s & 63));
        const float fr = powf(10000.0f, -(float)f / 16.0f);
        float sn, cs; sincosf(pos * fr, &sn, &cs);
        p->rope[2 * e] = cs; p->rope[2 * e + 1] = sn;
    }
    if (bid == 0 && tid < 128) {
        const int L = tid >> 6, lane = tid & 63;
        const float* lv = p->da_lambda + L * 256;
        const float a = wave_sum(lv[lane] * lv[64 + lane]), b = wave_sum(lv[128 + lane] * lv[192 + lane]);
        const float lam_init = 0.8f - 0.6f * expf(-0.3f * (float)L);
        if (lane == 0) p->lamv[L] = expf(a) - expf(b) + lam_init;
        float gq = fabsf(p->da_qnorm_g[L * 64 + lane]), gk = fabsf(p->da_knorm_g[L * 64 + lane]);
#pragma unroll
        for (int o = 32; o >= 1; o >>= 1) { gq = fmaxf(gq, sx_(gq, o)); gk = fmaxf(gk, sx_(gk, o)); }
        if (lane == 0) p->lamv[2 + L] = 64.0f * gq * gk * 0.125f * 1.4426950408889634f * 1.001f + 0.01f;
    }
}

__device__ __forceinline__ void phase_prenorm(CP p, int L, int grp, int bid, int nb) {
    const int lane = ltid() & 63, wid = ltid() >> 6;
    const int RG = p->G * SALL;
    const float* g1 = p->norm1_g + L * 1024;
    for (int r = bid * 8 + wid; r < RG; r += nb * 8) {
        const int bl = r / SALL, pos = r - bl * SALL, b = grp * p->G + bl;
        const float* src; const float* md;
        if (pos < CTXL) { src = (L == 0 ? p->ctx : p->XC1) + ((size_t)b * CTXL + pos) * 1024; md = p->mods_c + (size_t)L * 6144; }
        else { src = (L == 0 ? p->x : p->out) + ((size_t)b * SEQ + (pos - CTXL)) * 1024; md = p->mods_l + ((size_t)L * 32 + b) * 6144; }
        float4 v[4]; float ss = 0.f;
#pragma unroll
        for (int i = 0; i < 4; ++i) { v[i] = *(const float4*)(src + i * 256 + lane * 4); ss += v[i].x * v[i].x + v[i].y * v[i].y + v[i].z * v[i].z + v[i].w * v[i].w; }
        ss = wave_sum(ss);
        const float rstd = rsqrtf(ss * (1.0f / 1024.0f) + 1e-6f);
#pragma unroll
        for (int i = 0; i < 4; ++i) {
            const int col = i * 256 + lane * 4;
            const float4 g = *(const float4*)(g1 + col), sh = *(const float4*)(md + col), sc = *(const float4*)(md + 1024 + col);
            const float o0 = v[i].x * rstd * g.x * (1.f + sc.x) + sh.x, o1 = v[i].y * rstd * g.y * (1.f + sc.y) + sh.y;
            const float o2 = v[i].z * rstd * g.z * (1.f + sc.z) + sh.z, o3 = v[i].w * rstd * g.w * (1.f + sc.w) + sh.w;
            if (IN_N8 > 0) { int w8 = 0; w8 = __builtin_amdgcn_cvt_pk_fp8_f32(o0, o1, w8, false); w8 = __builtin_amdgcn_cvt_pk_fp8_f32(o2, o3, w8, true); *(unsigned*)(p->H8 + (size_t)r * 1024 + col) = (unsigned)w8; }
            if (IN_NBF > 0) *(u32x2*)(p->H + (size_t)r * 1024 + col) = mk2(pk2(o0, o1), pk2(o2, o3));
        }
    }
}

__device__ __forceinline__ void phase_daprep(CP p, int L, int grp, int bid, int nb) {
    const int lane = ltid() & 63, wid = ltid() >> 6;
    const int RG = p->G * SALL;
    const float* qg = p->da_qnorm_g + L * 64; const float* kg = p->da_knorm_g + L * 64;
    const int d0 = (lane & 7) * 8;
    float gq[8], gk[8];
    const float qscale = 0.125f * 1.4426950408889634f;
#pragma unroll
    for (int j = 0; j < 8; ++j) { gq[j] = qg[d0 + j] * qscale; gk[j] = kg[d0 + j]; }
    const bool second = (lane & 2) != 0;
    for (int r = bid * 8 + wid; r < RG; r += nb * 8) {
        const int bl = r / SALL, pos = r - bl * SALL;
        bf16_t* row = p->P + (size_t)r * PWID + PC_DQ;
        const bool lat = pos >= CTXL;
        u32x4 u[4];
#pragma unroll
        for (int i = 0; i < 4; ++i) u[i] = *(const u32x4*)(row + (lane + 64 * i) * 8);
        f32x4 rt4[4];
#pragma unroll
        for (int q = 0; q < 4; ++q) rt4[q] = (f32x4){1.f, 0.f, 1.f, 0.f};
        if (lat) {
            const int s2 = pos - CTXL, ax = (lane >> 2) & 1, f0 = (lane & 1) * 8;
            const float* rt = p->rope + ((size_t)s2 * 32 + ax * 16 + f0) * 2;
#pragma unroll
            for (int q = 0; q < 4; ++q) rt4[q] = *(const f32x4*)(rt + 4 * q);
        }
#pragma unroll
        for (int i = 0; i < 4; ++i) {
            float v[8] = {lo_bf(u[i].x), hi_bf(u[i].x), lo_bf(u[i].y), hi_bf(u[i].y), lo_bf(u[i].z), hi_bf(u[i].z), lo_bf(u[i].w), hi_bf(u[i].w)};
            float ss = 0.f;
#pragma unroll
            for (int j = 0; j < 8; ++j) ss += v[j] * v[j];
            ss += dppf<0xB1>(0.f, ss); ss += dppf<0x4E>(0.f, ss); ss += dppf<0x141>(0.f, ss);
            const float rstd = rsqrtf(ss * (1.0f / 64.0f) + 1e-6f);
#pragma unroll
            for (int j = 0; j < 8; ++j) v[j] = v[j] * rstd * (i < 2 ? gq[j] : gk[j]);
            if (lat) {
#pragma unroll
                for (int j = 0; j < 8; ++j) {
                    const float cs = rt4[j >> 1][(j & 1) * 2], sn = rt4[j >> 1][(j & 1) * 2 + 1];
                    const float o = dppf<0x4E>(0.f, v[j]);
                    v[j] = second ? (v[j] * cs + o * sn) : (v[j] * cs - o * sn);
                }
            }
            u[i] = mk4(pk2(v[0], v[1]), pk2(v[2], v[3]), pk2(v[4], v[5]), pk2(v[6], v[7]));
        }
#pragma unroll
        for (int i = 0; i < 4; ++i) *(u32x4*)(row + (lane + 64 * i) * 8) = u[i];
    }
}

constexpr int AT_KROW = 272, AT_VROW = 288, AT_K = 64 * AT_KROW, AT_STAGE = 64 * AT_KROW + 64 * AT_VROW;
constexpr int A2_QROW = 272, A2_KV = 256 * A2_QROW, A3_STAGE_BYTES = 32768;
static_assert(A2_KV + 2 * AT_STAGE <= 147456 - 64, "attention LDS");
__device__ __forceinline__ void attn_unit2(CP p, int L, LAS unsigned char* lds, int bl, int hd, int qt) {
    const int tid = ltid(), lane = tid & 63, wid = tid >> 6, q4 = lane >> 4, l15 = lane & 15;
    const size_t rowbase = (size_t)bl * SALL;
    const int qpos0 = (qt < 8) ? (CTXL + qt * 256) : 0;
    const int nkt = (qt < 8) ? 36 : 4;
    LAS unsigned char* kv = lds + A2_KV;
    __syncthreads();
    {
#pragma unroll
        for (int i = 0; i < 8; ++i) {
            const int id = tid + NTHREADS * i, row = id >> 4, ch = id & 15;
            *(LAS u32x4*)(lds + row * A2_QROW + ch * 16) = *(const u32x4*)(p->P + (rowbase + qpos0 + row) * PWID + PC_DQ + hd * 128 + ch * 8);
        }
    }
    const bf16_t* kbase = p->P + rowbase * PWID + PC_DK + hd * 128;
    const bf16_t* vbase = kbase + (PC_DV - PC_DK);
    const int drow = wid * 8 + (lane >> 4);
    const unsigned dof0 = (unsigned)drow * PWID + (((lane & 15) ^ (drow & 15)) << 3);
    const unsigned dof1 = (unsigned)(drow + 4) * PWID + (((lane & 15) ^ ((drow + 4) & 15)) << 3);
#define A3_STAGE(stg, kt_) do { const bf16_t* kb_ = kbase + (size_t)(kt_) * 64 * PWID; const bf16_t* vb_ = kb_ + (PC_DV - PC_DK); LAS unsigned char* d_ = kv + (stg) * A3_STAGE_BYTES + wid * 2048; \
        __builtin_amdgcn_global_load_lds((const unsigned*)(kb_ + dof0), (LAS unsigned*)(d_), 16, 0, 0); __builtin_amdgcn_global_load_lds((const unsigned*)(kb_ + dof1), (LAS unsigned*)(d_ + 1024), 16, 0, 0); \
        __builtin_amdgcn_global_load_lds((const unsigned*)(vb_ + dof0), (LAS unsigned*)(d_ + 16384), 16, 0, 0); __builtin_amdgcn_global_load_lds((const unsigned*)(vb_ + dof1), (LAS unsigned*)(d_ + 16384 + 1024), 16, 0, 0); } while (0)
    A3_STAGE(0, 0);
    asm volatile("s_waitcnt vmcnt(0)" ::: "memory");
    __syncthreads();
    f32x4 o[2][2][8];
#pragma unroll
    for (int c = 0; c < 2; ++c)
#pragma unroll
        for (int mt = 0; mt < 2; ++mt)
#pragma unroll
            for (int d = 0; d < 8; ++d) o[c][mt][d] = (f32x4){0.f, 0.f, 0.f, 0.f};
    float ls[2][2] = {{0.f, 0.f}, {0.f, 0.f}};
    const float nbound = -p->lamv[2 + L];
    const int qro = (wid * 32 + l15) * A2_QROW + q4 * 16;
    bf16x8 qf[2][2];
#pragma unroll
    for (int mt = 0; mt < 2; ++mt)
#pragma unroll
        for (int ks = 0; ks < 2; ++ks) qf[mt][ks] = *(LAS bf16x8*)(lds + qro + mt * 16 * A2_QROW + ks * 64);
    for (int kt = 0; kt < nkt; ++kt) {
        LAS unsigned char* cur = kv + (kt & 1) * A3_STAGE_BYTES;
        const bool more = kt + 1 < nkt;
        int lz = l15; asm volatile("" : "+v"(lz));
        const int kro = lz * 256, vrow0 = 4 * q4 + (lz >> 2);
        if (more) A3_STAGE((kt + 1) & 1, kt + 1);
        bf16x8 pf[2][2][2];
        f32x4 sacc[2][2][4];
#define A3_QLOAD(c_) do { _Pragma("unroll") for (int mt = 0; mt < 2; ++mt) _Pragma("unroll") for (int ks = 0; ks < 2; ++ks) qf[mt][ks] = *(LAS bf16x8*)(lds + qro + mt * 16 * A2_QROW + (c_) * 128 + ks * 64); } while (0)
#define A3_SC(s_) ((((s_) >> 3) == 0) ? (((s_) & 7) >> 2) : (1 - (((s_) & 7) >> 2)))
#define A3_SN(s_) (2 * ((s_) >> 3) + ((((s_) & 7) >> 1) & 1))
#define A3_KLOAD(s_) kf[(s_) % 3] = *(LAS bf16x8*)(cur + kro + A3_SN(s_) * 4096 + (((A3_SC(s_) * 8 + ((s_) & 1) * 4 + q4) ^ lz) << 4))
#define A3_EXP4(c_, mt_, n_) do { _Pragma("unroll") for (int j = 0; j < 4; ++j) { sacc[c_][mt_][n_][j] = __builtin_amdgcn_exp2f(sacc[c_][mt_][n_][j]); ls[c_][mt_] += sacc[c_][mt_][n_][j]; } } while (0)
#define A3_PACK(c_, mt_, k2_) do { union { bf16x8 v; unsigned u[4]; } cv; \
            cv.u[0] = pk2(sacc[c_][mt_][2 * (k2_)][0], sacc[c_][mt_][2 * (k2_)][1]); cv.u[1] = pk2(sacc[c_][mt_][2 * (k2_)][2], sacc[c_][mt_][2 * (k2_)][3]); \
            cv.u[2] = pk2(sacc[c_][mt_][2 * (k2_) + 1][0], sacc[c_][mt_][2 * (k2_) + 1][1]); cv.u[3] = pk2(sacc[c_][mt_][2 * (k2_) + 1][2], sacc[c_][mt_][2 * (k2_) + 1][3]); pf[c_][mt_][k2_] = cv.v; } while (0)
#define A3_VREAD(v_) do { const int d_ = (v_) & 7, k2_ = (v_) >> 3; const int vr0 = 32 * k2_ + vrow0, vr1 = vr0 + 16; \
            const int vsw = (((d_ * 2 + ((lz & 3) >> 1)) ^ (vr0 & 15)) << 4) + (lz & 1) * 8; \
            const s16x4 v0 = __builtin_amdgcn_ds_read_tr16_b64_v4i16((LAS s16x4*)(cur + 16384 + vr0 * 256 + vsw)); \
            const s16x4 v1 = __builtin_amdgcn_ds_read_tr16_b64_v4i16((LAS s16x4*)(cur + 16384 + vr1 * 256 + vsw)); \
            vf[(v_) % 3] = (bf16x8){v0[0], v0[1], v0[2], v0[3], v1[0], v1[1], v1[2], v1[3]}; } while (0)
        bf16x8 kf[3], vf[3];
        A3_KLOAD(0); A3_KLOAD(1);
#pragma unroll
        for (int sq = 0; sq < 16; ++sq) {
            if (sq == 4) A3_QLOAD(1);
            if (sq == 12) A3_QLOAD(0);
            if (sq + 2 < 16) A3_KLOAD(sq + 2); else A3_VREAD(sq + 2 - 16);
            {
                const int c = A3_SC(sq), n = A3_SN(sq), ks = sq & 1;
                if (ks == 0) { sacc[c][0][n] = (f32x4){nbound, nbound, nbound, nbound}; sacc[c][1][n] = (f32x4){nbound, nbound, nbound, nbound}; }
                sacc[c][0][n] = __builtin_amdgcn_mfma_f32_16x16x32_bf16(kf[sq % 3], qf[0][ks], sacc[c][0][n], 0, 0, 0);
                sacc[c][1][n] = __builtin_amdgcn_mfma_f32_16x16x32_bf16(kf[sq % 3], qf[1][ks], sacc[c][1][n], 0, 0, 0);
            }
            if (sq >= 4) { const int e = sq - 4; A3_EXP4((e >> 2) ? 1 : 0, (e >> 1) & 1, ((e >> 3) ? 2 : 0) + (e & 1)); }
            if (sq == 7) { A3_PACK(0, 0, 0); A3_PACK(0, 1, 0); }
            if (sq == 11) { A3_PACK(1, 0, 0); A3_PACK(1, 1, 0); }
            if (sq == 15) { A3_PACK(1, 0, 1); A3_PACK(1, 1, 1); }
            __builtin_amdgcn_sched_barrier(0);
        }
#pragma unroll
        for (int v = 0; v < 16; ++v) {
            if (v + 2 < 16) A3_VREAD(v + 2);
            if (v == 8) { A3_PACK(0, 0, 1); A3_PACK(0, 1, 1); }
            {
                const int d = v & 7, k2 = v >> 3;
                o[0][0][d] = __builtin_amdgcn_mfma_f32_16x16x32_bf16(vf[v % 3], pf[0][0][k2], o[0][0][d], 0, 0, 0); o[0][1][d] = __builtin_amdgcn_mfma_f32_16x16x32_bf16(vf[v % 3], pf[0][1][k2], o[0][1][d], 0, 0, 0);
                o[1][0][d] = __builtin_amdgcn_mfma_f32_16x16x32_bf16(vf[v % 3], pf[1][0][k2], o[1][0][d], 0, 0, 0); o[1][1][d] = __builtin_amdgcn_mfma_f32_16x16x32_bf16(vf[v % 3], pf[1][1][k2], o[1][1][d], 0, 0, 0);
            }
            if (v < 8 && (v & 1) == 0) A3_EXP4(0, (v >> 2) & 1, 2 + ((v >> 1) & 1));
            __builtin_amdgcn_sched_barrier(0);
        }
#undef A3_VREAD
#undef A3_QLOAD
#undef A3_SC
#undef A3_SN
#undef A3_KLOAD
#undef A3_EXP4
#undef A3_PACK
        asm volatile("s_waitcnt vmcnt(0)" ::: "memory");
        __syncthreads();
    }
#undef A3_STAGE
    const float lam = p->lamv[L];
    const float lam_init = 0.8f - 0.6f * expf(-0.3f * (float)L);
    const float* sg = p->da_subln_g + L * 128;
#pragma unroll
    for (int mt = 0; mt < 2; ++mt) {
        float l0 = ls[0][mt], l1 = ls[1][mt];
        l0 += sx_(l0, 16); l0 += sx_(l0, 32); l1 += sx_(l1, 16); l1 += sx_(l1, 32);
        const float i0 = 1.0f / l0, i1 = lam / l1;
        float ss = 0.f;
#pragma unroll
        for (int d = 0; d < 8; ++d)
#pragma unroll
            for (int j = 0; j < 4; ++j) { const float v = o[0][mt][d][j] * i0 - o[1][mt][d][j] * i1; o[0][mt][d][j] = v; ss += v * v; }
        ss += sx_(ss, 16); ss += sx_(ss, 32);
        const float rstd = rsqrtf(ss * (1.0f / 128.0f) + 1e-6f) * (1.0f - lam_init);
        bf16_t* orow = p->YC + (rowbase + qpos0 + wid * 32 + mt * 16 + l15) * 1024 + hd * 128;
#pragma unroll
        for (int d = 0; d < 8; ++d) {
            const int dv = d * 16 + 4 * q4;
            const f32x4 g = *(const f32x4*)(sg + dv);
            if (MERGE_F8) { int w8 = 0; w8 = __builtin_amdgcn_cvt_pk_fp8_f32(o[0][mt][d][0] * rstd * g[0], o[0][mt][d][1] * rstd * g[1], w8, false); w8 = __builtin_amdgcn_cvt_pk_fp8_f32(o[0][mt][d][2] * rstd * g[2], o[0][mt][d][3] * rstd * g[3], w8, true);
                *(unsigned*)((unsigned char*)p->YC + (rowbase + qpos0 + wid * 32 + mt * 16 + l15) * 1024 + hd * 128 + dv) = (unsigned)w8; }
            else *(u32x2*)(orow + dv) = mk2(pk2(o[0][mt][d][0] * rstd * g[0], o[0][mt][d][1] * rstd * g[1]), pk2(o[0][mt][d][2] * rstd * g[2], o[0][mt][d][3] * rstd * g[3]));
        }
    }
}

constexpr int ML_QROW = 272, ML_KROW = 288, ML_VROW = 544, ML_SROW = 144;
constexpr int ML_Q = 0, ML_K = ML_Q + 64 * ML_QROW, ML_V = ML_K + 64 * ML_KROW, ML_S = ML_V + 64 * ML_VROW, ML_ARR = ML_S + 64 * ML_SROW, ML_N = ML_ARR + 4 * 256, ML_RD = ML_N + 2 * 512, ML_NP = ML_RD + 8 * 256, ML_H = ML_NP + 4 * 512, ML_HROW = 528, ML_SSP = ML_H + 64 * ML_HROW  , ML_QN = ML_SSP + 1024  , ML_END = ML_QN + 256;
static_assert(ML_END <= LDS_BYTES, "mlstm LDS");
__device__ __forceinline__ void mlstm_unit(CP p, int L, LAS unsigned char* lds, int bl, int hd, int dir) {
    const int tid = ltid(), lane = tid & 63, wid = tid >> 6, q4 = lane >> 4, l15 = lane & 15;
    const size_t rowbase = (size_t)bl * SALL;
    LAS float* carr = (LAS float*)(lds + ML_ARR);
    LAS float* Marr = carr + 64;
    LAS float* wsarr = carr + 128;
    LAS float* wiarr = carr + 192;
    LAS float* nbuf = (LAS float*)(lds + ML_N);
    LAS float* npart = (LAS float*)(lds + ML_NP);
    const float gbi = p->ml_gate_b[((L * 2 + dir) * 2 + 0) * 4 + hd], gbf = p->ml_gate_b[((L * 2 + dir) * 2 + 1) * 4 + hd];
    __syncthreads();
    if (tid < 128) nbuf[tid] = 0.f;
    f32x4 C[8][2];
#pragma unroll
    for (int a = 0; a < 8; ++a) { C[a][0] = (f32x4){0.f, 0.f, 0.f, 0.f}; C[a][1] = C[a][0]; }
    float mstate = 0.f;
    const int srow = tid >> 4, sch = tid & 15;
    const int vrow = tid >> 5, vch = tid & 31;
    u32x4 rq[2], rk[2], rv[4]; float rgi = 0.f, rgf = 0.f;
    auto chunk_pb = [&](int t) -> int { return dir == 0 ? t * 64 : (t < 4 ? (3 - t) * 64 : (39 - t) * 64); };
    auto grow_of = [&](int pb, int j) -> size_t { return rowbase + pb + (dir ? 63 - j : j); };
    auto issue = [&](int t) {
        const int pb = chunk_pb(t);
#pragma unroll
        for (int i = 0; i < 2; ++i) {
            const bf16_t* r = p->P + grow_of(pb, srow + 32 * i) * PWID;
            rq[i] = *(const u32x4*)(r + PC_MQ + hd * 128 + sch * 8);
            rk[i] = *(const u32x4*)(r + PC_MK + hd * 128 + sch * 8);
        }
#pragma unroll
        for (int i = 0; i < 4; ++i) rv[i] = *(const u32x4*)(p->P + grow_of(pb, vrow + 16 * i) * PWID + PC_MV + hd * 256 + vch * 8);
        { const float* gr = p->GATES + grow_of(pb, lane) * 16 + dir * 8 + hd; rgi = gr[0]; rgf = gr[4]; }
    };
    issue(0);
    for (int t = 0; t < 36; ++t) {
        const int pb = chunk_pb(t);
        const float gi = rgi + gbi, gf = rgf + gbf;
        const float lf = fminf(gf, 0.f) - __logf(1.0f + __expf(-fabsf(gf)));
        float bcs = lf;
        bcs += dppf<0x111>(0.f, bcs); bcs += dppf<0x112>(0.f, bcs); bcs += dppf<0x114>(0.f, bcs); bcs += dppf<0x118>(0.f, bcs);
        {
            const float t0 = __builtin_bit_cast(float, __builtin_amdgcn_readlane(__builtin_bit_cast(int, bcs), 15));
            const float t1 = __builtin_bit_cast(float, __builtin_amdgcn_readlane(__builtin_bit_cast(int, bcs), 31));
            const float t2 = __builtin_bit_cast(float, __builtin_amdgcn_readlane(__builtin_bit_cast(int, bcs), 47));
            bcs += (q4 == 0) ? 0.f : ((q4 == 1) ? t0 : ((q4 == 2) ? (t0 + t1) : (t0 + t1 + t2)));
        }
        const float cval = gi - bcs;
        float cm = cval;
        cm = fmaxf(cm, dppf<0x111>(-3.0e38f, cm)); cm = fmaxf(cm, dppf<0x112>(-3.0e38f, cm)); cm = fmaxf(cm, dppf<0x114>(-3.0e38f, cm)); cm = fmaxf(cm, dppf<0x118>(-3.0e38f, cm));
        {
            const float t0 = __builtin_bit_cast(float, __builtin_amdgcn_readlane(__builtin_bit_cast(int, cm), 15));
            const float t1 = __builtin_bit_cast(float, __builtin_amdgcn_readlane(__builtin_bit_cast(int, cm), 31));
            const float t2 = __builtin_bit_cast(float, __builtin_amdgcn_readlane(__builtin_bit_cast(int, cm), 47));
            const float pm = (q4 == 0) ? -3.0e38f : ((q4 == 1) ? t0 : ((q4 == 2) ? fmaxf(t0, t1) : fmaxf(fmaxf(t0, t1), t2)));
            cm = fmaxf(cm, pm);
        }
        const float Mj = fmaxf(mstate, cm);
        const float bL = __builtin_bit_cast(float, __builtin_amdgcn_readlane(__builtin_bit_cast(int, bcs), 63)), ML = __builtin_bit_cast(float, __builtin_amdgcn_readlane(__builtin_bit_cast(int, Mj), 63));
        const float w_inter = __expf(mstate - Mj);
        const float w_s = __expf(cval - ML);
        const float w_c = __expf(mstate - ML);
        const float floorj = __expf(-bcs - Mj);
        if (wid == 0) { carr[lane] = cval; Marr[lane] = Mj; wsarr[lane] = w_s; wiarr[lane] = w_inter; }
        {
            const float ksc = 0.08838834764831845f;
#pragma unroll
            for (int i = 0; i < 2; ++i) {
                *(LAS u32x4*)(lds + ML_Q + (srow + 32 * i) * ML_QROW + sch * 16) = rq[i];
                u32x4 u = rk[i];
                u.x = pk2(lo_bf(u.x) * ksc, hi_bf(u.x) * ksc); u.y = pk2(lo_bf(u.y) * ksc, hi_bf(u.y) * ksc);
                u.z = pk2(lo_bf(u.z) * ksc, hi_bf(u.z) * ksc); u.w = pk2(lo_bf(u.w) * ksc, hi_bf(u.w) * ksc);
                *(LAS u32x4*)(lds + ML_K + (srow + 32 * i) * ML_KROW + sch * 16) = u;
            }
#pragma unroll
            for (int i = 0; i < 4; ++i) *(LAS u32x4*)(lds + ML_V + (vrow + 16 * i) * ML_VROW + vch * 16) = rv[i];
        }
        __syncthreads();
#pragma unroll
        for (int ti = 0; ti < 2; ++ti) {
            const int idx = wid * 2 + ti, jt = idx >> 2, st = idx & 3;
            f32x4 s = (f32x4){0.f, 0.f, 0.f, 0.f};
            if (st <= jt) {
#pragma unroll
                for (int ks = 0; ks < 4; ++ks) {
                    const bf16x8 kf = *(LAS bf16x8*)(lds + ML_K + (st * 16 + l15) * ML_KROW + ks * 64 + q4 * 16);
                    const bf16x8 qf = *(LAS bf16x8*)(lds + ML_Q + (jt * 16 + l15) * ML_QROW + ks * 64 + q4 * 16);
                    s = __builtin_amdgcn_mfma_f32_16x16x32_bf16(kf, qf, s, 0, 0, 0);
                }
                const int j = jt * 16 + l15;
                const float Mv = Marr[j];
#pragma unroll
                for (int r = 0; r < 4; ++r) { const int sidx = st * 16 + 4 * q4 + r; s[r] = (sidx <= j) ? s[r] * __expf(carr[sidx] - Mv) : 0.f; }
            }
            const unsigned p01 = pk2(s[0], s[1]), p23 = pk2(s[2], s[3]);
            *(LAS u32x2*)(lds + ML_S + (jt * 16 + l15) * ML_SROW + (st * 16 + 4 * q4) * 2) = mk2(p01, p23);
            {
                float rs = (lo_bf(p01) + hi_bf(p01)) + (lo_bf(p23) + hi_bf(p23));
                rs += sx_(rs, 16); rs += sx_(rs, 32);
                if (q4 == 0) ((LAS float*)(lds + ML_SSP))[st * 64 + jt * 16 + l15] = rs;
            }
        }
        {
            const int row = tid >> 3, part = tid & 7;
            LAS unsigned char* qp = lds + ML_Q + row * ML_QROW + part * 32;
            const u32x4 u0 = *(LAS u32x4*)qp, u1 = *(LAS u32x4*)(qp + 16);
            LAS float* nv = nbuf + (t & 1) * 128 + part * 16;
            const f32x4 n0 = *(LAS f32x4*)nv, n1 = *(LAS f32x4*)(nv + 4), n2 = *(LAS f32x4*)(nv + 8), n3 = *(LAS f32x4*)(nv + 12);
            float a = lo_bf(u0.x) * n0[0] + hi_bf(u0.x) * n0[1] + lo_bf(u0.y) * n0[2] + hi_bf(u0.y) * n0[3] + lo_bf(u0.z) * n1[0] + hi_bf(u0.z) * n1[1] + lo_bf(u0.w) * n1[2] + hi_bf(u0.w) * n1[3]
                    + lo_bf(u1.x) * n2[0] + hi_bf(u1.x) * n2[1] + lo_bf(u1.y) * n2[2] + hi_bf(u1.y) * n2[3] + lo_bf(u1.z) * n3[0] + hi_bf(u1.z) * n3[1] + lo_bf(u1.w) * n3[2] + hi_bf(u1.w) * n3[3];
            a += dppf<0xB1>(0.f, a); a += dppf<0x4E>(0.f, a); a += dppf<0x141>(0.f, a);
            if (part == 0) ((LAS float*)(lds + ML_QN))[row] = a;
        }
        {
            const int dk = tid & 127, part = tid >> 7;
            float a = 0.f;
#pragma unroll
            for (int s2 = 0; s2 < 16; ++s2) a += wsarr[part * 16 + s2] * bf2f(*(LAS bf16_t*)(lds + ML_K + (part * 16 + s2) * ML_KROW + dk * 2));
            npart[part * 128 + dk] = a;
        }
        __syncthreads();
        if (tid < 128) nbuf[((t + 1) & 1) * 128 + tid] = w_c * nbuf[(t & 1) * 128 + tid] + (npart[tid] + npart[128 + tid]) + (npart[256 + tid] + npart[384 + tid]);
        float rden;
        {
            LAS float* ssp = (LAS float*)(lds + ML_SSP);
            const float ssum = (ssp[lane] + ssp[64 + lane]) + (ssp[128 + lane] + ssp[192 + lane]);
            const float den = ssum + w_inter * ((LAS float*)(lds + ML_QN))[lane];
            rden = __builtin_amdgcn_rcpf(fmaxf(fabsf(den), floorj));
        }
        f32x4 acc[4][2];
#pragma unroll
        for (int m = 0; m < 4; ++m) { acc[m][0] = (f32x4){0.f, 0.f, 0.f, 0.f}; acc[m][1] = acc[m][0]; }
#pragma unroll
        for (int tt = 0; tt < 4; ++tt) {
            bf16x8 cb[2];
#pragma unroll
            for (int nn = 0; nn < 2; ++nn) {
                union { bf16x8 v; unsigned u[4]; } cv;
                cv.u[0] = pk2(C[2 * tt][nn][0], C[2 * tt][nn][1]); cv.u[1] = pk2(C[2 * tt][nn][2], C[2 * tt][nn][3]);
                cv.u[2] = pk2(C[2 * tt + 1][nn][0], C[2 * tt + 1][nn][1]); cv.u[3] = pk2(C[2 * tt + 1][nn][2], C[2 * tt + 1][nn][3]);
                cb[nn] = cv.v;
            }
#pragma unroll
            for (int m = 0; m < 4; ++m) {
                LAS unsigned char* qp = lds + ML_Q + (m * 16 + l15) * ML_QROW + (32 * tt + 4 * q4) * 2;
                const u32x2 a0 = *(LAS u32x2*)qp, a1 = *(LAS u32x2*)(qp + 32);
                union { bf16x8 v; unsigned u[4]; } av; av.u[0] = a0.x; av.u[1] = a0.y; av.u[2] = a1.x; av.u[3] = a1.y;
                acc[m][0] = __builtin_amdgcn_mfma_f32_16x16x32_bf16(av.v, cb[0], acc[m][0], 0, 0, 0);
                acc[m][1] = __builtin_amdgcn_mfma_f32_16x16x32_bf16(av.v, cb[1], acc[m][1], 0, 0, 0);
            }
        }
#pragma unroll
        for (int m = 0; m < 4; ++m) {
            const f32x4 wi = *(LAS f32x4*)(wiarr + m * 16 + 4 * q4);
#pragma unroll
            for (int r = 0; r < 4; ++r) { acc[m][0][r] *= wi[r]; acc[m][1][r] *= wi[r]; }
        }
        bf16x8 vfr[2][2];
#pragma unroll
        for (int nn = 0; nn < 2; ++nn)
#pragma unroll
            for (int ks = 0; ks < 2; ++ks) {
                LAS unsigned char* vp2 = lds + ML_V + (32 * ks + 8 * q4 + (l15 >> 2)) * ML_VROW + ((2 * wid + nn) * 16 + (l15 & 3) * 4) * 2;
                const s16x4 v0 = __builtin_amdgcn_ds_read_tr16_b64_v4i16((LAS s16x4*)vp2);
                const s16x4 v1 = __builtin_amdgcn_ds_read_tr16_b64_v4i16((LAS s16x4*)(vp2 + 4 * ML_VROW));
                vfr[nn][ks] = (bf16x8){v0[0], v0[1], v0[2], v0[3], v1[0], v1[1], v1[2], v1[3]};
            }
#pragma unroll
        for (int m = 0; m < 4; ++m)
#pragma unroll
            for (int ks = 0; ks < 2; ++ks) {
                const bf16x8 sf = *(LAS bf16x8*)(lds + ML_S + (m * 16 + l15) * ML_SROW + ks * 64 + q4 * 16);
                acc[m][0] = __builtin_amdgcn_mfma_f32_16x16x32_bf16(sf, vfr[0][ks], acc[m][0], 0, 0, 0);
                acc[m][1] = __builtin_amdgcn_mfma_f32_16x16x32_bf16(sf, vfr[1][ks], acc[m][1], 0, 0, 0);
            }
        {
            LAS float* rdw = (LAS float*)(lds + ML_RD) + wid * 64;
            rdw[lane] = rden;
#pragma unroll
            for (int m = 0; m < 4; ++m) {
                const f32x4 rd = *(LAS f32x4*)(rdw + m * 16 + 4 * q4);
#pragma unroll
                for (int r = 0; r < 4; ++r) {
                    LAS bf16_t* hp = (LAS bf16_t*)(lds + ML_H + (m * 16 + 4 * q4 + r) * ML_HROW) + (2 * wid) * 16 + l15;
                    hp[0] = (bf16_t)(pk2(acc[m][0][r] * rd[r], 0.f) & 0xffffu);
                    hp[16] = (bf16_t)(pk2(acc[m][1][r] * rd[r], 0.f) & 0xffffu);
                }
            }
        }
        if (t + 1 < 36) issue(t + 1);
        {
            bf16x8 vw[2][2];
#pragma unroll
            for (int ks = 0; ks < 2; ++ks) {
                const f32x4 w0 = *(LAS f32x4*)(wsarr + 32 * ks + 8 * q4), w1 = *(LAS f32x4*)(wsarr + 32 * ks + 8 * q4 + 4);
#pragma unroll
                for (int nn = 0; nn < 2; ++nn) {
                    union { bf16x8 v; unsigned u[4]; } x; x.v = vfr[nn][ks];
                    x.u[0] = pk2(lo_bf(x.u[0]) * w0[0], hi_bf(x.u[0]) * w0[1]); x.u[1] = pk2(lo_bf(x.u[1]) * w0[2], hi_bf(x.u[1]) * w0[3]);
                    x.u[2] = pk2(lo_bf(x.u[2]) * w1[0], hi_bf(x.u[2]) * w1[1]); x.u[3] = pk2(lo_bf(x.u[3]) * w1[2], hi_bf(x.u[3]) * w1[3]);
                    vw[nn][ks] = x.v;
                }
            }
#pragma unroll
            for (int dk = 0; dk < 8; ++dk) {
                C[dk][0] *= w_c; C[dk][1] *= w_c;
#pragma unroll
                for (int ks = 0; ks < 2; ++ks) {
                    LAS unsigned char* kp2 = lds + ML_K + (32 * ks + 8 * q4 + (l15 >> 2)) * ML_KROW + (dk * 16 + (l15 & 3) * 4) * 2;
                    const s16x4 k0 = __builtin_amdgcn_ds_read_tr16_b64_v4i16((LAS s16x4*)kp2);
                    const s16x4 k1 = __builtin_amdgcn_ds_read_tr16_b64_v4i16((LAS s16x4*)(kp2 + 4 * ML_KROW));
                    const bf16x8 kf = {k0[0], k0[1], k0[2], k0[3], k1[0], k1[1], k1[2], k1[3]};
                    C[dk][0] = __builtin_amdgcn_mfma_f32_16x16x32_bf16(kf, vw[0][ks], C[dk][0], 0, 0, 0);
                    C[dk][1] = __builtin_amdgcn_mfma_f32_16x16x32_bf16(kf, vw[1][ks], C[dk][1], 0, 0, 0);
                }
            }
        }
        mstate = bL + ML;
        __syncthreads();
        {
            bf16_t* hb = (dir == 0 ? p->YB : p->HB);
#pragma unroll
            for (int i = 0; i < 4; ++i) {
                const int j = vrow + 16 * i;
                const u32x4 v = *(LAS u32x4*)(lds + ML_H + j * ML_HROW + vch * 16);
                *(u32x4*)(hb + grow_of(pb, j) * 1024 + hd * 256 + vch * 8) = v;
            }
        }
    }
}

__device__ __forceinline__ void phase_mlfinish(CP p, int L, int bid, int nb) {
    const int lane = ltid() & 63, wid = ltid() >> 6;
    const int RG = p->G * SALL;
    const float* ng = p->ml_norm_g + L * 1024;
    for (int r = bid * 8 + wid; r < RG; r += nb * 8) {
        if (L == 1 && (r % SALL) < CTXL) continue;
        u32x2 a[4], b2[4], ov[4];
#pragma unroll
        for (int hh = 0; hh < 4; ++hh) {
            const int col = hh * 256 + lane * 4;
            a[hh] = *(const u32x2*)(p->YB + (size_t)r * 1024 + col); b2[hh] = *(const u32x2*)(p->HB + (size_t)r * 1024 + col); ov[hh] = mk2(*(const unsigned*)(p->MO8 + (size_t)r * 1024 + col), 0u);
        }
#pragma unroll
        for (int hh = 0; hh < 4; ++hh) {
            const int col = hh * 256 + lane * 4;
            float v[4] = {lo_bf(a[hh].x) + lo_bf(b2[hh].x), hi_bf(a[hh].x) + hi_bf(b2[hh].x), lo_bf(a[hh].y) + lo_bf(b2[hh].y), hi_bf(a[hh].y) + hi_bf(b2[hh].y)};
            const float ss = wave_sum(v[0] * v[0] + v[1] * v[1] + v[2] * v[2] + v[3] * v[3]);
            const float rstd = rsqrtf(ss * (1.0f / 256.0f) + 1e-6f);
            const float4 g = *(const float4*)(ng + col);
            const f32x2 q0 = __builtin_amdgcn_cvt_pk_f32_fp8((int)ov[hh].x, false), q1 = __builtin_amdgcn_cvt_pk_f32_fp8((int)ov[hh].x, true);
            const float o0 = sigmoidf_(q0[0]), o1 = sigmoidf_(q0[1]), o2 = sigmoidf_(q1[0]), o3 = sigmoidf_(q1[1]);
            if (MERGE_F8) { int w8 = 0; w8 = __builtin_amdgcn_cvt_pk_fp8_f32(v[0] * rstd * g.x * o0, v[1] * rstd * g.y * o1, w8, false); w8 = __builtin_amdgcn_cvt_pk_fp8_f32(v[2] * rstd * g.z * o2, v[3] * rstd * g.w * o3, w8, true); *(unsigned*)(p->YB8 + (size_t)r * 1024 + col) = (unsigned)w8; }
            else *(u32x2*)(p->YB + (size_t)r * 1024 + col) = mk2(pk2(v[0] * rstd * g.x * o0, v[1] * rstd * g.y * o1), pk2(v[2] * rstd * g.z * o2, v[3] * rstd * g.w * o3));
        }
    }
}

constexpr int LSEG = 128, LNSEG = SALL / LSEG, LCTXSEG = CTXL / LSEG, LMT = LSEG / 16;
constexpr int LC_XA = 0, LC_ROW = 272, LC_UB = LC_XA + (LSEG + 4) * LC_ROW, LC_HB = LC_UB + LSEG * LC_ROW, LC_CW = LC_HB + LSEG * LC_ROW, LC_END = LC_CW + 5 * 128 * 4;
static_assert(LC_END <= 131072, "LRU LDS");
#define LRU_SCAN_STAGE(SH) \
    "v_fmac_f32_dpp %0, %0, %4 " SH " row_mask:0xf bank_mask:0xf\n\tv_fmac_f32_dpp %1, %1, %5 " SH " row_mask:0xf bank_mask:0xf\n\t" \
    "v_fmac_f32_dpp %2, %2, %6 " SH " row_mask:0xf bank_mask:0xf\n\tv_fmac_f32_dpp %3, %3, %7 " SH " row_mask:0xf bank_mask:0xf\n\t" \
    "v_mul_f32_dpp %4, %4, %4 " SH " row_mask:0xf bank_mask:0xf\n\tv_mul_f32_dpp %5, %5, %5 " SH " row_mask:0xf bank_mask:0xf\n\t" \
    "v_mul_f32_dpp %6, %6, %6 " SH " row_mask:0xf bank_mask:0xf\n\tv_mul_f32_dpp %7, %7, %7 " SH " row_mask:0xf bank_mask:0xf\n\t"
template <int D>
__device__ __forceinline__ void lru_scan16(float (&a)[LMT][4], float (&b)[LMT][4]) {
#pragma unroll
    for (int m = 0; m < LMT; ++m) {
        if (D == 0) asm volatile("s_nop 1\n\t" LRU_SCAN_STAGE("row_shr:1") LRU_SCAN_STAGE("row_shr:2") LRU_SCAN_STAGE("row_shr:4") LRU_SCAN_STAGE("row_shr:8")
                                 : "+v"(b[m][0]), "+v"(b[m][1]), "+v"(b[m][2]), "+v"(b[m][3]), "+v"(a[m][0]), "+v"(a[m][1]), "+v"(a[m][2]), "+v"(a[m][3]));
        else asm volatile("s_nop 1\n\t" LRU_SCAN_STAGE("row_shl:1") LRU_SCAN_STAGE("row_shl:2") LRU_SCAN_STAGE("row_shl:4") LRU_SCAN_STAGE("row_shl:8")
                          : "+v"(b[m][0]), "+v"(b[m][1]), "+v"(b[m][2]), "+v"(b[m][3]), "+v"(a[m][0]), "+v"(a[m][1]), "+v"(a[m][2]), "+v"(a[m][3]));
    }
}
template <int D>
__device__ __forceinline__ void lru_chain_dir(CP p, int L, LAS unsigned char* lds, int bl, int hb) {
    const int tid = ltid(), lane = tid & 63, wid = tid >> 6, q4 = lane >> 4, l15 = lane & 15;
    const size_t rowbase = (size_t)bl * SALL;
    LAS float* cwl = (LAS float*)(lds + LC_CW);
    __syncthreads();
    for (int e = tid; e < 5 * 128; e += NTHREADS) { const int j = e >> 7, ch = e & 127; cwl[e] = (j < 4) ? p->conv_w[((size_t)L * 4 + j) * 1024 + hb * 128 + ch] : p->conv_b[L * 1024 + hb * 128 + ch]; }
    bf16x8 wf[2][4];
    {
        const int cq = wid >> 1, n0 = wid & 1;
        const bf16_t* wb = p->bt_lru + ((size_t)(D * 8 + hb) * 256 + cq * 64 + n0 * 16 + l15) * 128 + q4 * 8;
#pragma unroll
        for (int g = 0; g < 2; ++g)
#pragma unroll
            for (int ks = 0; ks < 4; ++ks) wf[g][ks] = *(const bf16x8*)(wb + (size_t)g * 32 * 128 + ks * 32);
    }
    const int chb = wid * 16 + 4 * q4, gch = hb * 128 + chb;
    const f32x4 ba = *(const f32x4*)(p->lru_ba + (L * 2 + D) * 1024 + gch), bx = *(const f32x4*)(p->lru_bx + (L * 2 + D) * 1024 + gch);
    f32x4 sp;
    { const f32x4 lam = *(const f32x4*)(p->lru_lam + (L * 2 + D) * 1024 + gch);
#pragma unroll
      for (int j = 0; j < 4; ++j) { const float z = -lam[j]; sp[j] = -8.0f * (fmaxf(z, 0.f) + log1pf(__expf(-fabsf(z)))); } }
    float carry[4] = {0.f, 0.f, 0.f, 0.f};
    const int t = tid >> 3, c8 = tid & 7;
    const bf16_t* pbase = p->P + rowbase * PWID + PC_XA + hb * 128;
    bf16_t* obase = (D == 0 ? p->YA : p->HB2) + rowbase * 1024 + hb * 128;
    u32x4 x0[2], x1[2], h0, h1;
    auto seg_of = [&](int s) -> int { return D == 0 ? s : (s < LCTXSEG ? LCTXSEG - 1 - s : LNSEG + LCTXSEG - 1 - s); };
    auto issue = [&](int s) {
        const int seg = seg_of(s), pb = seg * LSEG, lo = (seg < LCTXSEG) ? 0 : CTXL, hi = (seg < LCTXSEG) ? CTXL : SALL;
        const int tid = ltid(), t = tid >> 3, c8 = tid & 7;
#pragma unroll
        for (int i = 0; i < 2; ++i) { const bf16_t* xr = (const bf16_t*)((const char*)pbase + (unsigned)(((pb + t + 64 * i) * PWID + c8 * 16) * 2)); x0[i] = *(const u32x4*)xr; x1[i] = *(const u32x4*)(xr + 8); }
        h0 = mk4(0u, 0u, 0u, 0u); h1 = h0;
        if (tid < 24) {
            const int pos = (t < 2) ? (pb - 2 + t) : (pb + LSEG);
            if (pos >= lo && pos < hi) { const bf16_t* hr = (const bf16_t*)((const char*)pbase + (unsigned)((pos * PWID + c8 * 16) * 2)); h0 = *(const u32x4*)hr; h1 = *(const u32x4*)(hr + 8); }
        }
    };
    issue(0);
    for (int s = 0; s < LNSEG; ++s) {
        const int seg = seg_of(s), pb = seg * LSEG;
#pragma unroll
        for (int i = 0; i < 2; ++i) { *(LAS u32x4*)(lds + LC_XA + (t + 64 * i + 2) * LC_ROW + c8 * 32) = x0[i]; *(LAS u32x4*)(lds + LC_XA + (t + 64 * i + 2) * LC_ROW + c8 * 32 + 16) = x1[i]; }
        if (tid < 24) { const int lr = (t < 2) ? t : (LSEG + 2); *(LAS u32x4*)(lds + LC_XA + lr * LC_ROW + c8 * 32) = h0; *(LAS u32x4*)(lds + LC_XA + lr * LC_ROW + c8 * 32 + 16) = h1; }
        if (s + 1 < LNSEG) issue(s + 1);
        __syncthreads();
        {
            const int cg = tid & 31, r0c = (tid >> 5) * 8;
            f32x4 cwr[5];
#pragma unroll
            for (int j = 0; j < 5; ++j) cwr[j] = *(LAS f32x4*)(cwl + j * 128 + cg * 4);
            float xw[4][4];
#pragma unroll
            for (int k = 0; k < 3; ++k) { const u32x2 a = *(LAS u32x2*)(lds + LC_XA + (r0c + k) * LC_ROW + cg * 8); xw[k][0] = lo_bf(a.x); xw[k][1] = hi_bf(a.x); xw[k][2] = lo_bf(a.y); xw[k][3] = hi_bf(a.y); }
#pragma unroll
            for (int k = 0; k < 8; ++k) {
                { const u32x2 a = *(LAS u32x2*)(lds + LC_XA + (r0c + k + 3) * LC_ROW + cg * 8); xw[(k + 3) & 3][0] = lo_bf(a.x); xw[(k + 3) & 3][1] = hi_bf(a.x); xw[(k + 3) & 3][2] = lo_bf(a.y); xw[(k + 3) & 3][3] = hi_bf(a.y); }
                float u[4];
#pragma unroll
                for (int i = 0; i < 4; ++i) u[i] = cwr[4][i] + cwr[0][i] * xw[k & 3][i] + cwr[1][i] * xw[(k + 1) & 3][i] + cwr[2][i] * xw[(k + 2) & 3][i] + cwr[3][i] * xw[(k + 3) & 3][i];
                *(LAS u32x2*)(lds + LC_UB + (r0c + k) * LC_ROW + cg * 8) = mk2(pk2(u[0], u[1]), pk2(u[2], u[3]));
            }
        }
        __syncthreads();
        float a[LMT][4], b[LMT][4];
#pragma unroll
        for (int m = 0; m < LMT; ++m) {
            f32x4 acc0 = (f32x4){0.f, 0.f, 0.f, 0.f}, acc1 = acc0;
#pragma unroll
            for (int ks = 0; ks < 4; ++ks) {
                const bf16x8 uu = *(LAS bf16x8*)(lds + LC_UB + (m * 16 + l15) * LC_ROW + ks * 64 + q4 * 16);
                acc0 = __builtin_amdgcn_mfma_f32_16x16x32_bf16(wf[0][ks], uu, acc0, 0, 0, 0);
                acc1 = __builtin_amdgcn_mfma_f32_16x16x32_bf16(wf[1][ks], uu, acc1, 0, 0, 0);
            }
            const u32x2 uv = *(LAS u32x2*)(lds + LC_UB + (m * 16 + l15) * LC_ROW + chb * 2);
            const float uf4[4] = {lo_bf(uv.x), hi_bf(uv.x), lo_bf(uv.y), hi_bf(uv.y)};
#pragma unroll
            for (int j = 0; j < 4; ++j) {
                const float rr = __builtin_amdgcn_rcpf(1.0f + __expf(-(acc0[j] + ba[j]))), ii = __builtin_amdgcn_rcpf(1.0f + __expf(-(acc1[j] + bx[j])));
                const float av = __expf(rr * sp[j]);
                a[m][j] = av; b[m][j] = __builtin_amdgcn_sqrtf(fmaxf(1.0f - av * av, 0.f)) * ii * uf4[j];
            }
        }
        lru_scan16<D>(a, b);
#pragma unroll
        for (int j = 0; j < 4; ++j) {
            float h = carry[j];
#pragma unroll
            for (int mi = 0; mi < LMT; ++mi) {
                const int m = (D == 0) ? mi : LMT - 1 - mi;
                const float hv = a[m][j] * h + b[m][j];
                b[m][j] = hv;
                h = (D == 0) ? dppf<0x15F>(0.f, hv) : dppf<0x150>(0.f, hv);
            }
            carry[j] = h;
        }
#pragma unroll
        for (int m = 0; m < LMT; ++m) *(LAS u32x2*)(lds + LC_HB + (m * 16 + l15) * LC_ROW + chb * 2) = mk2(pk2(b[m][0], b[m][1]), pk2(b[m][2], b[m][3]));
        __syncthreads();
#pragma unroll
        for (int i = 0; i < 2; ++i) {
            const int r = t + 64 * i;
            bf16_t* dst = (bf16_t*)((char*)obase + (unsigned)(((pb + r) * 1024 + c8 * 16) * 2));
            *(u32x4*)dst = *(LAS u32x4*)(lds + LC_HB + r * LC_ROW + c8 * 32); *(u32x4*)(dst + 8) = *(LAS u32x4*)(lds + LC_HB + r * LC_ROW + c8 * 32 + 16);
        }
    }
}
__device__ __forceinline__ void lru_chain_unit(CP p, int L, LAS unsigned char* lds, int bl, int hb, int d) {
    if (d == 0) lru_chain_dir<0>(p, L, lds, bl, hb); else lru_chain_dir<1>(p, L, lds, bl, hb);
}
__device__ __forceinline__ void phase_lrufinish(CP p, int L, int bid, int nb) {
    const int tid = ltid();
    const int nv = (L == 0) ? p->G * SALL : p->G * SEQ;
    const long total = (long)nv * 128, stride = (long)nb * NTHREADS;
    for (long e0 = (long)bid * NTHREADS + tid; e0 < total; e0 += 2 * stride) {
        u32x4 hf[2], hb[2], ga[2]; size_t off[2]; bool ok[2];
#pragma unroll
        for (int k = 0; k < 2; ++k) {
            const long e = e0 + k * stride; ok[k] = e < total;
            const int i = (int)((ok[k] ? e : e0) >> 7), c = (int)((ok[k] ? e : e0) & 127) * 8;
            const int r = (L == 0) ? i : ((i >> 11) * SALL + CTXL + (i & 2047));
            off[k] = (size_t)r * 1024 + c;
            hf[k] = *(const u32x4*)(p->YA + off[k]); hb[k] = *(const u32x4*)(p->HB2 + off[k]); ga[k] = *(const u32x4*)(p->P + (size_t)r * PWID + PC_GA + c);
        }
#pragma unroll
        for (int k = 0; k < 2; ++k) {
            if (!ok[k]) continue;
            u32x4 o;
            o.x = pk2(gelu_tanh(lo_bf(ga[k].x)) * (lo_bf(hf[k].x) + lo_bf(hb[k].x)), gelu_tanh(hi_bf(ga[k].x)) * (hi_bf(hf[k].x) + hi_bf(hb[k].x)));
            o.y = pk2(gelu_tanh(lo_bf(ga[k].y)) * (lo_bf(hf[k].y) + lo_bf(hb[k].y)), gelu_tanh(hi_bf(ga[k].y)) * (hi_bf(hf[k].y) + hi_bf(hb[k].y)));
            o.z = pk2(gelu_tanh(lo_bf(ga[k].z)) * (lo_bf(hf[k].z) + lo_bf(hb[k].z)), gelu_tanh(hi_bf(ga[k].z)) * (hi_bf(hf[k].z) + hi_bf(hb[k].z)));
            o.w = pk2(gelu_tanh(lo_bf(ga[k].w)) * (lo_bf(hf[k].w) + lo_bf(hb[k].w)), gelu_tanh(hi_bf(ga[k].w)) * (hi_bf(hf[k].w) + hi_bf(hb[k].w)));
            *(u32x4*)(p->YA + off[k]) = o;
        }
    }
}

__device__ __forceinline__ int next_unit(unsigned* ctr, LAS unsigned char* lds) {
    LAS int* slot = (LAS int*)(lds + LDS_BYTES - 32);
    __syncthreads();
    if (ltid() == 0) *slot = (int)__hip_atomic_fetch_add(ctr, 1u, __ATOMIC_RELAXED, __HIP_MEMORY_SCOPE_AGENT);
    __syncthreads();
    return __builtin_amdgcn_readfirstlane(*slot);
}
__device__ __forceinline__ void phase_probe_at(CP p, int L, LAS unsigned char* lds, int bid, int nb) {
    const int nqt = (L == 0) ? 9 : 8, nat = p->G * 8 * nqt;
    for (int u = bid; u < nat; u += nb) { const int qt = u % nqt, bh = u / nqt; attn_unit2(p, L, lds, bh >> 3, bh & 7, qt); }
}
__device__ __forceinline__ void phase_probe_lru(CP p, int L, LAS unsigned char* lds, int bid, int nb) {
    for (int v = bid; v < p->G * 16; v += nb) lru_chain_unit(p, L, lds, v >> 4, (v >> 1) & 7, v & 1);
}
__device__ __forceinline__ void phase_probe_ml(CP p, int L, LAS unsigned char* lds, int bid, int nb) {
    for (int u = bid; u < p->G * 8; u += nb) mlstm_unit(p, L, lds, u >> 3, (u >> 1) & 3, u & 1);
}
__device__ __forceinline__ void phase_mix_dyn(CP p, int L, int grp, LAS unsigned char* lds, int cofs = 0) {
    unsigned* ctr = (unsigned*)p->ecnt + 128 + (L * 8 + grp) * 4 + cofs;
    const int nml = p->G * 8, nqt = (L == 0) ? 9 : 8, nat = p->G * 8 * nqt, nlr = p->G * 16;
    int u = next_unit(ctr, lds);
    while (u < nml) { mlstm_unit(p, L, lds, u >> 3, (u >> 1) & 3, u & 1); u = next_unit(ctr, lds); }
    while (u < nml + nlr) { const int v = u - nml; lru_chain_unit(p, L, lds, v >> 4, (v >> 1) & 7, v & 1); u = next_unit(ctr, lds); }
    while (u < nml + nlr + nat) { const int v = u - nml - nlr; const int nlat = p->G * 64; const int qt = (v < nlat) ? (v & 7) : 8, bh = (v < nlat) ? (v >> 3) : (v - nlat);
        attn_unit2(p, L, lds, bh >> 3, bh & 7, qt); u = next_unit(ctr, lds); }
}
__device__ __forceinline__ int vidx_to_r(int L, int i) { return L == 0 ? i : ((i >> 11) * SALL + CTXL + (i & 2047)); }
__device__ __forceinline__ float* xrow_ptr(CP p, int grp, int r, int L, const float*& md) {
    const int bl = r / SALL, pos = r - bl * SALL, b = grp * p->G + bl;
    if (pos < CTXL) { md = p->mods_c + (size_t)L * 6144; return p->XC1 + ((size_t)b * CTXL + pos) * 1024; }
    md = p->mods_l + ((size_t)L * 32 + b) * 6144; return p->out + ((size_t)b * SEQ + (pos - CTXL)) * 1024;
}
constexpr int RCH = 32, RPICK = RCH * 6;
constexpr int RT_H = 0, RT_HROW = 1028, RT_PART = 16 * RT_HROW * 4, RT_PICK = RT_PART + 8 * 16 * 64 * 4, RT_END = RT_PICK + RPICK * 12;
__device__ __forceinline__ void split_bf(float a0, float a1, unsigned& hi, unsigned& lo) { hi = pk2(a0, a1); lo = pk2(a0 - lo_bf(hi), a1 - hi_bf(hi)); }
__device__ __forceinline__ void phase_route1(CP p, int L, int grp, LAS unsigned char* lds, int bid, int nb) {
    const int tid = ltid(), lane = tid & 63, wid = tid >> 6, q4 = lane >> 4, l15 = lane & 15;
    LAS float* hs = (LAS float*)(lds + RT_H);
    LAS float* part = (LAS float*)(lds + RT_PART);
    LAS int* pick_e = (LAS int*)(lds + RT_PICK);
    LAS float* pick_w = (LAS float*)(pick_e + RPICK);
    LAS int* pick_r = (LAS int*)(pick_e + 2 * RPICK);
    const float* g2 = p->norm2_g + L * 1024;
    const float brv = p->b_router[L * 64 + lane];
    const float* wr = p->w_router + (size_t)L * 1024 * 64;
    const int nchunks = p->G * SALL / RCH;
    bf16x8 whi[4][4], wlo[4][4];
#pragma unroll
    for (int ks = 0; ks < 4; ++ks)
#pragma unroll
        for (int n = 0; n < 4; ++n) { unsigned h[4], l[4];
#pragma unroll
            for (int jj = 0; jj < 4; ++jj) { const float* wp = wr + (size_t)(wid * 128 + ks * 32 + q4 * 8 + 2 * jj) * 64 + n * 16 + l15; split_bf(wp[0], wp[64], h[jj], l[jj]); }
            whi[ks][n] = __builtin_bit_cast(bf16x8, mk4(h[0], h[1], h[2], h[3])); wlo[ks][n] = __builtin_bit_cast(bf16x8, mk4(l[0], l[1], l[2], l[3])); }
    const int cpb = SALL / RCH, cctx = CTXL / RCH;
#define RT_NEXT_VALID(cv) do { while ((cv) < nchunks && L == 1 && ((cv) % cpb) < cctx) { if (tid < 64) p->CC[(cv) * 64 + tid] = 0; (cv) += nb; } } while (0)
#define RT_LOAD(rbase) do { _Pragma("unroll") for (int rr = 0; rr < 2; ++rr) { const float* md_; const float* src_ = xrow_ptr(p, grp, (rbase) + rr, L, md_); \
        _Pragma("unroll") for (int i = 0; i < 4; ++i) v[rr][i] = *(const float4*)(src_ + i * 256 + lane * 4); } } while (0)
    int chunk = bid; RT_NEXT_VALID(chunk);
    float4 v[2][4];
    if (chunk < nchunks) RT_LOAD(chunk * RCH + wid * 2);
    while (chunk < nchunks) {
        int nchunk = chunk + nb; RT_NEXT_VALID(nchunk);
#pragma nounroll
        for (int sub = 0; sub < RCH / 16; ++sub) {
            const int r0 = chunk * RCH + sub * 16;
            __syncthreads();
            {
                float ss[2] = {0.f, 0.f};
#pragma unroll
                for (int rr = 0; rr < 2; ++rr)
#pragma unroll
                    for (int i = 0; i < 4; ++i) ss[rr] += v[rr][i].x * v[rr][i].x + v[rr][i].y * v[rr][i].y + v[rr][i].z * v[rr][i].z + v[rr][i].w * v[rr][i].w;
#pragma unroll
                for (int o = 32; o >= 1; o >>= 1) { ss[0] += sx_(ss[0], o); ss[1] += sx_(ss[1], o); }
#pragma unroll
                for (int rr = 0; rr < 2; ++rr) {
                    const int tl = wid * 2 + rr, r = r0 + tl;
                    const float* md; (void)xrow_ptr(p, grp, r, L, md);
                    const float rstd = rsqrtf(ss[rr] * (1.0f / 1024.0f) + 1e-6f);
#pragma unroll
                    for (int i = 0; i < 4; ++i) {
                        const int col = i * 256 + lane * 4;
                        const float4 g = *(const float4*)(g2 + col), sh = *(const float4*)(md + 3072 + col), sc = *(const float4*)(md + 4096 + col);
                        const float o0 = v[rr][i].x * rstd * g.x * (1.f + sc.x) + sh.x, o1 = v[rr][i].y * rstd * g.y * (1.f + sc.y) + sh.y;
                        const float o2 = v[rr][i].z * rstd * g.z * (1.f + sc.z) + sh.z, o3 = v[rr][i].w * rstd * g.w * (1.f + sc.w) + sh.w;
                        { int w8 = 0; w8 = __builtin_amdgcn_cvt_pk_fp8_f32(o0, o1, w8, false); w8 = __builtin_amdgcn_cvt_pk_fp8_f32(o2, o3, w8, true); *(unsigned*)((unsigned char*)p->H2 + (size_t)r * 1024 + col) = (unsigned)w8; }
                        *(LAS f32x4*)(hs + tl * RT_HROW + col) = (f32x4){o0, o1, o2, o3};
                    }
                }
                if (sub == 0) RT_LOAD(r0 + 16 + wid * 2); else if (nchunk < nchunks) RT_LOAD(nchunk * RCH + wid * 2);
            }
            __syncthreads();
            {
                f32x4 lg[4];
#pragma unroll
                for (int n = 0; n < 4; ++n) lg[n] = (f32x4){0.f, 0.f, 0.f, 0.f};
#pragma unroll
                for (int ks = 0; ks < 4; ++ks) {
                    const LAS float* hp = hs + l15 * RT_HROW + wid * 128 + ks * 32 + q4 * 8;
                    const f32x4 x0 = *(const LAS f32x4*)hp, x1 = *(const LAS f32x4*)(hp + 4);
                    unsigned h[4], l[4];
                    split_bf(x0[0], x0[1], h[0], l[0]); split_bf(x0[2], x0[3], h[1], l[1]); split_bf(x1[0], x1[1], h[2], l[2]); split_bf(x1[2], x1[3], h[3], l[3]);
                    const bf16x8 ah = __builtin_bit_cast(bf16x8, mk4(h[0], h[1], h[2], h[3])), al = __builtin_bit_cast(bf16x8, mk4(l[0], l[1], l[2], l[3]));
#pragma unroll
                    for (int n = 0; n < 4; ++n) {
                        lg[n] = __builtin_amdgcn_mfma_f32_16x16x32_bf16(al, whi[ks][n], lg[n], 0, 0, 0);
                        lg[n] = __builtin_amdgcn_mfma_f32_16x16x32_bf16(ah, wlo[ks][n], lg[n], 0, 0, 0);
                        lg[n] = __builtin_amdgcn_mfma_f32_16x16x32_bf16(ah, whi[ks][n], lg[n], 0, 0, 0);
                    }
                }
#pragma unroll
                for (int n = 0; n < 4; ++n)
#pragma unroll
                    for (int r = 0; r < 4; ++r) part[(wid * 16 + 4 * q4 + r) * 64 + n * 16 + l15] = lg[n][r];
            }
            __syncthreads();
            {
                float score[2], sel[2], ssum[2] = {0.f, 0.f}; int myrank[2] = {-1, -1};
#pragma unroll
                for (int rr = 0; rr < 2; ++rr) {
                    const int tl = wid * 2 + rr; float lgt = 0.f;
#pragma unroll
                    for (int w8 = 0; w8 < 8; ++w8) lgt += part[(w8 * 16 + tl) * 64 + lane];
                    score[rr] = 1.0f / (1.0f + expf(-lgt)); sel[rr] = score[rr] + brv;
                }
#pragma unroll
                for (int k = 0; k < TOPK; ++k) {
#pragma unroll
                    for (int rr = 0; rr < 2; ++rr) {
                        float mv = sel[rr];
                        mv = fmaxf(mv, dppf<0x111>(-3.0e38f, mv)); mv = fmaxf(mv, dppf<0x112>(-3.0e38f, mv)); mv = fmaxf(mv, dppf<0x114>(-3.0e38f, mv)); mv = fmaxf(mv, dppf<0x118>(-3.0e38f, mv));
                        const float m0 = __builtin_bit_cast(float, __builtin_amdgcn_readlane(__builtin_bit_cast(int, mv), 15)), m1 = __builtin_bit_cast(float, __builtin_amdgcn_readlane(__builtin_bit_cast(int, mv), 31));
                        const float m2 = __builtin_bit_cast(float, __builtin_amdgcn_readlane(__builtin_bit_cast(int, mv), 47)), m3 = __builtin_bit_cast(float, __builtin_amdgcn_readlane(__builtin_bit_cast(int, mv), 63));
                        const float wm = fmaxf(fmaxf(m0, m1), fmaxf(m2, m3));
                        const unsigned long long bal = __ballot(sel[rr] == wm);
                        const int win = __ffsll((long long)bal) - 1;
                        ssum[rr] += __builtin_bit_cast(float, __builtin_amdgcn_readlane(__builtin_bit_cast(int, score[rr]), win));
                        if (lane == win) { myrank[rr] = k; sel[rr] = -1e30f; }
                    }
                }
#pragma unroll
                for (int rr = 0; rr < 2; ++rr)
                    if (myrank[rr] >= 0) { const int slot = (sub * 16 + wid * 2 + rr) * 6 + myrank[rr]; pick_e[slot] = lane; pick_w[slot] = score[rr] / ssum[rr] * 2.5f; }
            }
        }
        __syncthreads();
        {
            const int lane = ltid() & 63;
            const int e0 = pick_e[lane], e1 = pick_e[64 + lane], e2 = pick_e[128 + lane];
            int rk0 = 0, rk1 = 0, rk2 = 0, mycnt = 0;
#pragma unroll
            for (int x = 0; x < 8; ++x) {
                const int ex = wid * 8 + x;
                const unsigned long long m0 = __ballot(e0 == ex), m1 = __ballot(e1 == ex), m2 = __ballot(e2 == ex);
                const int c0 = __builtin_popcountll(m0), c1 = __builtin_popcountll(m1), c2 = __builtin_popcountll(m2);
                if (e0 == ex) rk0 = __builtin_amdgcn_mbcnt_hi((unsigned)(m0 >> 32), __builtin_amdgcn_mbcnt_lo((unsigned)m0, 0));
                if (e1 == ex) rk1 = c0 + __builtin_amdgcn_mbcnt_hi((unsigned)(m1 >> 32), __builtin_amdgcn_mbcnt_lo((unsigned)m1, 0));
                if (e2 == ex) rk2 = c0 + c1 + __builtin_amdgcn_mbcnt_hi((unsigned)(m2 >> 32), __builtin_amdgcn_mbcnt_lo((unsigned)m2, 0));
                if (lane == x) mycnt = c0 + c1 + c2;
            }
            if ((e0 >> 3) == wid) pick_r[lane] = rk0;
            if ((e1 >> 3) == wid) pick_r[64 + lane] = rk1;
            if ((e2 >> 3) == wid) pick_r[128 + lane] = rk2;
            if (lane < 8) p->CC[chunk * 64 + wid * 8 + lane] = mycnt;
        }
        __syncthreads();
        { const int s2 = ltid(); if (s2 < RPICK) { p->PE[(size_t)chunk * RPICK + s2] = pick_e[s2] | (pick_r[s2] << 8); p->PW[(size_t)chunk * RPICK + s2] = pick_w[s2]; } }
        chunk = nchunk;
    }
#undef RT_NEXT_VALID
#undef RT_LOAD
}
__device__ __forceinline__ void phase_route2(CP p, int L, LAS unsigned char* lds, int bid, int nb) {
    const int tid = ltid();
    LAS int* basel = (LAS int*)lds; LAS int* totl = basel + 256; LAS int* tabl = totl + 64; LAS int* pb = tabl + 128; LAS int* pt = pb + 4 * 512;
    const int nchunks = p->G * SALL / RCH;
    const int e = tid & 63, part = tid >> 6, per = (nchunks + 7) >> 3;
    __syncthreads();
    {
        int t = 0, b0 = 0, b1 = 0, b2 = 0, b3 = 0;
        const int k0 = bid, k1 = bid + nb, k2 = bid + 2 * nb, k3 = bid + 3 * nb;
        const int c0 = part * per, c1 = (c0 + per < nchunks) ? c0 + per : nchunks;
#pragma unroll 12
        for (int c = c0; c < c1; ++c) { const int v = p->CC[c * 64 + e]; t += v; b0 += (c < k0) ? v : 0; b1 += (c < k1) ? v : 0; b2 += (c < k2) ? v : 0; b3 += (c < k3) ? v : 0; }
        pt[part * 64 + e] = t; pb[part * 64 + e] = b0; pb[512 + part * 64 + e] = b1; pb[1024 + part * 64 + e] = b2; pb[1536 + part * 64 + e] = b3;
    }
    __syncthreads();
    if (tid < 64) {
        int t = 0, b[4] = {0, 0, 0, 0};
#pragma unroll
        for (int q = 0; q < 8; ++q) { t += pt[q * 64 + tid];
#pragma unroll
            for (int k = 0; k < 4; ++k) b[k] += pb[k * 512 + q * 64 + tid]; }
        totl[tid] = t;
#pragma unroll
        for (int k = 0; k < 4; ++k) basel[k * 64 + tid] = b[k];
        if (bid == 0) p->ecnt[tid] = t;
    }
    __syncthreads();
    if (tid == 0) { int acc = 0; for (int x = 0; x < 64; ++x) { tabl[x] = acc; acc += (totl[x] + 255) >> 8; } tabl[64] = acc; }
    __syncthreads();
    if (bid == 0) {
        const int dummy = (L == 0) ? 0 : CTXL;
        for (int x = tid; x < 64 * 256; x += NTHREADS) { const int ee = x >> 8, i = totl[ee] + (x & 255); if (i < (((totl[ee] + 255) >> 8) << 8)) { p->LIST[(size_t)tabl[ee] * 256 + i] = dummy; p->LISTW[(size_t)tabl[ee] * 256 + i] = 0.f; } }
    }
    {
        const int nv = (L == 0) ? p->G * SALL : p->G * SEQ; int* idl = p->LIST + (size_t)tabl[64] * 256;
        for (int i = bid * NTHREADS + tid; i < nv; i += nb * NTHREADS) idl[i] = vidx_to_r(L, i);
    }
    int kq = 0;
    for (int chunk = bid; chunk < nchunks; chunk += nb, ++kq) {
        if (L == 1 && (chunk % (SALL / RCH)) < (CTXL / RCH)) continue;
        for (int s2 = tid; s2 < RPICK; s2 += NTHREADS) {
            const int pe = p->PE[(size_t)chunk * RPICK + s2], ee = pe & 255, lr = pe >> 8;
            const int r = chunk * RCH + s2 / 6, pos = tabl[ee] * 256 + basel[kq * 64 + ee] + lr;
            p->LIST[pos] = r; p->LISTW[pos] = p->PW[(size_t)chunk * RPICK + s2];
            p->POS[(size_t)chunk * RPICK + s2] = pos;
        }
    }
}

constexpr int MOE_TAB = 131072;
__device__ __forceinline__ int moe_nshared(CP p, int L) { return L == 0 ? p->G * SALL : p->G * SEQ; }
__device__ __forceinline__ int moe_find(LAS int* tab, int tile) { int e = 0; for (int s = 64; s >= 1; s >>= 1) if (e + s <= 64 && tab[e + s] <= tile) e += s; return e; }
__device__ __forceinline__ void moe_table8(CP p, int L, LAS unsigned char* lds) {
    LAS int* tab = (LAS int*)(lds + MOE_TAB);
    __syncthreads();
    if (ltid() == 0) {
        int acc = 0;
        for (int e = 0; e < 65; ++e) { tab[e] = acc; const int c = (e < 64) ? p->ecnt[e] : moe_nshared(p, L); acc += (c + 255) >> 8; }
        tab[65] = acc;
    }
    __syncthreads();
}
__device__ __forceinline__ void phase_moe_combine(CP p, int L, int grp, LAS unsigned char* lds, int bid, int nb) {
    const int lane = ltid() & 63, wid = ltid() >> 6;
    moe_table8(p, L, lds);
    LAS int* tab = (LAS int*)(lds + MOE_TAB);
    const int nv = moe_nshared(p, L);
    const size_t sbase = (size_t)tab[64] * 256;
    const unsigned char* D8 = (const unsigned char*)p->DBUF;
    for (int i = bid * 8 + wid; i < nv; i += nb * 8) {
        const int r = vidx_to_r(L, i);
        const float* md; float* xr = xrow_ptr(p, grp, r, L, md);
        float a[16];
        u32x4 dv[7];
        int pos6[6];
#pragma unroll
        for (int k = 0; k < 6; ++k) pos6[k] = p->POS[(size_t)r * 6 + k];
        dv[0] = *(const u32x4*)(D8 + (sbase + i) * 1024 + lane * 16);
        f32x4 xv4[4], g4[4];
#pragma unroll
        for (int q = 0; q < 4; ++q) { xv4[q] = *(const f32x4*)(xr + lane * 16 + q * 4); g4[q] = *(const f32x4*)(md + 5120 + lane * 16 + q * 4); }
#pragma unroll
        for (int k = 0; k < 6; ++k) dv[k + 1] = *(const u32x4*)(D8 + (size_t)pos6[k] * 1024 + lane * 16);
#pragma unroll
        for (int q = 0; q < 16; ++q) a[q] = 0.f;
#pragma unroll
        for (int k = 0; k < 7; ++k)
#pragma unroll
            for (int w = 0; w < 4; ++w) {
                const f32x2 lo = __builtin_amdgcn_cvt_pk_f32_fp8((int)dv[k][w], false), hi = __builtin_amdgcn_cvt_pk_f32_fp8((int)dv[k][w], true);
                a[4 * w] += lo[0]; a[4 * w + 1] += lo[1]; a[4 * w + 2] += hi[0]; a[4 * w + 3] += hi[1];
            }
#pragma unroll
        for (int q = 0; q < 4; ++q) {
            const int col = lane * 16 + q * 4;
            const f32x4 g = g4[q];
            f32x4 xv = xv4[q];
            xv[0] += g[0] * a[4 * q] * D_ISCALE; xv[1] += g[1] * a[4 * q + 1] * D_ISCALE; xv[2] += g[2] * a[4 * q + 2] * D_ISCALE; xv[3] += g[3] * a[4 * q + 3] * D_ISCALE;
            *(f32x4*)(xr + col) = xv;
        }
    }
}

__device__ __forceinline__ int valid_tile(int L, int pmv) { return L == 0 ? pmv : ((pmv >> 3) * 9 + 1 + (pmv & 7)); }
struct SchedMerge { const char *Y, *B; size_t ystride; int nMv, L, G, c;
    __device__ __forceinline__ bool next(int i, pg8::Unit& u) const { int pmv, pn; if (!pg8::static_tile(i, G, c, nMv, 12, pmv, pn)) return false; const int pm = valid_tile(L, pmv), j = pn >> 2;
        u.pm = pm; u.pn = pn; u.tag = 0; u.rows = nullptr; u.a = Y + (size_t)j * ystride + (size_t)pm * 256 * 1024 * 2; u.b = B + (size_t)pn * 256 * 1024 * 2; return true; } };
struct SchedMerge8 { const char *YB8, *YC8, *B; int nMv, L, G, c;
    __device__ __forceinline__ bool next(int i, pg8::Unit& u) const { int pmv, q; if (!pg8::static_tile(i, G, c, nMv, 8, pmv, q)) return false; const int pm = valid_tile(L, pmv), pn = 4 + q, j = pn >> 2;
        u.pm = pm; u.pn = pn; u.tag = 0; u.rows = nullptr; u.a = (j == 1 ? YB8 : YC8) + (size_t)pm * 256 * 1024; u.b = B + (size_t)j * 1024 * 1024 * 2 + (size_t)(pn & 3) * 256 * 1024; return true; } };
struct SchedMerge0 { const char *Y, *B; int nMv, L, G, c;
    __device__ __forceinline__ bool next(int i, pg8::Unit& u) const { int pmv, pn; if (!pg8::static_tile(i, G, c, nMv, 4, pmv, pn)) return false; const int pm = valid_tile(L, pmv);
        u.pm = pm; u.pn = pn; u.tag = 0; u.rows = nullptr; u.a = Y + (size_t)pm * 256 * 1024 * 2; u.b = B + (size_t)pn * 256 * 1024 * 2; return true; } };
struct EpiBf16RowsS { static constexpr bool PERM = true; bf16_t* O; int ldo; float sc;
    __device__ __forceinline__ void operator()(const f32x4 (&acc)[2][2][4][2], const pg8::Unit& u, int wr, int wc, int fr, int fq) const {
        const size_t row0 = (size_t)u.pm * 256 + wr * 64 + fr;
#pragma unroll
        for (int ai = 0; ai < 2; ++ai)
#pragma unroll
            for (int m = 0; m < 4; ++m) { bf16_t* rowp = O + (row0 + ai * 128 + m * 16) * ldo + u.pn * 256 + wc * 32 + 8 * fq;
#pragma unroll
                for (int bj = 0; bj < 2; ++bj) { const f32x4 v0 = acc[ai][bj][m][0] * sc, v1 = acc[ai][bj][m][1] * sc;
                    *(u32x4*)(rowp + bj * 128) = mk4(pk2(v0[0], v0[1]), pk2(v0[2], v0[3]), pk2(v1[0], v1[1]), pk2(v1[2], v1[3])); } }
    } };
struct EpiBf16Rows { static constexpr bool PERM = true; bf16_t* O; int ldo;
    __device__ __forceinline__ void operator()(const f32x4 (&acc)[2][2][4][2], const pg8::Unit& u, int wr, int wc, int fr, int fq) const {
        const size_t row0 = (size_t)u.pm * 256 + wr * 64 + fr;
#pragma unroll
        for (int ai = 0; ai < 2; ++ai)
#pragma unroll
            for (int m = 0; m < 4; ++m) { bf16_t* rowp = O + (row0 + ai * 128 + m * 16) * ldo + u.pn * 256 + wc * 32 + 8 * fq;
#pragma unroll
                for (int bj = 0; bj < 2; ++bj) { const f32x4 v0 = acc[ai][bj][m][0], v1 = acc[ai][bj][m][1];
                    *(u32x4*)(rowp + bj * 128) = mk4(pk2(v0[0], v0[1]), pk2(v0[2], v0[3]), pk2(v1[0], v1[1]), pk2(v1[2], v1[3])); } }
    } };
template <int SCALED>
struct EpiFp8RowsT { static constexpr bool PERM = true; unsigned char* O; int ldo;
    __device__ __forceinline__ void operator()(const f32x4 (&acc)[2][2][4][2], const pg8::Unit& u, int wr, int wc, int fr, int fq) const {
        constexpr float SC = SCALED == 1 ? pg8::F8_WINV : (SCALED == 2 ? D_SCALE / (ACT_SC * DW_SC) : 1.0f);
        unsigned char* tb = O + ((size_t)u.pm * 256) * ldo + u.pn * 256;
        const unsigned lo0 = (unsigned)(wr * 64 + fr) * (unsigned)ldo + wc * 32 + 8 * fq;
#pragma unroll
        for (int ai = 0; ai < 2; ++ai)
#pragma unroll
            for (int m = 0; m < 4; ++m) { unsigned char* rowp = tb + (lo0 + (unsigned)(ai * 128 + m * 16) * (unsigned)ldo);
#pragma unroll
                for (int bj = 0; bj < 2; ++bj) { const f32x4 v0 = acc[ai][bj][m][0] * SC, v1 = acc[ai][bj][m][1] * SC;
                    int w0 = 0, w1 = 0;
                    w0 = __builtin_amdgcn_cvt_pk_fp8_f32(v0[0], v0[1], w0, false); w0 = __builtin_amdgcn_cvt_pk_fp8_f32(v0[2], v0[3], w0, true);
                    w1 = __builtin_amdgcn_cvt_pk_fp8_f32(v1[0], v1[1], w1, false); w1 = __builtin_amdgcn_cvt_pk_fp8_f32(v1[2], v1[3], w1, true);
                    *(u32x2*)(rowp + bj * 128) = mk2((unsigned)w0, (unsigned)w1); } }
    } };
typedef EpiFp8RowsT<0> EpiFp8Rows;
__device__ __forceinline__ void phase_merge8(CP p, int L, LAS unsigned char* lds, int bid, int nb) {
    if constexpr (MERGE_F8) {
        { SchedMerge8 S{(const char*)p->YB8, (const char*)p->YC, (const char*)p->bt_br, (L == 0 ? p->G * 9 : p->G * 8), L, nb, bid};
          EpiFp8RowsT<1> E{(unsigned char*)p->Z + 2048 - 4 * 256, 6144};
          pg8::gemm_phase<false, true>(lds, 512, S, E); }
        { SchedMerge0 S{(const char*)p->YA, (const char*)p->bt_br, (L == 0 ? p->G * 9 : p->G * 8), L, nb, nb - 1 - bid};
          EpiBf16Rows E{p->Z, 3072};
          pg8::gemm_phase<false, false>(lds, 1024, S, E); }
        return;
    }
    SchedMerge S{(const char*)p->YA, (const char*)p->bt_br, (size_t)((const char*)p->YB - (const char*)p->YA), (L == 0 ? p->G * 9 : p->G * 8), L, nb, bid};
    EpiBf16Rows E{p->Z, 3072};
    pg8::gemm_phase<false, false>(lds, 1024, S, E);
}
__device__ __forceinline__ void phase_gate(CP p, int L, int bid, int nb) {
    const int lane = ltid() & 63, wid = ltid() >> 6;
    const int nv = (L == 0) ? p->G * SALL : p->G * SEQ;
    for (int i = bid * 8 + wid; i < nv; i += nb * 8) {
        const int r = (L == 0) ? i : ((i >> 11) * SALL + CTXL + (i & 2047));
        const bf16_t* z = p->Z + (size_t)r * 3072; const unsigned char* g = p->GP8 + (size_t)r * 3072;
        u32x4 zv[2][3]; u32x2 gv[2][3];
#pragma unroll
        for (int q = 0; q < 2; ++q)
#pragma unroll
            for (int j = 0; j < 3; ++j) { const int col = q * 512 + lane * 8; gv[q][j] = *(const u32x2*)(g + j * 1024 + col);
                if (MERGE_F8 && j > 0) { const u32x2 t8 = *(const u32x2*)((const unsigned char*)z + 2048 + (j - 1) * 1024 + col); zv[q][j] = mk4(t8.x, t8.y, 0u, 0u); }
                else zv[q][j] = *(const u32x4*)(z + j * 1024 + col); }
#pragma unroll
        for (int q = 0; q < 2; ++q) {
            const int col = q * 512 + lane * 8;
            float a[8] = {0.f, 0.f, 0.f, 0.f, 0.f, 0.f, 0.f, 0.f};
#pragma unroll
            for (int j = 0; j < 3; ++j) {
                const f32x2 g0 = __builtin_amdgcn_cvt_pk_f32_fp8((int)gv[q][j].x, false), g1 = __builtin_amdgcn_cvt_pk_f32_fp8((int)gv[q][j].x, true), g2 = __builtin_amdgcn_cvt_pk_f32_fp8((int)gv[q][j].y, false), g3 = __builtin_amdgcn_cvt_pk_f32_fp8((int)gv[q][j].y, true);
                float zf[8];
                if (MERGE_F8 && j > 0) { const f32x2 z0 = __builtin_amdgcn_cvt_pk_f32_fp8((int)zv[q][j].x, false), z1 = __builtin_amdgcn_cvt_pk_f32_fp8((int)zv[q][j].x, true), z2 = __builtin_amdgcn_cvt_pk_f32_fp8((int)zv[q][j].y, false), z3 = __builtin_amdgcn_cvt_pk_f32_fp8((int)zv[q][j].y, true);
                    zf[0] = z0[0]; zf[1] = z0[1]; zf[2] = z1[0]; zf[3] = z1[1]; zf[4] = z2[0]; zf[5] = z2[1]; zf[6] = z3[0]; zf[7] = z3[1]; }
                else { zf[0] = lo_bf(zv[q][j].x); zf[1] = hi_bf(zv[q][j].x); zf[2] = lo_bf(zv[q][j].y); zf[3] = hi_bf(zv[q][j].y); zf[4] = lo_bf(zv[q][j].z); zf[5] = hi_bf(zv[q][j].z); zf[6] = lo_bf(zv[q][j].w); zf[7] = hi_bf(zv[q][j].w); }
                a[0] += sigmoidf_(g0[0]) * zf[0]; a[1] += sigmoidf_(g0[1]) * zf[1]; a[2] += sigmoidf_(g1[0]) * zf[2]; a[3] += sigmoidf_(g1[1]) * zf[3];
                a[4] += sigmoidf_(g2[0]) * zf[4]; a[5] += sigmoidf_(g2[1]) * zf[5]; a[6] += sigmoidf_(g3[0]) * zf[6]; a[7] += sigmoidf_(g3[1]) * zf[7];
            }
            *(u32x4*)(p->H + (size_t)r * 1024 + col) = mk4(pk2(a[0], a[1]), pk2(a[2], a[3]), pk2(a[4], a[5]), pk2(a[6], a[7]));
        }
    }
}
struct SchedOut { const char *A, *B; int nMv, L, G, c;
    __device__ __forceinline__ bool next(int i, pg8::Unit& u) const { int pmv, pn; if (!pg8::static_tile(i, G, c, nMv, 4, pmv, pn)) return false; const int pm = valid_tile(L, pmv);
        u.pm = pm; u.pn = pn; u.tag = 0; u.rows = nullptr; u.a = A + (size_t)pm * 256 * 1024 * 2; u.b = B + (size_t)pn * 256 * 1024 * 2; return true; } };
struct EpiOut { static constexpr bool PERM = false; CP p; int L, grp;
    __device__ __forceinline__ void operator()(const f32x4 (&acc)[2][2][4][2], const pg8::Unit& u, int wr, int wc, int fr, int fq) const {
        const int bl = u.pm / 9, mloc = u.pm - bl * 9, b = grp * p->G + bl;
        const bool isctx = mloc == 0;
        const float* md = isctx ? (p->mods_c + (size_t)L * 6144 + 2048) : (p->mods_l + ((size_t)L * 32 + b) * 6144 + 2048);
        const int col0 = u.pn * 256 + wc * 32 + 4 * fq;
#pragma unroll
        for (int ai = 0; ai < 2; ++ai)
#pragma unroll
            for (int m = 0; m < 4; ++m) {
                const int pos = mloc * 256 + ai * 128 + wr * 64 + m * 16 + fr;
                const float* src; float* dst;
                if (isctx) { src = p->ctx + ((size_t)b * CTXL + pos) * 1024; dst = p->XC1 + ((size_t)b * CTXL + pos) * 1024; }
                else { const size_t o = ((size_t)b * SEQ + pos - CTXL) * 1024; src = (L == 0 ? p->x : p->out) + o; dst = p->out + o; }
#pragma unroll
                for (int bj = 0; bj < 2; ++bj)
#pragma unroll
                    for (int n = 0; n < 2; ++n) { const int col = col0 + bj * 128 + n * 16; const f32x4 xv = *(const f32x4*)(src + col), g = *(const f32x4*)(md + col); *(f32x4*)(dst + col) = xv + g * acc[ai][bj][m][n]; }
            }
    } };
__device__ __forceinline__ void phase_outproj8(CP p, int L, int grp, LAS unsigned char* lds, int bid, int nb) {
    SchedOut S{(const char*)p->H, (const char*)p->bt_out, (L == 0 ? p->G * 9 : p->G * 8), L, nb, bid};
    EpiOut E{p, L, grp};
    pg8::gemm_phase<false, false>(lds, 1024, S, E);
}
struct SchedMoeUp { CP p; LAS int* tab; int L, G, c;
    __device__ __forceinline__ bool next(int i, pg8::Unit& u) const { const int x = i * G + c, tile = (x >> 4) * 8 + (x & 7), nt = (x >> 3) & 1; if (tile >= __builtin_amdgcn_readfirstlane(tab[65])) return false;
        const int e = __builtin_amdgcn_readfirstlane(moe_find(tab, tile));
        u.pm = tile; u.pn = nt; u.tag = e;
        u.rows = p->LIST + (size_t)tile * 256; u.a = (const char*)p->H2;
        u.b = (const char*)p->bt_eup + ((size_t)e * 512 + nt * 256) * 1024; return true; } };
struct EpiMoeUp { static constexpr bool PERM = true; bf16_t* ACT; const float* W;
    __device__ __forceinline__ void operator()(const f32x4 (&acc)[2][2][4][2], const pg8::Unit& u, int wr, int wc, int fr, int fq) const {
        const size_t pos0 = (size_t)u.pm * 256 + wr * 64 + fr;
#pragma unroll
        for (int ai = 0; ai < 2; ++ai)
#pragma unroll
            for (int m = 0; m < 4; ++m) { const size_t pos = pos0 + ai * 128 + m * 16; const float w = ((u.tag < 64) ? W[pos] : 1.0f) * pg8::F8_WINV;
                float v[8];
#pragma unroll
                for (int n = 0; n < 2; ++n)
#pragma unroll
                    for (int j = 0; j < 4; ++j) { const float g = acc[ai][0][m][n][j] * pg8::F8_WINV; v[n * 4 + j] = g * __builtin_amdgcn_rcpf(1.0f + __expf(-g)) * acc[ai][1][m][n][j] * w; }
                if (DOWN_F8) { int w0 = 0, w1 = 0;
                    w0 = __builtin_amdgcn_cvt_pk_fp8_f32(v[0] * ACT_SC, v[1] * ACT_SC, w0, false); w0 = __builtin_amdgcn_cvt_pk_fp8_f32(v[2] * ACT_SC, v[3] * ACT_SC, w0, true);
                    w1 = __builtin_amdgcn_cvt_pk_fp8_f32(v[4] * ACT_SC, v[5] * ACT_SC, w1, false); w1 = __builtin_amdgcn_cvt_pk_fp8_f32(v[6] * ACT_SC, v[7] * ACT_SC, w1, true);
                    *(u32x2*)((unsigned char*)ACT + pos * 256 + u.pn * 128 + wc * 32 + 8 * fq) = mk2((unsigned)w0, (unsigned)w1); }
                else *(u32x4*)(ACT + pos * 256 + u.pn * 128 + wc * 32 + 8 * fq) = mk4(pk2(v[0], v[1]), pk2(v[2], v[3]), pk2(v[4], v[5]), pk2(v[6], v[7])); }
    } };
__device__ __forceinline__ void phase_moe_up8(CP p, int L, LAS unsigned char* lds, int bid, int nb) {
    moe_table8(p, L, lds);
    SchedMoeUp S{p, (LAS int*)(lds + MOE_TAB), L, nb, bid};
    EpiMoeUp E{p->ACT, p->LISTW};
    pg8::gemm_phase<true, true>(lds, 512, S, E);
}
struct SchedMoeDown { CP p; LAS int* tab; int G, c;
    __device__ __forceinline__ bool next(int i, pg8::Unit& u) const { const int x = i * G + c, tile = (x >> 5) * 8 + (x & 7), nt = (x >> 3) & 3; if (tile >= __builtin_amdgcn_readfirstlane(tab[65])) return false;
        const int e = __builtin_amdgcn_readfirstlane(moe_find(tab, tile));
        u.pm = tile; u.pn = nt; u.tag = e; u.rows = nullptr; u.a = (const char*)p->ACT + (size_t)tile * 256 * 256 * (DOWN_F8 ? 1 : 2); u.b = (const char*)p->bt_edn + ((size_t)e * 1024 + nt * 256) * 256 * (DOWN_F8 ? 1 : 2); return true; } };
__device__ __forceinline__ void phase_moe_down8(CP p, int L, LAS unsigned char* lds, int bid, int nb) {
    moe_table8(p, L, lds);
    SchedMoeDown S{p, (LAS int*)(lds + MOE_TAB), nb, bid};
    if constexpr (DOWN_F8) { EpiFp8RowsT<2> E{(unsigned char*)p->DBUF, 1024}; pg8::gemm_phase<false, true>(lds, 128, S, E); return; }
    EpiFp8Rows E{(unsigned char*)p->DBUF, 1024};
    pg8::gemm_phase<false, false>(lds, 256, S, E);
}

extern __shared__ __attribute__((aligned(16))) unsigned char smem_raw[];
#define XB_TMO      128
#define XB_XCNT(j)  (256  + 64 * (j))
#define XB_XSUB(j)  (1280 + 64 * (j))
#define XB_XGEN(j)  (2304 + 64 * (j))
#define XB_TOP      3328
#define XB_TOPGEN   3392
#define XCD_BAR_WORDS 3456
#define XB_SPIN_CAP (1u << 18)

__device__ __forceinline__ unsigned xb_ld(unsigned* p)              { return __hip_atomic_load(p, __ATOMIC_RELAXED, __HIP_MEMORY_SCOPE_AGENT); }
__device__ __forceinline__ unsigned xb_add(unsigned* p, unsigned v) { return __hip_atomic_fetch_add(p, v, __ATOMIC_RELAXED, __HIP_MEMORY_SCOPE_AGENT); }
__device__ __forceinline__ unsigned xb_xcc_id() { return (unsigned)__builtin_amdgcn_s_getreg((3 << 11) | 20) & 0xFu; }
#define XB_SPIN(cond, bar) do { unsigned _sp = 0; while (cond) { __builtin_amdgcn_s_sleep(1); \
    if ((++_sp & 255u) == 0u) { if (xb_ld(&(bar)[XB_TMO])) break; if (_sp > XB_SPIN_CAP) { atomicAdd(&(bar)[XB_TMO], 1u); break; } } } } while (0)

struct XcdBarrier {
    unsigned* bar; unsigned x;
    volatile LAS unsigned* st;
};

__device__ __forceinline__ XcdBarrier xcd_barrier_post(unsigned* bar, volatile LAS unsigned* st) {
    XcdBarrier b; b.bar = bar; b.x = xb_xcc_id(); b.st = st;
    if (threadIdx.x == 0) (void)xb_add(&bar[XB_XCNT(b.x)], 1u);
    return b;
}
__device__ __forceinline__ void xcd_barrier_complete(unsigned* bar, unsigned x, unsigned& nloc, unsigned& nx) {
    const unsigned G = gridDim.x * gridDim.y * gridDim.z;
    unsigned sum, cnt, mine, sp = 0u;
    for (;;) {
        sum = 0u; cnt = 0u; mine = 0u;
#pragma unroll
        for (unsigned j = 0; j < 16; ++j) { const unsigned c = xb_ld(&bar[XB_XCNT(j)]); sum += c; cnt += (c > 0u) ? 1u : 0u; mine = (j == x) ? c : mine; }
        if (sum == G) break;
        __builtin_amdgcn_s_sleep(1);
        if ((++sp & 255u) == 0u) { if (xb_ld(&bar[XB_TMO])) break; if (sp > XB_SPIN_CAP) { atomicAdd(&bar[XB_TMO], 1u); break; } }
    }
    nloc = mine > 0u ? mine : 1u; nx = cnt > 0u ? cnt : 1u;
}

__device__ __forceinline__ void xcd_barrier(const XcdBarrier& b) {
    asm volatile("s_waitcnt vmcnt(0)" ::: "memory");
    __syncthreads();
    if (threadIdx.x == 0) {
        unsigned* bar = b.bar;
        __builtin_amdgcn_s_waitcnt(0);
        unsigned nloc = b.st[0], nx = b.st[1];
        if (nloc == 0u) { xcd_barrier_complete(bar, b.x, nloc, nx); b.st[0] = nloc; b.st[1] = nx; }
        const unsigned old = xb_add(&bar[XB_XSUB(b.x)], 1u);
        const unsigned gen = old / nloc;
        if (old + 1u == (gen + 1u) * nloc) {
            __builtin_amdgcn_fence(__ATOMIC_RELEASE, "agent");
            asm volatile("s_waitcnt vmcnt(0)" ::: "memory");
            const unsigned og = xb_add(&bar[XB_TOP], 1u);
            const unsigned tg = og / nx;
            if (og + 1u == (tg + 1u) * nx) xb_add(&bar[XB_TOPGEN], 1u);
            else XB_SPIN(xb_ld(&bar[XB_TOPGEN]) == tg, bar);
            __builtin_amdgcn_fence(__ATOMIC_ACQUIRE, "agent");
            xb_add(&bar[XB_XGEN(b.x)], 1u);
            asm volatile("s_waitcnt vmcnt(0)" ::: "memory");
        } else {
            XB_SPIN(xb_ld(&bar[XB_XGEN(b.x)]) == gen, bar);
            __builtin_amdgcn_fence(__ATOMIC_ACQUIRE, "agent");
            asm volatile("s_waitcnt vmcnt(0)" ::: "memory");
        }
    }
    __syncthreads();
}


constexpr int XB_LDS_OFF = LDS_BYTES - 16;
#if MK_CG_SYNC
#define GBAR() cooperative_groups::this_grid().sync()
#else
#define GBAR() do { XcdBarrier b2_ = bar; asm volatile("" : "+s"(b2_.bar), "+s"(b2_.x)); xcd_barrier(b2_); } while (0)
#endif
#define PH(call) do { CP p = pk; int bid = bid0, nb = nb0, L = L0v, grp = grp0v; LAS unsigned char* lds = lds0; asm volatile("" : "+s"(p), "+s"(bid), "+s"(nb), "+s"(lds), "+s"(L), "+s"(grp)); (void)L; (void)grp; (void)bid; (void)nb; (void)lds; __syncthreads(); call; } while (0)
__global__ void __launch_bounds__(NTHREADS, 2) k_fused(Params p_) {
    CP pk = (CP)__builtin_amdgcn_kernarg_segment_ptr();
    LAS unsigned char* lds0 = (LAS unsigned char*)smem_raw;
    asm volatile("s_setreg_imm32_b32 hwreg(HW_REG_MODE, 23, 1), 1");
    const int bid0 = blockIdx.x, nb0 = gridDim.x;
    if (ltid() == 0) *(LAS u32x4*)(lds0 + XB_LDS_OFF) = mk4(0u, 0u, 0u, 0u);
    __syncthreads();
    XcdBarrier bar = xcd_barrier_post(pk->bar, (volatile LAS unsigned*)(lds0 + XB_LDS_OFF));
    int L0v = 0, grp0v = 0;
    PH(phase_mods(p, lds, bid, nb));
    for (L0v = 0; L0v < 2; ++L0v) {
        PH(phase_convert(p, L, lds, bid, nb));
        GBAR();
        const int ngroups = pk->ngroups;
        for (grp0v = 0; grp0v < ngroups; ++grp0v) {
            PH(phase_prenorm(p, L, grp, bid, nb));          GBAR();
            if (PROBE & 128) { PH(phase_prenorm(p, L, grp, bid, nb)); GBAR(); }
            PH(phase_inproj8(p, lds, bid, nb));             GBAR();
            if (PROBE & 1) { PH(phase_inproj8(p, lds, bid, nb)); GBAR(); }
            PH(phase_daprep(p, L, grp, bid, nb));           GBAR();
            PH(phase_mix_dyn(p, L, grp, lds));              GBAR();
            if (PROBE & 2) { PH(phase_mix_dyn(p, L, grp, lds, 1)); GBAR(); }
            if (PROBE & 4) { PH(phase_probe_at(p, L, lds, bid, nb)); GBAR(); }
            if (PROBE & 8) { PH(phase_probe_lru(p, L, lds, bid, nb)); GBAR(); }
            if (PROBE & 512) { PH(phase_probe_ml(p, L, lds, bid, nb)); GBAR(); }
            PH(phase_lrufinish(p, L, bid, nb));
            PH(phase_mlfinish(p, L, bid, nb));              GBAR();
            PH(phase_merge8(p, L, lds, bid, nb));           GBAR();
            PH(phase_gate(p, L, bid, nb));                  GBAR();
            if (PROBE & 64) { PH(phase_merge8(p, L, lds, bid, nb)); GBAR(); PH(phase_gate(p, L, bid, nb)); GBAR(); }
            PH(phase_outproj8(p, L, grp, lds, bid, nb));    GBAR();
            PH(phase_route1(p, L, grp, lds, bid, nb));      GBAR();
            PH(phase_route2(p, L, lds, bid, nb));           GBAR();
            if (PROBE & 16384) { PH(phase_route1(p, L, grp, lds, bid, nb)); GBAR(); }
            if (PROBE & 32768) { PH(phase_route2(p, L, lds, bid, nb)); GBAR(); }
            if (PROBE & 16) { PH(phase_route1(p, L, grp, lds, bid, nb)); GBAR(); PH(phase_route2(p, L, lds, bid, nb)); GBAR(); }
            PH(phase_moe_up8(p, L, lds, bid, nb));          GBAR();
            PH(phase_moe_down8(p, L, lds, bid, nb));        GBAR();
            if (PROBE & 32) { PH(phase_moe_up8(p, L, lds, bid, nb)); GBAR(); PH(phase_moe_down8(p, L, lds, bid, nb)); GBAR(); }
            if (PROBE & 2048) { PH(phase_moe_up8(p, L, lds, bid, nb)); GBAR(); }
            if (PROBE & 4096) { PH(phase_moe_down8(p, L, lds, bid, nb)); GBAR(); }
            if (PROBE & 256) { for (int z = 0; z < 12; ++z) GBAR(); }
            PH(phase_moe_combine(p, L, grp, lds, bid, nb)); GBAR();
        }
    }
}

static inline size_t align_up(size_t v, size_t a) { return (v + a - 1) / a * a; }

extern "C" void kernel_launch(void* const* d_in, const int* in_sizes, int n_in, void* d_out, int out_size, void* d_ws, size_t ws_size, hipStream_t stream) {
    (void)in_sizes; (void)n_in; (void)out_size;
    Params p; memset(&p, 0, sizeof(p));
    const float** f = (const float**)&p;
    for (int i = 0; i < 32; ++i) f[i] = (const float*)d_in[i];
    p.out = (float*)d_out;
    unsigned char* ws = (unsigned char*)d_ws;
    int G = 8;
    for (;;) {
        size_t o = 0;
        auto take = [&](size_t bytes) { size_t r = o; o = align_up(o + bytes, 256); return r; };
        const size_t RG = (size_t)G * SALL;
        const size_t o_bar = take(16384), o_ecnt = take(1024), o_lam = take(256), o_modsl = take((size_t)2 * 32 * 6144 * 4), o_modsc = take((size_t)2 * 6144 * 4), o_rope = take((size_t)2048 * 32 * 2 * 4);
        const size_t o_btin = take((size_t)BTIN_ROWS * 1024 * 2), o_btbr = take((size_t)3 * 1024 * 1024 * 2), o_btout = take((size_t)1024 * 1024 * 2);
        const size_t o_bteup = take((size_t)65 * 512 * 1024), o_btin8 = take((size_t)BTIN_ROWS * 1024), o_h8 = take(RG * 1024), o_yb8 = take(RG * 1024), o_mo8 = take(RG * 1024), o_btedn = take((size_t)65 * 1024 * 256 * 2), o_btlru = take((size_t)16 * 256 * 128 * 2);
        const size_t o_h = take(RG * 1024 * 2);
        size_t pbytes = RG * PWID * 2; const size_t actrows = (size_t)7 * RG + 65 * 256; const size_t actbytes = align_up(actrows * 256 * 2, 256); if (pbytes < actbytes + actrows * 1024 * 2) pbytes = actbytes + actrows * 1024 * 2;
        const size_t o_p = take(pbytes), o_gates = take(RG * 16 * 4);
        const size_t o_ya = take(RG * 1024 * 2), o_yb = take(RG * 1024 * 2), o_yc = take(RG * 1024 * 2), o_hb = take(RG * 1024 * 2);
        const size_t o_lsum = take((size_t)G * 2 * 36 * 1024 * 8), o_xc1 = take((size_t)TCTX * 1024 * 4);
        const size_t o_z = take(RG * 3072 * 2), o_hb2 = take(RG * 1024 * 2), o_gp8 = take(RG * 3072);
        const size_t o_list = take(actrows * 4), o_listw = take(actrows * 4), o_cc = take(RG / 32 * 64 * 4), o_pe = take(RG * 6 * 4), o_pw = take(RG * 6 * 4), o_pos = take(RG * 6 * 4);
        if (o > ws_size && G > 1) { G >>= 1; continue; }
        p.bar = (unsigned*)(ws + o_bar); p.ecnt = (int*)(ws + o_ecnt); p.lamv = (float*)(ws + o_lam); p.mods_l = (float*)(ws + o_modsl); p.mods_c = (float*)(ws + o_modsc); p.rope = (float*)(ws + o_rope);
        p.bt_in = (bf16_t*)(ws + o_btin); p.bt_br = (bf16_t*)(ws + o_btbr); p.bt_out = (bf16_t*)(ws + o_btout); p.bt_eup = (bf16_t*)(ws + o_bteup); p.bt_edn = (bf16_t*)(ws + o_btedn); p.bt_lru = (bf16_t*)(ws + o_btlru);
        p.H8 = ws + o_h8; p.bt_in8 = ws + o_btin8; p.YB8 = ws + o_yb8; p.MO8 = ws + o_mo8;
        p.H = (bf16_t*)(ws + o_h); p.P = (bf16_t*)(ws + o_p); p.ACT = p.P; p.GATES = (float*)(ws + o_gates);
        p.YA = (bf16_t*)(ws + o_ya); p.YB = (bf16_t*)(ws + o_yb); p.HB = (bf16_t*)(ws + o_hb); p.YC = (bf16_t*)(ws + o_yc);
        p.LSUM = (float*)(ws + o_lsum); p.XC1 = (float*)(ws + o_xc1); p.H2 = p.YA; p.LIST = (int*)(ws + o_list); p.LISTW = (float*)(ws + o_listw);
        p.DBUF = (bf16_t*)(ws + o_p + actbytes); p.Z = (bf16_t*)(ws + o_z); p.HB2 = (bf16_t*)(ws + o_hb2); p.GP8 = ws + o_gp8; p.CC = (int*)(ws + o_cc); p.PE = (int*)(ws + o_pe); p.PW = (float*)(ws + o_pw); p.POS = (int*)(ws + o_pos);
        break;
    }
    p.G = G; p.ngroups = NBATCH / G;
#if MK_ONE_LAUNCH
    static int grid1 = 0;
    if (!grid1) {
        (void)hipFuncSetAttribute((const void*)k_fused, hipFuncAttributeMaxDynamicSharedMemorySize, LDS_BYTES);
        int dev = 0, cus = 0, per_cu = 0;
        (void)hipGetDevice(&dev);
        (void)hipDeviceGetAttribute(&cus, hipDeviceAttributeMultiprocessorCount, dev);
        (void)hipOccupancyMaxActiveBlocksPerMultiprocessor(&per_cu, k_fused, NTHREADS, LDS_BYTES);
        grid1 = (per_cu >= 1) ? cus : 0;
    }
    (void)hipMemsetAsync(p.bar, 0, 16384 + 1024, stream);
#if MK_CG_SYNC
    if (grid1 > 0) { void* args[] = {&p}; (void)hipLaunchCooperativeKernel((const void*)k_fused, dim3(grid1), dim3(NTHREADS), args, LDS_BYTES, stream); }
#else
    if (grid1 > 0) hipLaunchKernelGGL(k_fused, dim3(grid1), dim3(NTHREADS), LDS_BYTES, stream, p);
#endif
    return;
#endif
}
```

```cpp
#include <hip/hip_runtime.h>
#include <stdint.h>
#include <string.h>
#include <stdio.h>
#include <hip/hip_cooperative_groups.h>

#define LAS __attribute__((address_space(3)))
typedef unsigned short bf16_t;
typedef short bf16x8 __attribute__((ext_vector_type(8)));
typedef short s16x4 __attribute__((ext_vector_type(4)));
typedef float f32x4 __attribute__((ext_vector_type(4)));
typedef __bf16 bf2_t __attribute__((ext_vector_type(2)));
typedef unsigned u32x4 __attribute__((ext_vector_type(4)));
typedef unsigned u32x2 __attribute__((ext_vector_type(2)));
typedef float f32x2 __attribute__((ext_vector_type(2)));
__host__ __device__ __forceinline__ u32x4 mk4(unsigned a, unsigned b, unsigned c, unsigned d) { u32x4 r = {a, b, c, d}; return r; }
__host__ __device__ __forceinline__ u32x2 mk2(unsigned a, unsigned b) { u32x2 r = {a, b}; return r; }

#ifndef MK_ONE_LAUNCH
#define MK_ONE_LAUNCH 1
#define PROBE 0
#ifndef MK_CG_SYNC
#define MK_CG_SYNC 0
#endif
#endif

constexpr int DM = 1024, NBATCH = 32, SEQ = 2048, CTXL = 256, SALL = 2304;
constexpr int TLAT = NBATCH * SEQ, TCTX = NBATCH * CTXL, TALL = TLAT + TCTX;
constexpr int PWID = 8320;
constexpr int BTIN_ROWS = 11520;
constexpr int NT_IN = 45;
constexpr int PC_XA = 0, PC_GA = 1024, PC_MQ = 2048, PC_MK = 2560, PC_MV = 3072, PC_MO = 4096, PC_DQ = 5120, PC_DK = 6144, PC_DV = 7168, PC_GATE = 8192;
constexpr int NEXP = 64, TOPK = 6;
#ifndef IN_F8_MASK_V
#define IN_F8_MASK_V 0x1FFFFFFFFF01ull
#endif
constexpr unsigned long long IN_F8_MASK = IN_F8_MASK_V, IN_BF_MASK = ~IN_F8_MASK & ((1ull << 45) - 1);
constexpr int IN_N8 = __builtin_popcountll(IN_F8_MASK), IN_NBF = 45 - IN_N8;
constexpr bool DOWN_F8 = true;
constexpr float ACT_SC = 4.0f, DW_SC = 128.0f;
constexpr bool MERGE_F8 = true;
constexpr float D_SCALE = 4.0f, D_ISCALE = 1.0f / 4.0f;
constexpr int LDS_BYTES = 147456;
constexpr int NTHREADS = 512;

struct Params {
    const float *x, *c, *ctx, *c_ctx, *norm1_g, *norm2_g, *w_ada, *b_ada, *w_in, *conv_w, *conv_b, *lru_wa, *lru_ba, *lru_wx, *lru_bx, *lru_lam,
        *ml_gate_b, *ml_norm_g, *da_qnorm_g, *da_knorm_g, *da_lambda, *da_subln_g, *w_branch, *w_out, *w_router, *b_router, *w_e_gate, *w_e_up,
        *w_e_down, *w_s_gate, *w_s_up, *w_s_down;
    float* out;
    unsigned* bar; int* ecnt; float* lamv; float* mods_l; float* mods_c; float* rope;
    bf16_t *bt_in, *bt_br, *bt_out, *bt_eup, *bt_edn, *bt_lru;
    bf16_t *H, *P, *YA, *YB, *HB, *YC; float* GATES; float* LSUM; bf16_t* XC1;
    bf16_t* H2; int* LIST; float* LISTW; bf16_t* ACT; bf16_t* DBUF; bf16_t* HB2; unsigned char* GP8; int* CC; int* PE; float* PW; int* POS; bf16_t* Z;
    int G; int ngroups;
    bf16_t* XB;
    bf16_t* HM;
    unsigned char* MO8;
    unsigned char* YB8;
    unsigned char* H8; unsigned char* bt_in8;
};

typedef const Params __attribute__((address_space(4))) * CP;
__device__ __forceinline__ int ltid() { int t = threadIdx.x; asm volatile("" : "+v"(t)); return t; }
__device__ __forceinline__ float bf2f(bf16_t b) { return __uint_as_float(((unsigned)b) << 16); }
__device__ __forceinline__ unsigned pk2(float lo, float hi) { bf2_t v = {(__bf16)lo, (__bf16)hi}; return __builtin_bit_cast(unsigned, v); }
__device__ __forceinline__ float lo_bf(unsigned u) { return __uint_as_float(u << 16); }
__device__ __forceinline__ float hi_bf(unsigned u) { return __uint_as_float(u & 0xffff0000u); }
__device__ __forceinline__ float sx_(float v, int mask) { return __builtin_bit_cast(float, __builtin_amdgcn_ds_bpermute(((ltid() & 63) ^ mask) << 2, __builtin_bit_cast(int, v))); }
__device__ __forceinline__ float sidx_(float v, int src) { return __builtin_bit_cast(float, __builtin_amdgcn_ds_bpermute(src << 2, __builtin_bit_cast(int, v))); }
__device__ __forceinline__ float sup_(float v, int o) { return __builtin_bit_cast(float, __builtin_amdgcn_ds_bpermute(((ltid() & 63) - o) << 2, __builtin_bit_cast(int, v))); }
template <int CTRL> __device__ __forceinline__ float dppf(float oldv, float v) { return __builtin_bit_cast(float, __builtin_amdgcn_update_dpp(__builtin_bit_cast(int, oldv), __builtin_bit_cast(int, v), CTRL, 0xf, 0xf, false)); }
__device__ __forceinline__ float wave_sum(float v) {
#pragma unroll
    for (int o = 32; o >= 1; o >>= 1) v += sx_(v, o);
    return v;
}
__device__ __forceinline__ float sigmoidf_(float x) { return __builtin_amdgcn_rcpf(1.0f + __expf(-x)); }
__device__ __forceinline__ float gelu_tanh(float x) {
    const float u = 0.7978845608028654f * (x + 0.044715f * x * x * x);
    const float e = __expf(2.0f * u);
    const float t = 1.0f - 2.0f * __builtin_amdgcn_rcpf(e + 1.0f);
    return 0.5f * x * (1.0f + t);
}

constexpr int GS_ROW = 144;
constexpr int GS_A = 128 * GS_ROW, GS_STAGE = 384 * GS_ROW;

template <class AF>
__device__ __forceinline__ void gemm_kloop(LAS unsigned char* lds, const AF& af, const bf16_t* __restrict__ Bt, int ldb, int K, f32x4 (&acc)[4][4]) {
    const int tid = ltid(), lane = tid & 63, wid = tid >> 6, wm = wid >> 2, wn = wid & 3;
    const int srow = tid >> 3, sch = tid & 7;
    const bf16_t* pa0 = af(srow) + sch * 8;
    const bf16_t* pa1 = af(srow + 64) + sch * 8;
    const bf16_t* pb0 = Bt + (size_t)(srow) * ldb + sch * 8;
    const bf16_t* pb1 = Bt + (size_t)(srow + 64) * ldb + sch * 8;
    const bf16_t* pb2 = Bt + (size_t)(srow + 128) * ldb + sch * 8;
    const bf16_t* pb3 = Bt + (size_t)(srow + 192) * ldb + sch * 8;
    const int wofs = srow * GS_ROW + sch * 16;
    const int nkt = K >> 6;
    u32x4 ra0 = *(const u32x4*)pa0, ra1 = *(const u32x4*)pa1, rb0 = *(const u32x4*)pb0, rb1 = *(const u32x4*)pb1, rb2 = *(const u32x4*)pb2, rb3 = *(const u32x4*)pb3;
    {
        LAS unsigned char* s = lds;
        *(LAS u32x4*)(s + wofs) = ra0; *(LAS u32x4*)(s + wofs + 64 * GS_ROW) = ra1;
        *(LAS u32x4*)(s + GS_A + wofs) = rb0; *(LAS u32x4*)(s + GS_A + wofs + 64 * GS_ROW) = rb1;
        *(LAS u32x4*)(s + GS_A + wofs + 128 * GS_ROW) = rb2; *(LAS u32x4*)(s + GS_A + wofs + 192 * GS_ROW) = rb3;
    }
    __syncthreads();
    const int aoff = (wm * 64 + (lane & 15)) * GS_ROW + (lane >> 4) * 16;
    const int boff = GS_A + (wn * 64 + (lane & 15)) * GS_ROW + (lane >> 4) * 16;
    for (int kt = 0; kt < nkt; ++kt) {
        LAS unsigned char* cur = lds + (kt & 1) * GS_STAGE;
        LAS unsigned char* nxt = lds + ((kt + 1) & 1) * GS_STAGE;
        const bool more = (kt + 1 < nkt);
        if (more) {
            const int ko = (kt + 1) * 64;
            ra0 = *(const u32x4*)(pa0 + ko); ra1 = *(const u32x4*)(pa1 + ko);
            rb0 = *(const u32x4*)(pb0 + ko); rb1 = *(const u32x4*)(pb1 + ko); rb2 = *(const u32x4*)(pb2 + ko); rb3 = *(const u32x4*)(pb3 + ko);
        }
#pragma unroll
        for (int ks = 0; ks < 2; ++ks) {
            bf16x8 a[4], b[4];
#pragma unroll
            for (int m = 0; m < 4; ++m) a[m] = *(LAS bf16x8*)(cur + aoff + m * 16 * GS_ROW + ks * 64);
#pragma unroll
            for (int n = 0; n < 4; ++n) b[n] = *(LAS bf16x8*)(cur + boff + n * 16 * GS_ROW + ks * 64);
#pragma unroll
            for (int m = 0; m < 4; ++m)
#pragma unroll
                for (int n = 0; n < 4; ++n) acc[m][n] = __builtin_amdgcn_mfma_f32_16x16x32_bf16(b[n], a[m], acc[m][n], 0, 0, 0);
        }
        if (more) {
            *(LAS u32x4*)(nxt + wofs) = ra0; *(LAS u32x4*)(nxt + wofs + 64 * GS_ROW) = ra1;
            *(LAS u32x4*)(nxt + GS_A + wofs) = rb0; *(LAS u32x4*)(nxt + GS_A + wofs + 64 * GS_ROW) = rb1;
            *(LAS u32x4*)(nxt + GS_A + wofs + 128 * GS_ROW) = rb2; *(LAS u32x4*)(nxt + GS_A + wofs + 192 * GS_ROW) = rb3;
        }
        __syncthreads();
    }
}
__device__ __forceinline__ void acc_zero(f32x4 (&acc)[4][4]) {
#pragma unroll
    for (int m = 0; m < 4; ++m)
#pragma unroll
        for (int n = 0; n < 4; ++n) acc[m][n] = (f32x4){0.f, 0.f, 0.f, 0.f};
}
struct ARowLinear { const bf16_t* base; int ld; __device__ __forceinline__ const bf16_t* operator()(int r) const { return base + (size_t)r * ld; } };

__device__ __forceinline__ bool dense_unit(int it, int bid, int nb, int MT, int NT, int& mt, int& nt) {
    if (nb == 256) {
        const int xcd = bid & 7, loc = bid >> 3, nmacN = (NT + 3) >> 2, nmacM = (MT + 7) >> 3;
        const int q = it * 8 + xcd;
        if (q >= nmacM * nmacN) { mt = -1; return false; }
        const int mm = q / nmacN, nn = q - mm * nmacN;
        mt = mm * 8 + (loc & 7); nt = nn * 4 + (loc >> 3);
        if (mt >= MT || nt >= NT) mt = -1;
        return true;
    }
    const int u = it * nb + bid;
    if (u >= MT * NT) { mt = -1; return false; }
    mt = u / NT; nt = u - mt * NT; return true;
}

namespace pg8 {
typedef unsigned short bf16_t;
constexpr float F8_WMUL = 64.0f, F8_WINV = 1.0f / 64.0f;
constexpr int BM = 256, BK = 64, HALF = 128, HTB = HALF * BK * 2, STAGE_BYTES = 8 * HTB, NXCD = 8, WGM = 8;
__host__ __device__ __forceinline__ int lds_byte(int r, int c) { const int st = (r >> 4) * 2 + (c >> 5), rr = r & 15, cc = c & 31, ob = rr * 64 + cc * 2; return st * 1024 + (ob ^ (((ob >> 9) & 1) << 5)); }
__host__ __device__ __forceinline__ void stage_rc(int b, int& R, int& C) { const int st = b / 1024, sb = b % 1024, swz = sb ^ (((sb >> 9) & 1) << 5); R = (st >> 1) * 16 + swz / 64; C = (st & 1) * 32 + (swz % 64) / 2; }
__host__ __device__ __forceinline__ int perm32(int rho) { const int n = rho >> 4, i = rho & 15; return 8 * (i >> 2) + 4 * n + (i & 3); }
struct Unit { const char* a; const char* b; const int* rows; int pm, pn, tag; };
__device__ __forceinline__ bool static_tile(int i, int G, int c, int nM, int nN, int& pm, int& pn) {
    const int nwg = nM * nN; const long L = (long)i * G + c; if (L >= nwg) return false;
    int wgid = (int)L; { const int q = nwg / NXCD, r = nwg % NXCD, xcd = wgid % NXCD, off = wgid / NXCD; wgid = (xcd < r ? xcd * (q + 1) : r * (q + 1) + (xcd - r) * q) + off; }
    const int nig = WGM * nN, gid = wgid / nig, fm = gid * WGM, gsz = (nM - fm) < WGM ? (nM - fm) : WGM;
    pm = fm + ((wgid % nig) % gsz); pn = (wgid % nig) / gsz; return true;
}
__device__ __forceinline__ void tile_of(int wgid, int nM, int nN, int& pm, int& pn) {
    const int nwg = nM * nN;
    { const int q = nwg / NXCD, r = nwg % NXCD, xcd = wgid % NXCD, off = wgid / NXCD; wgid = (xcd < r ? xcd * (q + 1) : r * (q + 1) + (xcd - r) * q) + off; }
    const int nig = WGM * nN, gid = wgid / nig, fm = gid * WGM, gsz = (nM - fm) < WGM ? (nM - fm) : WGM;
    pm = fm + ((wgid % nig) % gsz); pn = (wgid % nig) / gsz;
}
typedef int i32x8 __attribute__((ext_vector_type(8)));
typedef int i32x4 __attribute__((ext_vector_type(4)));
template <bool GATHER, bool F8, class Epi, class Sched>
__device__ __forceinline__ void gemm_phase(LAS unsigned char* lds, const int K, const Sched& S, const Epi& E) {
    const int tid = ltid(), wid = __builtin_amdgcn_readfirstlane(tid >> 6), lane = tid & 63, wr = wid >> 2, wc = wid & 3, fr = lane & 15, fq = lane >> 4;
    const int nt = K / BK;
    unsigned voffA[2], voffB[2];
#pragma unroll
    for (int i = 0; i < 2; ++i) { int R, C; stage_rc(tid * 16 + i * 8192, R, C); const int Rb = ((int)Epi::PERM == 2) ? (64 * (R >> 5) + 16 * ((R & 15) >> 2) + 4 * ((R >> 4) & 1) + (R & 3))
                       : (Epi::PERM ? ((R & ~31) + perm32(R & 31)) : R);
        voffA[i] = (unsigned)(R * K + C) * 2u; voffB[i] = (unsigned)(Rb * K + C) * 2u; }
    (void)voffA;
    const size_t kstep = (size_t)(BK * 2);
    const size_t hstep = (size_t)HALF * K * 2;
    const size_t bhstep = ((int)Epi::PERM == 2) ? (size_t)8 * K * 2 : hstep;
    const unsigned ldsw = (unsigned)wid * 1024u;
    const int aoff = lds_byte(wr * 64 + fr, fq * 8), boff = lds_byte(wc * 32 + fr, fq * 8);
#define PG8_SA(b, h) (((b) * 2 + (h)) * HTB)
#define PG8_SB(b, h) ((4 + (b) * 2 + (h)) * HTB)
#define PG8_STAGE(bufoff, gbase, voff) do { _Pragma("unroll") for (int _i = 0; _i < 2; ++_i) { unsigned vo_ = (voff)[_i]; asm volatile("" : "+v"(vo_));     \
        __builtin_amdgcn_global_load_lds((const unsigned*)((const char*)(gbase) + vo_), (LAS unsigned*)(lds + (bufoff) + ldsw + _i * 8192), 16, 0, 0); } } while (0)
#define PG8_LDA(dst, b, h) do { if constexpr (F8) { _Pragma("unroll") for (int m = 0; m < 4; ++m) { dst##8[m].lo = *(const LAS i32x4*)(lds + PG8_SA(b, h) + aoff + m * 2048); dst##8[m].hi = *(const LAS i32x4*)(lds + PG8_SA(b, h) + aoff + m * 2048 + 1024); } } \
        else { _Pragma("unroll") for (int m = 0; m < 4; ++m) _Pragma("unroll") for (int k = 0; k < 2; ++k) dst[m][k] = *(const LAS bf16x8*)(lds + PG8_SA(b, h) + aoff + m * 2048 + k * 1024); } } while (0)
#define PG8_LDB(dst, b, h) do { if constexpr (F8) { _Pragma("unroll") for (int n = 0; n < 2; ++n) { dst##8[n].lo = *(const LAS i32x4*)(lds + PG8_SB(b, h) + boff + n * 2048); dst##8[n].hi = *(const LAS i32x4*)(lds + PG8_SB(b, h) + boff + n * 2048 + 1024); } } \
        else { _Pragma("unroll") for (int n = 0; n < 2; ++n) _Pragma("unroll") for (int k = 0; k < 2; ++k) dst[n][k] = *(const LAS bf16x8*)(lds + PG8_SB(b, h) + boff + n * 2048 + k * 1024); } } while (0)
#define PG8_MMA(ai, bj, At, Bt) do { __builtin_amdgcn_s_setprio(1); _Pragma("unroll") for (int m = 0; m < 4; ++m) _Pragma("unroll") for (int n = 0; n < 2; ++n) { \
        if constexpr (F8) acc[ai][bj][m][n] = __builtin_amdgcn_mfma_scale_f32_16x16x128_f8f6f4(Bt##8[n], At##8[m], acc[ai][bj][m][n], 0, 0, 0, 0, 0, 0); \
        else { _Pragma("unroll") for (int k = 0; k < 2; ++k) acc[ai][bj][m][n] = __builtin_amdgcn_mfma_f32_16x16x32_bf16(Bt[n][k], At[m][k], acc[ai][bj][m][n], 0, 0, 0); } } \
        __builtin_amdgcn_s_setprio(0); } while (0)
#define PG8_WAIT_V(n) asm volatile("s_waitcnt vmcnt(" #n ")" ::: "memory")
#define PG8_WAIT_L(n) asm volatile("s_waitcnt lgkmcnt(" #n ")" ::: "memory")
#define PG8_BAR __builtin_amdgcn_s_barrier()
#define PG8_SCHED __builtin_amdgcn_sched_barrier(0)
    Unit cur, nxt; int ui = 0;
    if (!S.next(0, cur)) return;
    f32x4 acc[2][2][4][2];
#pragma unroll
    for (int a = 0; a < 2; ++a)
#pragma unroll
        for (int b = 0; b < 2; ++b)
#pragma unroll
            for (int m = 0; m < 4; ++m)
#pragma unroll
                for (int n = 0; n < 2; ++n) acc[a][b][m][n] = (f32x4){0.f, 0.f, 0.f, 0.f};
    bf16x8 At[4][2], B0[2][2], B1[2][2];
    i32x8 At8[4], B08[2], B18[2];
    (void)At; (void)B0; (void)B1; (void)At8; (void)B08; (void)B18;
    const char* cA = cur.a; const char* cB = cur.b;
    unsigned ca0[2], ca1[2], na0[2], na1[2];
#define PG8_AOFFS(u, o0, o1) do { _Pragma("unroll") for (int _i = 0; _i < 2; ++_i) { \
        if constexpr (GATHER) { int R_, C_; stage_rc(ltid() * 16 + _i * 8192, R_, C_); const int* rw_ = (u).rows + R_; \
            o0[_i] = (unsigned)rw_[0] * (unsigned)(K * 2) + (unsigned)C_ * 2u; o1[_i] = (unsigned)rw_[128] * (unsigned)(K * 2) + (unsigned)C_ * 2u; } \
        else { o0[_i] = voffA[_i]; o1[_i] = voffA[_i] + (unsigned)hstep; } } } while (0)
    PG8_AOFFS(cur, ca0, ca1);
#pragma unroll
    for (int i = 0; i < 2; ++i) { na0[i] = ca0[i]; na1[i] = ca1[i]; }
    (void)na0; (void)na1;
    PG8_STAGE(PG8_SB(0, 0), cB, voffB); PG8_STAGE(PG8_SA(0, 0), cA, ca0); PG8_STAGE(PG8_SB(0, 1), cB + bhstep, voffB); PG8_STAGE(PG8_SA(0, 1), cA, ca1);
    if (wr == 1) PG8_BAR;
    PG8_WAIT_V(4); PG8_BAR;
    PG8_STAGE(PG8_SB(1, 0), cB + kstep, voffB); PG8_STAGE(PG8_SA(1, 0), cA + kstep, ca0); PG8_STAGE(PG8_SB(1, 1), cB + bhstep + kstep, voffB);
    PG8_WAIT_V(6); PG8_BAR;
    for (;;) {
        const bool has_next = S.next(ui + 1, nxt);
        const char* nA = has_next ? nxt.a : cA; const char* nB = has_next ? nxt.b : cB;
        if constexpr (!GATHER) { if (has_next) PG8_AOFFS(nxt, na0, na1); }
#pragma nounroll
        for (int t = 0; t < nt; t += 2) {
            const bool last = (t == nt - 2);
            const char* a1 = cA + (size_t)(t + 1) * kstep;
            const char* a2 = last ? nA : cA + (size_t)(t + 2) * kstep; const char* b2 = last ? nB : cB + (size_t)(t + 2) * kstep;
            const char* a3 = a2 + kstep; const char* b3 = b2 + kstep;
            unsigned xa0[2] = {ca0[0], ca0[1]}, xa1[2] = {ca1[0], ca1[1]};
            if (last) {
                if constexpr (GATHER) { if (has_next) PG8_AOFFS(nxt, xa0, xa1); }
                else { xa0[0] = na0[0]; xa0[1] = na0[1]; xa1[0] = na1[0]; xa1[1] = na1[1]; }
            }
            PG8_LDB(B0, 0, 0); PG8_SCHED; PG8_LDA(At, 0, 0); PG8_STAGE(PG8_SA(1, 1), a1, ca1);
            PG8_WAIT_L(8); PG8_BAR; PG8_WAIT_L(0); PG8_MMA(0, 0, At, B0); PG8_BAR; PG8_SCHED;
            PG8_LDB(B1, 0, 1); PG8_STAGE(PG8_SB(0, 0), b2, voffB);
            PG8_BAR; PG8_WAIT_L(0); PG8_MMA(0, 1, At, B1); PG8_BAR;
            PG8_LDA(At, 0, 1); PG8_STAGE(PG8_SA(0, 0), a2, xa0);
            PG8_BAR; PG8_WAIT_L(0); PG8_MMA(1, 0, At, B0); PG8_BAR; PG8_SCHED;
            PG8_STAGE(PG8_SB(0, 1), b2 + bhstep, voffB);
            PG8_WAIT_V(6); PG8_BAR; PG8_MMA(1, 1, At, B1); PG8_BAR;
            PG8_LDB(B0, 1, 0); PG8_SCHED; PG8_LDA(At, 1, 0); PG8_STAGE(PG8_SA(0, 1), a2, xa1);
            PG8_WAIT_L(8); PG8_BAR; PG8_WAIT_L(0); PG8_MMA(0, 0, At, B0); PG8_BAR; PG8_SCHED;
            PG8_LDB(B1, 1, 1); PG8_STAGE(PG8_SB(1, 0), b3, voffB);
            PG8_BAR; PG8_WAIT_L(0); PG8_MMA(0, 1, At, B1); PG8_BAR;
            PG8_LDA(At, 1, 1); PG8_STAGE(PG8_SA(1, 0), a3, xa0);
            PG8_BAR; PG8_WAIT_L(0); PG8_MMA(1, 0, At, B0); PG8_BAR; PG8_SCHED;
            PG8_STAGE(PG8_SB(1, 1), b3 + bhstep, voffB);
            PG8_WAIT_V(6); PG8_BAR; PG8_MMA(1, 1, At, B1); PG8_BAR;
        }
        { const int le = ltid() & 63; E(acc, cur, wr, wc, le & 15, le >> 4); }
        if (!has_next) break;
#pragma unroll
        for (int a = 0; a < 2; ++a)
#pragma unroll
            for (int b = 0; b < 2; ++b)
#pragma unroll
                for (int m = 0; m < 4; ++m)
#pragma unroll
                    for (int n = 0; n < 2; ++n) acc[a][b][m][n] = (f32x4){0.f, 0.f, 0.f, 0.f};
        cur = nxt; cA = nA; cB = nB; ++ui;
        if constexpr (GATHER) PG8_AOFFS(cur, ca0, ca1);
        else {
#pragma unroll
            for (int i = 0; i < 2; ++i) { ca0[i] = na0[i]; ca1[i] = na1[i]; }
        }
    }
    PG8_WAIT_V(0);
    if (wr == 0) PG8_BAR;
    PG8_BAR;
#undef PG8_AOFFS
#undef PG8_SA
#undef PG8_SB
#undef PG8_STAGE
#undef PG8_LDA
#undef PG8_LDB
#undef PG8_MMA
#undef PG8_WAIT_V
#undef PG8_WAIT_L
#undef PG8_BAR
#undef PG8_SCHED
}
}

constexpr unsigned long long IN_CTX_NEED = 0xFull | (3ull << 10) | (0xFull << 12) | (0xFull << 24) | (0xFull << 28) | (1ull << 44);
constexpr int IN_N8A = __builtin_popcountll(IN_F8_MASK & IN_CTX_NEED), IN_N8B = IN_N8 - IN_N8A;
template <bool F8>
struct SchedInproj { const char* A; const char* B; int nM, G, c, L;
    __device__ __forceinline__ bool next(int i, pg8::Unit& u) const { int pm, j; unsigned long long m = F8 ? IN_F8_MASK : IN_BF_MASK;
        if (F8 && L == 1 && IN_N8B > 0) {
            const long Lx = (long)i * G + c; const int totA = nM * IN_N8A, nMl = (nM / 9) * 8, totB = nMl * IN_N8B;
            if (Lx >= totA + totB) return false;
            if (Lx < totA) { pg8::tile_of((int)Lx, nM, IN_N8A, pm, j); m = IN_F8_MASK & IN_CTX_NEED; }
            else { int pmv; pg8::tile_of((int)Lx - totA, nMl, IN_N8B, pmv, j); pm = (pmv >> 3) * 9 + 1 + (pmv & 7); m = IN_F8_MASK & ~IN_CTX_NEED; }
        } else if (!pg8::static_tile(i, G, c, nM, F8 ? IN_N8 : IN_NBF, pm, j)) return false;
        for (int q = 0; q < j; ++q) m &= m - 1;
        const int pn = __builtin_ctzll(m);
        u.pm = pm; u.pn = pn; u.tag = 0; u.rows = nullptr; u.a = A + (size_t)pm * 256 * 1024 * (F8 ? 1 : 2); u.b = B + (size_t)pn * 256 * 1024 * (F8 ? 1 : 2); return true; } };
template <bool F8>
struct EpiInproj { static constexpr int PERM = 2; bf16_t* P; float* GATES; unsigned char* GP8; unsigned char* MO8;
    __device__ __forceinline__ void operator()(const f32x4 (&acc)[2][2][4][2], const pg8::Unit& u, int wr, int wc, int fr, int fq) const {
        const size_t row0 = (size_t)u.pm * 256 + wr * 64 + fr;
        constexpr float ASC = F8 ? pg8::F8_WINV : 1.0f;
        const int cw = wc * 64 + 16 * fq;
        if ((u.pn >= 16 && u.pn < 20) || (u.pn >= 32 && u.pn < 44)) {
            unsigned char* base = (u.pn < 20) ? (MO8 + (size_t)(u.pn - 16) * 256) : (GP8 + (size_t)(u.pn - 32) * 256);
            const unsigned ld8 = (u.pn < 20) ? 1024u : 3072u;
#pragma unroll
            for (int ai = 0; ai < 2; ++ai)
#pragma unroll
                for (int m = 0; m < 4; ++m) { unsigned char* rowp = base + (row0 + ai * 128 + m * 16) * ld8 + cw;
                    unsigned w[4];
#pragma unroll
                    for (int bj = 0; bj < 2; ++bj) { const f32x4 v0 = acc[ai][bj][m][0] * ASC, v1 = acc[ai][bj][m][1] * ASC;
                        int w0 = 0, w1 = 0;
                        w0 = __builtin_amdgcn_cvt_pk_fp8_f32(v0[0], v0[1], w0, false); w0 = __builtin_amdgcn_cvt_pk_fp8_f32(v0[2], v0[3], w0, true);
                        w1 = __builtin_amdgcn_cvt_pk_fp8_f32(v1[0], v1[1], w1, false); w1 = __builtin_amdgcn_cvt_pk_fp8_f32(v1[2], v1[3], w1, true);
                        w[2 * bj] = (unsigned)w0; w[2 * bj + 1] = (unsigned)w1; }
                    *(u32x4*)rowp = mk4(w[0], w[1], w[2], w[3]); }
        } else if (u.pn < 32) {
#pragma unroll
            for (int ai = 0; ai < 2; ++ai)
#pragma unroll
                for (int m = 0; m < 4; ++m) { bf16_t* rowp = P + (row0 + ai * 128 + m * 16) * PWID + u.pn * 256 + cw;
#pragma unroll
                    for (int bj = 0; bj < 2; ++bj) { const f32x4 v0 = acc[ai][bj][m][0] * ASC, v1 = acc[ai][bj][m][1] * ASC;
                        *(u32x4*)(rowp + bj * 8) = mk4(pk2(v0[0], v0[1]), pk2(v0[2], v0[3]), pk2(v1[0], v1[1]), pk2(v1[2], v1[3])); } }
        } else if (wc == 0 && fq == 0) {
#pragma unroll
            for (int ai = 0; ai < 2; ++ai)
#pragma unroll
                for (int m = 0; m < 4; ++m) { float* g = GATES + (row0 + ai * 128 + m * 16) * 16;
                    *(f32x4*)g = acc[ai][0][m][0] * ASC; *(f32x4*)(g + 4) = acc[ai][0][m][1] * ASC; *(f32x4*)(g + 8) = acc[ai][1][m][0] * ASC; *(f32x4*)(g + 12) = acc[ai][1][m][1] * ASC; }
        }
    } };
__device__ __forceinline__ void phase_inproj8(CP p, int L, LAS unsigned char* lds, int bid, int nb) {
    if constexpr (IN_N8 > 0) {
        SchedInproj<true> S{(const char*)p->H8, (const char*)p->bt_in8, p->G * SALL / 256, nb, bid, L};
        EpiInproj<true> E{p->P, p->GATES, p->GP8, p->MO8};
        pg8::gemm_phase<false, true>(lds, 512, S, E);
    }
    if constexpr (IN_NBF > 0) {
        SchedInproj<false> S{(const char*)p->H, (const char*)p->bt_in, p->G * SALL / 256, nb, nb - 1 - bid, L};
        EpiInproj<false> E{p->P, p->GATES, p->GP8, p->MO8};
        pg8::gemm_phase<false, false>(lds, 1024, S, E);
    }
}

struct CvtItem { const float* src; int sld; bf16_t* dst; int dld; int zero; float scale; int f8; };
__device__ __forceinline__ CvtItem cvt_decode(CP p, int L, int item) {
    CvtItem c; c.zero = 0; c.scale = 1.0f; c.f8 = 0;
    if (item < 11520) {
        const int g = item >> 4, kb = item & 15; int sc = 0;
        if (g < 320) sc = 16 * g; else if (g < 704) sc = 16 * g + 16; else if (g == 704) sc = 5120; else c.zero = 1;
        c.src = p->w_in + (size_t)L * 1024 * 11280 + (size_t)kb * 64 * 11280 + sc; c.sld = 11280;
        if ((IN_F8_MASK >> (g >> 4)) & 1) { c.dst = (bf16_t*)(p->bt_in8 + (size_t)g * 16 * 1024 + kb * 64); c.dld = 1024; c.f8 = 1; c.scale = pg8::F8_WMUL; return c; }
        c.dst = p->bt_in + (size_t)g * 16 * 1024 + kb * 64; c.dld = 1024; return c;
    }
    item -= 11520;
    if (item < 3072) {
        const int j = item >> 10, r = item & 1023, g = r >> 4, kb = r & 15;
        c.src = p->w_branch + ((size_t)(L * 3 + j) * 1024 + kb * 64) * 1024 + g * 16; c.sld = 1024;
        if (MERGE_F8 && j > 0) { c.dst = (bf16_t*)((unsigned char*)p->bt_br + (size_t)j * 1024 * 1024 * 2 + (size_t)g * 16 * 1024 + kb * 64); c.dld = 1024; c.f8 = 1; c.scale = pg8::F8_WMUL; return c; }
        c.dst = p->bt_br + ((size_t)j * 1024 + g * 16) * 1024 + kb * 64; c.dld = 1024; return c;
    }
    item -= 3072;
    if (item < 1024) {
        const int g = item >> 4, kb = item & 15;
        c.src = p->w_out + ((size_t)L * 1024 + kb * 64) * 1024 + g * 16; c.sld = 1024;
        c.dst = p->bt_out + (size_t)g * 16 * 1024 + kb * 64; c.dld = 1024; return c;
    }
    item -= 1024;
    if (item < 33280) {
        const int e = item >> 9, r = item & 511, g = r >> 4, kb = r & 15;
        const int nt = g >> 4, n = ((g >> 3) & 1) * 2, f = nt * 128 + (g & 7) * 16;
        const float* base = (e < 64) ? ((n < 2 ? p->w_e_gate : p->w_e_up) + ((size_t)(L * 64 + e)) * 1024 * 256) : ((n < 2 ? p->w_s_gate : p->w_s_up) + (size_t)L * 1024 * 256);
        c.src = base + (size_t)kb * 64 * 256 + f; c.sld = 256;
        c.dst = (bf16_t*)((unsigned char*)p->bt_eup + ((size_t)e * 512 + g * 16) * 1024 + kb * 64); c.dld = 1024; c.f8 = 1; c.scale = 64.0f; return c;
    }
    item -= 33280;
    if (item < 16640) {
        const int e = item >> 8, r = item & 255, g = r >> 2, kb = r & 3;
        const float* base = (e < 64) ? (p->w_e_down + ((size_t)(L * 64 + e)) * 256 * 1024) : (p->w_s_down + (size_t)L * 256 * 1024);
        c.src = base + (size_t)kb * 64 * 1024 + g * 16; c.sld = 1024;
        if (DOWN_F8) { c.dst = (bf16_t*)((unsigned char*)p->bt_edn + ((size_t)e * 1024 + g * 16) * 256 + kb * 64); c.dld = 256; c.f8 = 1; c.scale = DW_SC; return c; }
        c.dst = p->bt_edn + ((size_t)e * 1024 + g * 16) * 256 + kb * 64; c.dld = 256; c.scale = D_SCALE; return c;
    }
    item -= 16640;
    {
        const int dh = item >> 5, r = item & 31, g = r >> 1, kb = r & 1;
        const int cq = g >> 2, n = g & 3, ch = cq * 32 + (n & 1) * 16;
        const float* base = (n < 2 ? p->lru_wa : p->lru_wx) + ((size_t)(L * 16 + dh)) * 128 * 128;
        c.src = base + (size_t)kb * 64 * 128 + ch; c.sld = 128;
        c.dst = p->bt_lru + ((size_t)dh * 256 + g * 16) * 128 + kb * 64; c.dld = 128; return c;
    }
}
constexpr int CVT_ITEMS = 11520 + 3072 + 1024 + 33280 + 16640 + 512;
__device__ __forceinline__ void phase_convert(CP p, int L, LAS unsigned char* lds, int bid, int nb) {
    const int tid = ltid(), sub = tid >> 7, t = tid & 127;
    for (int it = bid; it * 8 < CVT_ITEMS; it += nb) {
        CvtItem c[2]; bool valid[2];
        float4 v0[2], v1[2];
        const int kp = t >> 2, qu = t & 3;
#pragma unroll
        for (int q = 0; q < 2; ++q) {
            int item = it * 8 + sub * 2 + q;
            valid[q] = item < CVT_ITEMS;
            if (item < 48896) item = (item & ~127) + ((item & 7) << 4) + ((item & 127) >> 3);
            else if (item < 48896 + 16640) { const int j = item - 48896; item = 48896 + (j & ~31) + ((j & 7) << 2) + ((j & 31) >> 3); }
            else if (item < CVT_ITEMS) { const int j = item - 65536; item = 65536 + (j & ~15) + ((j & 7) << 1) + ((j & 15) >> 3); }
            c[q].src = nullptr; c[q].dst = nullptr; c[q].sld = 0; c[q].dld = 0; c[q].zero = 1; c[q].scale = 1.0f; c[q].f8 = 0;
            if (valid[q]) c[q] = cvt_decode(p, L, item);
            v0[q] = make_float4(0.f, 0.f, 0.f, 0.f); v1[q] = v0[q];
            if (valid[q] && !c[q].zero) { const float* s2 = c[q].src + (size_t)(2 * kp) * c[q].sld + qu * 4; v0[q] = *(const float4*)s2; v1[q] = *(const float4*)(s2 + c[q].sld); }
        }
#pragma unroll
        for (int q = 0; q < 2; ++q) {
            LAS bf16_t* tile = (LAS bf16_t*)(lds + (sub * 2 + q) * (16 * 66 * 2));
            const float va[4] = {v0[q].x, v0[q].y, v0[q].z, v0[q].w}, vb[4] = {v1[q].x, v1[q].y, v1[q].z, v1[q].w};
#pragma unroll
            for (int i = 0; i < 4; ++i) *(LAS unsigned*)(tile + (qu * 4 + i) * 66 + 2 * kp) = pk2(va[i] * c[q].scale, vb[i] * c[q].scale);
        }
        __syncthreads();
#pragma unroll
        for (int q = 0; q < 2; ++q) {
            if (valid[q]) {
                LAS bf16_t* tile = (LAS bf16_t*)(lds + (sub * 2 + q) * (16 * 66 * 2));
                const int i = t >> 3, seg = t & 7;
                unsigned w[4];
#pragma unroll
                for (int x = 0; x < 4; ++x) w[x] = *(LAS unsigned*)(tile + i * 66 + seg * 8 + 2 * x);
                if (c[q].f8) { int f0 = 0, f1 = 0;
                    f0 = __builtin_amdgcn_cvt_pk_fp8_f32(lo_bf(w[0]), hi_bf(w[0]), f0, false); f0 = __builtin_amdgcn_cvt_pk_fp8_f32(lo_bf(w[1]), hi_bf(w[1]), f0, true);
                    f1 = __builtin_amdgcn_cvt_pk_fp8_f32(lo_bf(w[2]), hi_bf(w[2]), f1, false); f1 = __builtin_amdgcn_cvt_pk_fp8_f32(lo_bf(w[3]), hi_bf(w[3]), f1, true);
                    *(u32x2*)((unsigned char*)c[q].dst + (size_t)i * c[q].dld + seg * 8) = mk2((unsigned)f0, (unsigned)f1); }
                else *(u32x4*)(c[q].dst + (size_t)i * c[q].dld + seg * 8) = mk4(w[0], w[1], w[2], w[3]);
            }
        }
        __syncthreads();
    }
}

__device__ __forceinline__ void phase_mods(CP p, LAS unsigned char* lds, int bid, int nb) {
    const int tid = ltid();
    LAS float* sl = (LAS float*)lds;
    const int tcol = tid & 63, kp = tid >> 6;
    for (int item = bid; item < 192; item += nb) {
        const int L = item / 96, n0 = (item % 96) * 64;
        __syncthreads();
#pragma unroll 1
        for (int q0 = 0; q0 < 66; q0 += 22) {
            float cvv[22];
#pragma unroll
            for (int q = 0; q < 22; ++q) { const int e = tid + (q0 + q) * NTHREADS; cvv[q] = (q0 + q < 64) ? p->c[e] : p->c_ctx[e - 32768]; }
#pragma unroll
            for (int q = 0; q < 22; ++q) { const int e = tid + (q0 + q) * NTHREADS; sl[(e & 1023) * 33 + (e >> 10)] = cvv[q] * __builtin_amdgcn_rcpf(1.0f + __expf(-cvv[q])); }
        }
        __syncthreads();
        float acc[33];
#pragma unroll
        for (int r = 0; r < 33; ++r) acc[r] = 0.f;
        const float* w = p->w_ada + ((size_t)L * 1024 + kp * 128) * 6144 + n0 + tcol;
        for (int k0 = 0; k0 < 128; k0 += 16) {
            float wv[16];
#pragma unroll
            for (int k = 0; k < 16; ++k) wv[k] = w[(size_t)(k0 + k) * 6144];
            LAS float* sk = sl + (kp * 128 + k0) * 33;
#pragma unroll
            for (int k = 0; k < 16; ++k)
#pragma unroll
                for (int r = 0; r < 33; ++r) acc[r] += sk[k * 33 + r] * wv[k];
        }
        __syncthreads();
#pragma unroll
        for (int r = 0; r < 33; ++r) sl[(kp * 33 + r) * 64 + tcol] = acc[r];
        __syncthreads();
        const float bv = p->b_ada[L * 6144 + n0 + tcol];
        for (int r = kp; r < 33; r += 8) {
            float sum = 0.f;
#pragma unroll
            for (int q = 0; q < 8; ++q) sum += sl[(q * 33 + r) * 64 + tcol];
            if (r < 32) p->mods_l[((size_t)L * 32 + r) * 6144 + n0 + tcol] = sum + bv;
            else p->mods_c[(size_t)L * 6144 + n0 + tcol] = sum + bv;
        }
    }
    for (int e = bid * NTHREADS + tid; e < 2048 * 32; e += nb * NTHREADS) {
        const int s = e >> 5, a = (e >> 4) & 1, f = e & 15;
        const float pos = (float)(a == 0 ? (s >> 6) : (s & 63));
        const float fr = powf(10000.0f, -(float)f / 16.0f);
        float sn, cs; sincosf(pos * fr, &sn, &cs);
        p->rope[2 * e] = cs; p->rope[2 * e + 1] = sn;
    }
    if (bid == 0 && tid < 128) {
        const int L = tid >> 6, lane = tid & 63;
        const float* lv = p->da_lambda + L * 256;
        const float a = wave_sum(lv[lane] * lv[64 + lane]), b = wave_sum(lv[128 + lane] * lv[192 + lane]);
        const float lam_init = 0.8f - 0.6f * expf(-0.3f * (float)L);
        if (lane == 0) p->lamv[L] = expf(a) - expf(b) + lam_init;
        float gq = fabsf(p->da_qnorm_g[L * 64 + lane]), gk = fabsf(p->da_knorm_g[L * 64 + lane]);
#pragma unroll
        for (int o = 32; o >= 1; o >>= 1) { gq = fmaxf(gq, sx_(gq, o)); gk = fmaxf(gk, sx_(gk, o)); }
        if (lane == 0) p->lamv[2 + L] = 64.0f * gq * gk * 0.125f * 1.4426950408889634f * 1.001f + 0.01f;
    }
}

__device__ __forceinline__ void phase_prenorm(CP p, int L, int grp, int bid, int nb) {
    const int lane = ltid() & 63, wid = ltid() >> 6;
    const int RG = p->G * SALL;
    const float* g1 = p->norm1_g + L * 1024;
    float4 gq[4];
#pragma unroll
    for (int i = 0; i < 4; ++i) gq[i] = *(const float4*)(g1 + i * 256 + lane * 4);
    for (int r = bid * 8 + wid; r < RG; r += nb * 8) {
        const int bl = r / SALL, pos = r - bl * SALL, b = grp * p->G + bl;
        const float* src; const float* md;
        const bf16_t* srcb;
        if (pos < CTXL) { src = p->ctx + ((size_t)b * CTXL + pos) * 1024; srcb = p->XC1 + ((size_t)b * CTXL + pos) * 1024; md = p->mods_c + (size_t)L * 6144; }
        else { src = p->x + ((size_t)b * SEQ + (pos - CTXL)) * 1024; srcb = p->XB + ((size_t)b * SEQ + (pos - CTXL)) * 1024; md = p->mods_l + ((size_t)L * 32 + b) * 6144; }
        float4 v[4]; float ss = 0.f;
        if (L == 0) {
#pragma unroll
            for (int i = 0; i < 4; ++i) v[i] = *(const float4*)(src + i * 256 + lane * 4);
        } else {
            u32x2 vb[4];
#pragma unroll
            for (int i = 0; i < 4; ++i) vb[i] = *(const u32x2*)(srcb + i * 256 + lane * 4);
#pragma unroll
            for (int i = 0; i < 4; ++i) v[i] = make_float4(lo_bf(vb[i].x), hi_bf(vb[i].x), lo_bf(vb[i].y), hi_bf(vb[i].y));
        }
#pragma unroll
        for (int i = 0; i < 4; ++i) ss += v[i].x * v[i].x + v[i].y * v[i].y + v[i].z * v[i].z + v[i].w * v[i].w;
        float4 shq[4], scq[4];
#pragma unroll
        for (int i = 0; i < 4; ++i) { const int col = i * 256 + lane * 4; shq[i] = *(const float4*)(md + col); scq[i] = *(const float4*)(md + 1024 + col); }
        ss = wave_sum(ss);
        const float rstd = rsqrtf(ss * (1.0f / 1024.0f) + 1e-6f);
#pragma unroll
        for (int i = 0; i < 4; ++i) {
            const int col = i * 256 + lane * 4;
            const float4 g = gq[i], sh = shq[i], sc = scq[i];
            const float o0 = v[i].x * rstd * g.x * (1.f + sc.x) + sh.x, o1 = v[i].y * rstd * g.y * (1.f + sc.y) + sh.y;
            const float o2 = v[i].z * rstd * g.z * (1.f + sc.z) + sh.z, o3 = v[i].w * rstd * g.w * (1.f + sc.w) + sh.w;
            if (IN_N8 > 0) { int w8 = 0; w8 = __builtin_amdgcn_cvt_pk_fp8_f32(o0, o1, w8, false); w8 = __builtin_amdgcn_cvt_pk_fp8_f32(o2, o3, w8, true); *(unsigned*)(p->H8 + (size_t)r * 1024 + col) = (unsigned)w8; }
            if (IN_NBF > 0) *(u32x2*)(p->H + (size_t)r * 1024 + col) = mk2(pk2(o0, o1), pk2(o2, o3));
        }
    }
}

__device__ __forceinline__ void phase_daprep(CP p, int L, int grp, int bid, int nb) {
    const int lane = ltid() & 63, wid = ltid() >> 6;
    const int RG = p->G * SALL;
    const float* qg = p->da_qnorm_g + L * 64; const float* kg = p->da_knorm_g + L * 64;
    const int d0 = (lane & 7) * 8;
    float gq[8], gk[8];
    const float qscale = 0.125f * 1.4426950408889634f;
#pragma unroll
    for (int j = 0; j < 8; ++j) { gq[j] = qg[d0 + j] * qscale; gk[j] = kg[d0 + j]; }
    const bool second = (lane & 2) != 0;
    for (int r = bid * 8 + wid; r < RG; r += nb * 8) {
        const int bl = r / SALL, pos = r - bl * SALL;
        bf16_t* row = p->P + (size_t)r * PWID + PC_DQ;
        const bool lat = pos >= CTXL;
        u32x4 u[4];
#pragma unroll
        for (int i = 0; i < 4; ++i) u[i] = *(const u32x4*)(row + (lane + 64 * i) * 8);
        f32x4 rt4[4];
#pragma unroll
        for (int q = 0; q < 4; ++q) rt4[q] = (f32x4){1.f, 0.f, 1.f, 0.f};
        if (lat) {
            const int s2 = pos - CTXL, ax = (lane >> 2) & 1, f0 = (lane & 1) * 8;
            const float* rt = p->rope + ((size_t)s2 * 32 + ax * 16 + f0) * 2;
#pragma unroll
            for (int q = 0; q < 4; ++q) rt4[q] = *(const f32x4*)(rt + 4 * q);
        }
#pragma unroll
        for (int i = 0; i < 4; ++i) {
            float v[8] = {lo_bf(u[i].x), hi_bf(u[i].x), lo_bf(u[i].y), hi_bf(u[i].y), lo_bf(u[i].z), hi_bf(u[i].z), lo_bf(u[i].w), hi_bf(u[i].w)};
            float ss = 0.f;
#pragma unroll
            for (int j = 0; j < 8; ++j) ss += v[j] * v[j];
            ss += dppf<0xB1>(0.f, ss); ss += dppf<0x4E>(0.f, ss); ss += dppf<0x141>(0.f, ss);
            const float rstd = rsqrtf(ss * (1.0f / 64.0f) + 1e-6f);
#pragma unroll
            for (int j = 0; j < 8; ++j) v[j] = v[j] * rstd * (i < 2 ? gq[j] : gk[j]);
            if (lat) {
#pragma unroll
                for (int j = 0; j < 8; ++j) {
                    const float cs = rt4[j >> 1][(j & 1) * 2], sn = rt4[j >> 1][(j & 1) * 2 + 1];
                    const float o = dppf<0x4E>(0.f, v[j]);
                    v[j] = second ? (v[j] * cs + o * sn) : (v[j] * cs - o * sn);
                }
            }
            u[i] = mk4(pk2(v[0], v[1]), pk2(v[2], v[3]), pk2(v[4], v[5]), pk2(v[6], v[7]));
        }
#pragma unroll
        for (int i = 0; i < 4; ++i) *(u32x4*)(row + (lane + 64 * i) * 8) = u[i];
    }
}

constexpr int AT_KROW = 272, AT_VROW = 288, AT_K = 64 * AT_KROW, AT_STAGE = 64 * AT_KROW + 64 * AT_VROW;
constexpr int A2_QROW = 272, A2_KV = 256 * A2_QROW, A3_STAGE_BYTES = 32768;
static_assert(A2_KV + 2 * AT_STAGE <= 147456 - 64, "attention LDS");
__device__ __forceinline__ void attn_unit2(CP p, int L, LAS unsigned char* lds, int bl, int hd, int qt) {
    const int tid = ltid(), lane = tid & 63, wid = tid >> 6, q4 = lane >> 4, l15 = lane & 15;
    const size_t rowbase = (size_t)bl * SALL;
    const int qpos0 = (qt < 8) ? (CTXL + qt * 256) : 0;
    const int nkt = (qt < 8) ? 36 : 4;
    LAS unsigned char* kv = lds + A2_KV;
    __syncthreads();
    {
#pragma unroll
        for (int i = 0; i < 8; ++i) {
            const int id = tid + NTHREADS * i, row = id >> 4, ch = id & 15;
            *(LAS u32x4*)(lds + row * A2_QROW + ch * 16) = *(const u32x4*)(p->P + (rowbase + qpos0 + row) * PWID + PC_DQ + hd * 128 + ch * 8);
        }
    }
    const bf16_t* kbase = p->P + rowbase * PWID + PC_DK + hd * 128;
    const bf16_t* vbase = kbase + (PC_DV - PC_DK);
    const int drow = wid * 8 + (lane >> 4);
    const unsigned dof0 = (unsigned)drow * PWID + (((lane & 15) ^ (drow & 15)) << 3);
    const unsigned dof1 = (unsigned)(drow + 4) * PWID + (((lane & 15) ^ ((drow + 4) & 15)) << 3);
#define A3_STAGE(stg, kt_) do { const bf16_t* kb_ = kbase + (size_t)(kt_) * 64 * PWID; const bf16_t* vb_ = kb_ + (PC_DV - PC_DK); LAS unsigned char* d_ = kv + (stg) * A3_STAGE_BYTES + wid * 2048; \
        __builtin_amdgcn_global_load_lds((const unsigned*)(kb_ + dof0), (LAS unsigned*)(d_), 16, 0, 0); __builtin_amdgcn_global_load_lds((const unsigned*)(kb_ + dof1), (LAS unsigned*)(d_ + 1024), 16, 0, 0); \
        __builtin_amdgcn_global_load_lds((const unsigned*)(vb_ + dof0), (LAS unsigned*)(d_ + 16384), 16, 0, 0); __builtin_amdgcn_global_load_lds((const unsigned*)(vb_ + dof1), (LAS unsigned*)(d_ + 16384 + 1024), 16, 0, 0); } while (0)
    A3_STAGE(0, 0);
    asm volatile("s_waitcnt vmcnt(0)" ::: "memory");
    __syncthreads();
    f32x4 o[2][2][8];
#pragma unroll
    for (int c = 0; c < 2; ++c)
#pragma unroll
        for (int mt = 0; mt < 2; ++mt)
#pragma unroll
            for (int d = 0; d < 8; ++d) o[c][mt][d] = (f32x4){0.f, 0.f, 0.f, 0.f};
    float ls[2][2] = {{0.f, 0.f}, {0.f, 0.f}};
    const float nbound = -p->lamv[2 + L];
    const int qro = (wid * 32 + l15) * A2_QROW + q4 * 16;
    bf16x8 qf[2][2];
#pragma unroll
    for (int mt = 0; mt < 2; ++mt)
#pragma unroll
        for (int ks = 0; ks < 2; ++ks) qf[mt][ks] = *(LAS bf16x8*)(lds + qro + mt * 16 * A2_QROW + ks * 64);
    for (int kt = 0; kt < nkt; ++kt) {
        LAS unsigned char* cur = kv + (kt & 1) * A3_STAGE_BYTES;
        const bool more = kt + 1 < nkt;
        int lz = l15; asm volatile("" : "+v"(lz));
        const int kro = lz * 256, vrow0 = 4 * q4 + (lz >> 2);
        if (more) A3_STAGE((kt + 1) & 1, kt + 1);
        bf16x8 pf[2][2][2];
        f32x4 sacc[2][2][4];
#define A3_QLOAD(c_) do { _Pragma("unroll") for (int mt = 0; mt < 2; ++mt) _Pragma("unroll") for (int ks = 0; ks < 2; ++ks) qf[mt][ks] = *(LAS bf16x8*)(lds + qro + mt * 16 * A2_QROW + (c_) * 128 + ks * 64); } while (0)
#define A3_SC(s_) ((((s_) >> 3) == 0) ? (((s_) & 7) >> 2) : (1 - (((s_) & 7) >> 2)))
#define A3_SN(s_) (2 * ((s_) >> 3) + ((((s_) & 7) >> 1) & 1))
#define A3_KLOAD(s_) kf[(s_) % 3] = *(LAS bf16x8*)(cur + kro + A3_SN(s_) * 4096 + (((A3_SC(s_) * 8 + ((s_) & 1) * 4 + q4) ^ lz) << 4))
#define A3_EXP4(c_, mt_, n_) do { _Pragma("unroll") for (int j = 0; j < 4; ++j) { sacc[c_][mt_][n_][j] = __builtin_amdgcn_exp2f(sacc[c_][mt_][n_][j]); ls[c_][mt_] += sacc[c_][mt_][n_][j]; } } while (0)
#define A3_PACK(c_, mt_, k2_) do { union { bf16x8 v; unsigned u[4]; } cv; \
            cv.u[0] = pk2(sacc[c_][mt_][2 * (k2_)][0], sacc[c_][mt_][2 * (k2_)][1]); cv.u[1] = pk2(sacc[c_][mt_][2 * (k2_)][2], sacc[c_][mt_][2 * (k2_)][3]); \
            cv.u[2] = pk2(sacc[c_][mt_][2 * (k2_) + 1][0], sacc[c_][mt_][2 * (k2_) + 1][1]); cv.u[3] = pk2(sacc[c_][mt_][2 * (k2_) + 1][2], sacc[c_][mt_][2 * (k2_) + 1][3]); pf[c_][mt_][k2_] = cv.v; } while (0)
#define A3_VREAD(v_) do { const int d_ = (v_) & 7, k2_ = (v_) >> 3; const int vr0 = 32 * k2_ + vrow0, vr1 = vr0 + 16; \
            const int vsw = (((d_ * 2 + ((lz & 3) >> 1)) ^ (vr0 & 15)) << 4) + (lz & 1) * 8; \
            const s16x4 v0 = __builtin_amdgcn_ds_read_tr16_b64_v4i16((LAS s16x4*)(cur + 16384 + vr0 * 256 + vsw)); \
            const s16x4 v1 = __builtin_amdgcn_ds_read_tr16_b64_v4i16((LAS s16x4*)(cur + 16384 + vr1 * 256 + vsw)); \
            vf[(v_) % 3] = (bf16x8){v0[0], v0[1], v0[2], v0[3], v1[0], v1[1], v1[2], v1[3]}; } while (0)
        bf16x8 kf[3], vf[3];
        A3_KLOAD(0); A3_KLOAD(1);
#pragma unroll
        for (int sq = 0; sq < 16; ++sq) {
            if (sq == 4) A3_QLOAD(1);
            if (sq == 12) A3_QLOAD(0);
            if (sq + 2 < 16) A3_KLOAD(sq + 2); else A3_VREAD(sq + 2 - 16);
            {
                const int c = A3_SC(sq), n = A3_SN(sq), ks = sq & 1;
                if (ks == 0) { sacc[c][0][n] = (f32x4){nbound, nbound, nbound, nbound}; sacc[c][1][n] = (f32x4){nbound, nbound, nbound, nbound}; }
                sacc[c][0][n] = __builtin_amdgcn_mfma_f32_16x16x32_bf16(kf[sq % 3], qf[0][ks], sacc[c][0][n], 0, 0, 0);
                sacc[c][1][n] = __builtin_amdgcn_mfma_f32_16x16x32_bf16(kf[sq % 3], qf[1][ks], sacc[c][1][n], 0, 0, 0);
            }
            if (sq >= 4) { const int e = sq - 4; A3_EXP4((e >> 2) ? 1 : 0, (e >> 1) & 1, ((e >> 3) ? 2 : 0) + (e & 1)); }
            if (sq == 7) { A3_PACK(0, 0, 0); A3_PACK(0, 1, 0); }
            if (sq == 11) { A3_PACK(1, 0, 0); A3_PACK(1, 1, 0); }
            if (sq == 15) { A3_PACK(1, 0, 1); A3_PACK(1, 1, 1); }
            __builtin_amdgcn_sched_barrier(0);
        }
#pragma unroll
        for (int v = 0; v < 16; ++v) {
            if (v + 2 < 16) A3_VREAD(v + 2);
            if (v == 8) { A3_PACK(0, 0, 1); A3_PACK(0, 1, 1); }
            {
                const int d = v & 7, k2 = v >> 3;
                o[0][0][d] = __builtin_amdgcn_mfma_f32_16x16x32_bf16(vf[v % 3], pf[0][0][k2], o[0][0][d], 0, 0, 0); o[0][1][d] = __builtin_amdgcn_mfma_f32_16x16x32_bf16(vf[v % 3], pf[0][1][k2], o[0][1][d], 0, 0, 0);
                o[1][0][d] = __builtin_amdgcn_mfma_f32_16x16x32_bf16(vf[v % 3], pf[1][0][k2], o[1][0][d], 0, 0, 0); o[1][1][d] = __builtin_amdgcn_mfma_f32_16x16x32_bf16(vf[v % 3], pf[1][1][k2], o[1][1][d], 0, 0, 0);
            }
            if (v < 8 && (v & 1) == 0) A3_EXP4(0, (v >> 2) & 1, 2 + ((v >> 1) & 1));
            __builtin_amdgcn_sched_barrier(0);
        }
#undef A3_VREAD
#undef A3_QLOAD
#undef A3_SC
#undef A3_SN
#undef A3_KLOAD
#undef A3_EXP4
#undef A3_PACK
        asm volatile("s_waitcnt vmcnt(0)" ::: "memory");
        __syncthreads();
    }
#undef A3_STAGE
    const float lam = p->lamv[L];
    const float lam_init = 0.8f - 0.6f * expf(-0.3f * (float)L);
    const float* sg = p->da_subln_g + L * 128;
#pragma unroll
    for (int mt = 0; mt < 2; ++mt) {
        float l0 = ls[0][mt], l1 = ls[1][mt];
        l0 += sx_(l0, 16); l0 += sx_(l0, 32); l1 += sx_(l1, 16); l1 += sx_(l1, 32);
        const float i0 = 1.0f / l0, i1 = lam / l1;
        float ss = 0.f;
#pragma unroll
        for (int d = 0; d < 8; ++d)
#pragma unroll
            for (int j = 0; j < 4; ++j) { const float v = o[0][mt][d][j] * i0 - o[1][mt][d][j] * i1; o[0][mt][d][j] = v; ss += v * v; }
        ss += sx_(ss, 16); ss += sx_(ss, 32);
        const float rstd = rsqrtf(ss * (1.0f / 128.0f) + 1e-6f) * (1.0f - lam_init);
        bf16_t* orow = p->YC + (rowbase + qpos0 + wid * 32 + mt * 16 + l15) * 1024 + hd * 128;
#pragma unroll
        for (int d = 0; d < 8; ++d) {
            const int dv = d * 16 + 4 * q4;
            const f32x4 g = *(const f32x4*)(sg + dv);
            if (MERGE_F8) { int w8 = 0; w8 = __builtin_amdgcn_cvt_pk_fp8_f32(o[0][mt][d][0] * rstd * g[0], o[0][mt][d][1] * rstd * g[1], w8, false); w8 = __builtin_amdgcn_cvt_pk_fp8_f32(o[0][mt][d][2] * rstd * g[2], o[0][mt][d][3] * rstd * g[3], w8, true);
                *(unsigned*)((unsigned char*)p->YC + (rowbase + qpos0 + wid * 32 + mt * 16 + l15) * 1024 + hd * 128 + dv) = (unsigned)w8; }
            else *(u32x2*)(orow + dv) = mk2(pk2(o[0][mt][d][0] * rstd * g[0], o[0][mt][d][1] * rstd * g[1]), pk2(o[0][mt][d][2] * rstd * g[2], o[0][mt][d][3] * rstd * g[3]));
        }
    }
}

constexpr int ML_QROW = 272, ML_KROW = 288, ML_VROW = 544, ML_SROW = 144;
constexpr int ML_Q = 0, ML_K = ML_Q + 64 * ML_QROW, ML_V = ML_K + 64 * ML_KROW, ML_S = ML_V + 64 * ML_VROW, ML_ARR = ML_S + 64 * ML_SROW, ML_N = ML_ARR + 4 * 256, ML_RD = ML_N + 2 * 512, ML_NP = ML_RD + 8 * 256, ML_H = ML_NP + 4 * 512, ML_HROW = 528, ML_SSP = ML_H + 64 * ML_HROW  , ML_QN = ML_SSP + 1024  , ML_END = ML_QN + 256;
static_assert(ML_END <= LDS_BYTES, "mlstm LDS");
__device__ __forceinline__ void mlstm_unit(CP p, int L, LAS unsigned char* lds, int bl, int hd, int dir) {
    const int tid = ltid(), lane = tid & 63, wid = tid >> 6, q4 = lane >> 4, l15 = lane & 15;
    const size_t rowbase = (size_t)bl * SALL;
    LAS float* carr = (LAS float*)(lds + ML_ARR);
    LAS float* Marr = carr + 64;
    LAS float* wsarr = carr + 128;
    LAS float* wiarr = carr + 192;
    LAS float* nbuf = (LAS float*)(lds + ML_N);
    LAS float* npart = (LAS float*)(lds + ML_NP);
    const float gbi = p->ml_gate_b[((L * 2 + dir) * 2 + 0) * 4 + hd], gbf = p->ml_gate_b[((L * 2 + dir) * 2 + 1) * 4 + hd];
    __syncthreads();
    if (tid < 128) nbuf[tid] = 0.f;
    f32x4 C[8][2];
#pragma unroll
    for (int a = 0; a < 8; ++a) { C[a][0] = (f32x4){0.f, 0.f, 0.f, 0.f}; C[a][1] = C[a][0]; }
    float mstate = 0.f;
    const int srow = tid >> 4, sch = tid & 15;
    const int vrow = tid >> 5, vch = tid & 31;
    u32x4 rq[2], rk[2], rv[4]; float rgi = 0.f, rgf = 0.f;
    auto chunk_pb = [&](int t) -> int { return dir == 0 ? t * 64 : (t < 4 ? (3 - t) * 64 : (39 - t) * 64); };
    auto grow_of = [&](int pb, int j) -> size_t { return rowbase + pb + (dir ? 63 - j : j); };
    auto issue = [&](int t) {
        const int pb = chunk_pb(t);
#pragma unroll
        for (int i = 0; i < 2; ++i) {
            const bf16_t* r = p->P + grow_of(pb, srow + 32 * i) * PWID;
            rq[i] = *(const u32x4*)(r + PC_MQ + hd * 128 + sch * 8);
            rk[i] = *(const u32x4*)(r + PC_MK + hd * 128 + sch * 8);
        }
#pragma unroll
        for (int i = 0; i < 4; ++i) rv[i] = *(const u32x4*)(p->P + grow_of(pb, vrow + 16 * i) * PWID + PC_MV + hd * 256 + vch * 8);
        { const float* gr = p->GATES + grow_of(pb, lane) * 16 + dir * 8 + hd; rgi = gr[0]; rgf = gr[4]; }
    };
    issue(0);
    for (int t = 0; t < 36; ++t) {
        const int pb = chunk_pb(t);
        const float gi = rgi + gbi, gf = rgf + gbf;
        const float lf = fminf(gf, 0.f) - __logf(1.0f + __expf(-fabsf(gf)));
        float bcs = lf;
        bcs += dppf<0x111>(0.f, bcs); bcs += dppf<0x112>(0.f, bcs); bcs += dppf<0x114>(0.f, bcs); bcs += dppf<0x118>(0.f, bcs);
        {
            const float t0 = __builtin_bit_cast(float, __builtin_amdgcn_readlane(__builtin_bit_cast(int, bcs), 15));
            const float t1 = __builtin_bit_cast(float, __builtin_amdgcn_readlane(__builtin_bit_cast(int, bcs), 31));
            const float t2 = __builtin_bit_cast(float, __builtin_amdgcn_readlane(__builtin_bit_cast(int, bcs), 47));
            bcs += (q4 == 0) ? 0.f : ((q4 == 1) ? t0 : ((q4 == 2) ? (t0 + t1) : (t0 + t1 + t2)));
        }
        const float cval = gi - bcs;
        float cm = cval;
        cm = fmaxf(cm, dppf<0x111>(-3.0e38f, cm)); cm = fmaxf(cm, dppf<0x112>(-3.0e38f, cm)); cm = fmaxf(cm, dppf<0x114>(-3.0e38f, cm)); cm = fmaxf(cm, dppf<0x118>(-3.0e38f, cm));
        {
            const float t0 = __builtin_bit_cast(float, __builtin_amdgcn_readlane(__builtin_bit_cast(int, cm), 15));
            const float t1 = __builtin_bit_cast(float, __builtin_amdgcn_readlane(__builtin_bit_cast(int, cm), 31));
            const float t2 = __builtin_bit_cast(float, __builtin_amdgcn_readlane(__builtin_bit_cast(int, cm), 47));
            const float pm = (q4 == 0) ? -3.0e38f : ((q4 == 1) ? t0 : ((q4 == 2) ? fmaxf(t0, t1) : fmaxf(fmaxf(t0, t1), t2)));
            cm = fmaxf(cm, pm);
        }
        const float Mj = fmaxf(mstate, cm);
        const float bL = __builtin_bit_cast(float, __builtin_amdgcn_readlane(__builtin_bit_cast(int, bcs), 63)), ML = __builtin_bit_cast(float, __builtin_amdgcn_readlane(__builtin_bit_cast(int, Mj), 63));
        const float w_inter = __expf(mstate - Mj);
        const float w_s = __expf(cval - ML);
        const float w_c = __expf(mstate - ML);
        const float floorj = __expf(-bcs - Mj);
        if (wid == 0) { carr[lane] = cval; Marr[lane] = Mj; wsarr[lane] = w_s; wiarr[lane] = w_inter; }
        {
            const float ksc = 0.08838834764831845f;
#pragma unroll
            for (int i = 0; i < 2; ++i) {
                *(LAS u32x4*)(lds + ML_Q + (srow + 32 * i) * ML_QROW + sch * 16) = rq[i];
                u32x4 u = rk[i];
                u.x = pk2(lo_bf(u.x) * ksc, hi_bf(u.x) * ksc); u.y = pk2(lo_bf(u.y) * ksc, hi_bf(u.y) * ksc);
                u.z = pk2(lo_bf(u.z) * ksc, hi_bf(u.z) * ksc); u.w = pk2(lo_bf(u.w) * ksc, hi_bf(u.w) * ksc);
                *(LAS u32x4*)(lds + ML_K + (srow + 32 * i) * ML_KROW + sch * 16) = u;
            }
#pragma unroll
            for (int i = 0; i < 4; ++i) *(LAS u32x4*)(lds + ML_V + (vrow + 16 * i) * ML_VROW + vch * 16) = rv[i];
        }
        __syncthreads();
#pragma unroll
        for (int ti = 0; ti < 2; ++ti) {
            const int idx = wid * 2 + ti, jt = idx >> 2, st = idx & 3;
            f32x4 s = (f32x4){0.f, 0.f, 0.f, 0.f};
            if (st <= jt) {
#pragma unroll
                for (int ks = 0; ks < 4; ++ks) {
                    const bf16x8 kf = *(LAS bf16x8*)(lds + ML_K + (st * 16 + l15) * ML_KROW + ks * 64 + q4 * 16);
                    const bf16x8 qf = *(LAS bf16x8*)(lds + ML_Q + (jt * 16 + l15) * ML_QROW + ks * 64 + q4 * 16);
                    s = __builtin_amdgcn_mfma_f32_16x16x32_bf16(kf, qf, s, 0, 0, 0);
                }
                const int j = jt * 16 + l15;
                const float Mv = Marr[j];
#pragma unroll
                for (int r = 0; r < 4; ++r) { const int sidx = st * 16 + 4 * q4 + r; s[r] = (sidx <= j) ? s[r] * __expf(carr[sidx] - Mv) : 0.f; }
            }
            const unsigned p01 = pk2(s[0], s[1]), p23 = pk2(s[2], s[3]);
            *(LAS u32x2*)(lds + ML_S + (jt * 16 + l15) * ML_SROW + (st * 16 + 4 * q4) * 2) = mk2(p01, p23);
            {
                float rs = (lo_bf(p01) + hi_bf(p01)) + (lo_bf(p23) + hi_bf(p23));
                rs += sx_(rs, 16); rs += sx_(rs, 32);
                if (q4 == 0) ((LAS float*)(lds + ML_SSP))[st * 64 + jt * 16 + l15] = rs;
            }
        }
        {
            const int row = tid >> 3, part = tid & 7;
            LAS unsigned char* qp = lds + ML_Q + row * ML_QROW + part * 32;
            const u32x4 u0 = *(LAS u32x4*)qp, u1 = *(LAS u32x4*)(qp + 16);
            LAS float* nv = nbuf + (t & 1) * 128 + part * 16;
            const f32x4 n0 = *(LAS f32x4*)nv, n1 = *(LAS f32x4*)(nv + 4), n2 = *(LAS f32x4*)(nv + 8), n3 = *(LAS f32x4*)(nv + 12);
            float a = lo_bf(u0.x) * n0[0] + hi_bf(u0.x) * n0[1] + lo_bf(u0.y) * n0[2] + hi_bf(u0.y) * n0[3] + lo_bf(u0.z) * n1[0] + hi_bf(u0.z) * n1[1] + lo_bf(u0.w) * n1[2] + hi_bf(u0.w) * n1[3]
                    + lo_bf(u1.x) * n2[0] + hi_bf(u1.x) * n2[1] + lo_bf(u1.y) * n2[2] + hi_bf(u1.y) * n2[3] + lo_bf(u1.z) * n3[0] + hi_bf(u1.z) * n3[1] + lo_bf(u1.w) * n3[2] + hi_bf(u1.w) * n3[3];
            a += dppf<0xB1>(0.f, a); a += dppf<0x4E>(0.f, a); a += dppf<0x141>(0.f, a);
            if (part == 0) ((LAS float*)(lds + ML_QN))[row] = a;
        }
        {
            const int dk = tid & 127, part = tid >> 7;
            float a = 0.f;
#pragma unroll
            for (int s2 = 0; s2 < 16; ++s2) a += wsarr[part * 16 + s2] * bf2f(*(LAS bf16_t*)(lds + ML_K + (part * 16 + s2) * ML_KROW + dk * 2));
            npart[part * 128 + dk] = a;
        }
        __syncthreads();
        if (tid < 128) nbuf[((t + 1) & 1) * 128 + tid] = w_c * nbuf[(t & 1) * 128 + tid] + (npart[tid] + npart[128 + tid]) + (npart[256 + tid] + npart[384 + tid]);
        float rden;
        {
            LAS float* ssp = (LAS float*)(lds + ML_SSP);
            const float ssum = (ssp[lane] + ssp[64 + lane]) + (ssp[128 + lane] + ssp[192 + lane]);
            const float den = ssum + w_inter * ((LAS float*)(lds + ML_QN))[lane];
            rden = __builtin_amdgcn_rcpf(fmaxf(fabsf(den), floorj));
        }
        f32x4 acc[4][2];
#pragma unroll
        for (int m = 0; m < 4; ++m) { acc[m][0] = (f32x4){0.f, 0.f, 0.f, 0.f}; acc[m][1] = acc[m][0]; }
#pragma unroll
        for (int tt = 0; tt < 4; ++tt) {
            bf16x8 cb[2];
#pragma unroll
            for (int nn = 0; nn < 2; ++nn) {
                union { bf16x8 v; unsigned u[4]; } cv;
                cv.u[0] = pk2(C[2 * tt][nn][0], C[2 * tt][nn][1]); cv.u[1] = pk2(C[2 * tt][nn][2], C[2 * tt][nn][3]);
                cv.u[2] = pk2(C[2 * tt + 1][nn][0], C[2 * tt + 1][nn][1]); cv.u[3] = pk2(C[2 * tt + 1][nn][2], C[2 * tt + 1][nn][3]);
                cb[nn] = cv.v;
            }
#pragma unroll
            for (int m = 0; m < 4; ++m) {
                LAS unsigned char* qp = lds + ML_Q + (m * 16 + l15) * ML_QROW + (32 * tt + 4 * q4) * 2;
                const u32x2 a0 = *(LAS u32x2*)qp, a1 = *(LAS u32x2*)(qp + 32);
                union { bf16x8 v; unsigned u[4]; } av; av.u[0] = a0.x; av.u[1] = a0.y; av.u[2] = a1.x; av.u[3] = a1.y;
                acc[m][0] = __builtin_amdgcn_mfma_f32_16x16x32_bf16(av.v, cb[0], acc[m][0], 0, 0, 0);
                acc[m][1] = __builtin_amdgcn_mfma_f32_16x16x32_bf16(av.v, cb[1], acc[m][1], 0, 0, 0);
            }
        }
#pragma unroll
        for (int m = 0; m < 4; ++m) {
            const f32x4 wi = *(LAS f32x4*)(wiarr + m * 16 + 4 * q4);
#pragma unroll
            for (int r = 0; r < 4; ++r) { acc[m][0][r] *= wi[r]; acc[m][1][r] *= wi[r]; }
        }
        bf16x8 vfr[2][2];
#pragma unroll
        for (int nn = 0; nn < 2; ++nn)
#pragma unroll
            for (int ks = 0; ks < 2; ++ks) {
                LAS unsigned char* vp2 = lds + ML_V + (32 * ks + 8 * q4 + (l15 >> 2)) * ML_VROW + ((2 * wid + nn) * 16 + (l15 & 3) * 4) * 2;
                const s16x4 v0 = __builtin_amdgcn_ds_read_tr16_b64_v4i16((LAS s16x4*)vp2);
                const s16x4 v1 = __builtin_amdgcn_ds_read_tr16_b64_v4i16((LAS s16x4*)(vp2 + 4 * ML_VROW));
                vfr[nn][ks] = (bf16x8){v0[0], v0[1], v0[2], v0[3], v1[0], v1[1], v1[2], v1[3]};
            }
#pragma unroll
        for (int m = 0; m < 4; ++m)
#pragma unroll
            for (int ks = 0; ks < 2; ++ks) {
                const bf16x8 sf = *(LAS bf16x8*)(lds + ML_S + (m * 16 + l15) * ML_SROW + ks * 64 + q4 * 16);
                acc[m][0] = __builtin_amdgcn_mfma_f32_16x16x32_bf16(sf, vfr[0][ks], acc[m][0], 0, 0, 0);
                acc[m][1] = __builtin_amdgcn_mfma_f32_16x16x32_bf16(sf, vfr[1][ks], acc[m][1], 0, 0, 0);
            }
        {
            LAS float* rdw = (LAS float*)(lds + ML_RD) + wid * 64;
            rdw[lane] = rden;
#pragma unroll
            for (int m = 0; m < 4; ++m) {
                const f32x4 rd = *(LAS f32x4*)(rdw + m * 16 + 4 * q4);
#pragma unroll
                for (int r = 0; r < 4; ++r) {
                    LAS bf16_t* hp = (LAS bf16_t*)(lds + ML_H + (m * 16 + 4 * q4 + r) * ML_HROW) + (2 * wid) * 16 + l15;
                    hp[0] = (bf16_t)(pk2(acc[m][0][r] * rd[r], 0.f) & 0xffffu);
                    hp[16] = (bf16_t)(pk2(acc[m][1][r] * rd[r], 0.f) & 0xffffu);
                }
            }
        }
        if (t + 1 < 36) issue(t + 1);
        {
            bf16x8 vw[2][2];
#pragma unroll
            for (int ks = 0; ks < 2; ++ks) {
                const f32x4 w0 = *(LAS f32x4*)(wsarr + 32 * ks + 8 * q4), w1 = *(LAS f32x4*)(wsarr + 32 * ks + 8 * q4 + 4);
#pragma unroll
                for (int nn = 0; nn < 2; ++nn) {
                    union { bf16x8 v; unsigned u[4]; } x; x.v = vfr[nn][ks];
                    x.u[0] = pk2(lo_bf(x.u[0]) * w0[0], hi_bf(x.u[0]) * w0[1]); x.u[1] = pk2(lo_bf(x.u[1]) * w0[2], hi_bf(x.u[1]) * w0[3]);
                    x.u[2] = pk2(lo_bf(x.u[2]) * w1[0], hi_bf(x.u[2]) * w1[1]); x.u[3] = pk2(lo_bf(x.u[3]) * w1[2], hi_bf(x.u[3]) * w1[3]);
                    vw[nn][ks] = x.v;
                }
            }
#pragma unroll
            for (int dk = 0; dk < 8; ++dk) {
                C[dk][0] *= w_c; C[dk][1] *= w_c;
#pragma unroll
                for (int ks = 0; ks < 2; ++ks) {
                    LAS unsigned char* kp2 = lds + ML_K + (32 * ks + 8 * q4 + (l15 >> 2)) * ML_KROW + (dk * 16 + (l15 & 3) * 4) * 2;
                    const s16x4 k0 = __builtin_amdgcn_ds_read_tr16_b64_v4i16((LAS s16x4*)kp2);
                    const s16x4 k1 = __builtin_amdgcn_ds_read_tr16_b64_v4i16((LAS s16x4*)(kp2 + 4 * ML_KROW));
                    const bf16x8 kf = {k0[0], k0[1], k0[2], k0[3], k1[0], k1[1], k1[2], k1[3]};
                    C[dk][0] = __builtin_amdgcn_mfma_f32_16x16x32_bf16(kf, vw[0][ks], C[dk][0], 0, 0, 0);
                    C[dk][1] = __builtin_amdgcn_mfma_f32_16x16x32_bf16(kf, vw[1][ks], C[dk][1], 0, 0, 0);
                }
            }
        }
        mstate = bL + ML;
        __syncthreads();
        {
            bf16_t* hb = (dir == 0 ? p->YB : p->HB);
#pragma unroll
            for (int i = 0; i < 4; ++i) {
                const int j = vrow + 16 * i;
                const u32x4 v = *(LAS u32x4*)(lds + ML_H + j * ML_HROW + vch * 16);
                *(u32x4*)(hb + grow_of(pb, j) * 1024 + hd * 256 + vch * 8) = v;
            }
        }
    }
}

__device__ __forceinline__ int vidx_to_r(int L, int i) { return L == 0 ? i : ((i >> 11) * SALL + CTXL + (i & 2047)); }
struct MlRow { u32x4 a[2], b2[2], ov; };
__device__ __forceinline__ void mlfin_load(CP p, int r, MlRow& R) {
    const int lane = ltid() & 63, col = lane * 16;
    R.a[0] = *(const u32x4*)(p->YB + (size_t)r * 1024 + col); R.a[1] = *(const u32x4*)(p->YB + (size_t)r * 1024 + col + 8);
    R.b2[0] = *(const u32x4*)(p->HB + (size_t)r * 1024 + col); R.b2[1] = *(const u32x4*)(p->HB + (size_t)r * 1024 + col + 8);
    R.ov = *(const u32x4*)(p->MO8 + (size_t)r * 1024 + col);
}
__device__ __forceinline__ void mlfin_finish(CP p, int L, int r, const MlRow& R, const float4 (&gn)[4]) {
    const int lane = ltid() & 63, col = lane * 16; (void)L;
    float v[16]; float ss = 0.f;
#pragma unroll
    for (int h = 0; h < 2; ++h) {
        const unsigned wa[4] = {R.a[h].x, R.a[h].y, R.a[h].z, R.a[h].w}, wb[4] = {R.b2[h].x, R.b2[h].y, R.b2[h].z, R.b2[h].w};
#pragma unroll
        for (int q = 0; q < 4; ++q) { v[8 * h + 2 * q] = lo_bf(wa[q]) + lo_bf(wb[q]); v[8 * h + 2 * q + 1] = hi_bf(wa[q]) + hi_bf(wb[q]); }
    }
#pragma unroll
    for (int j = 0; j < 16; ++j) ss += v[j] * v[j];
    ss += dppf<0xB1>(0.f, ss); ss += dppf<0x4E>(0.f, ss); ss += dppf<0x141>(0.f, ss); ss += dppf<0x140>(0.f, ss);
    const float rstd = rsqrtf(ss * (1.0f / 256.0f) + 1e-6f);
    const unsigned wo[4] = {R.ov.x, R.ov.y, R.ov.z, R.ov.w};
    unsigned ow[4];
#pragma unroll
    for (int q = 0; q < 4; ++q) {
        const float4 g = gn[q];
        const f32x2 q0 = __builtin_amdgcn_cvt_pk_f32_fp8((int)wo[q], false), q1 = __builtin_amdgcn_cvt_pk_f32_fp8((int)wo[q], true);
        const float y0 = v[4 * q] * rstd * g.x * sigmoidf_(q0[0]), y1 = v[4 * q + 1] * rstd * g.y * sigmoidf_(q0[1]), y2 = v[4 * q + 2] * rstd * g.z * sigmoidf_(q1[0]), y3 = v[4 * q + 3] * rstd * g.w * sigmoidf_(q1[1]);
        if (MERGE_F8) { int w8 = 0; w8 = __builtin_amdgcn_cvt_pk_fp8_f32(y0, y1, w8, false); w8 = __builtin_amdgcn_cvt_pk_fp8_f32(y2, y3, w8, true); ow[q] = (unsigned)w8; }
        else *(u32x2*)(p->YB + (size_t)r * 1024 + col + 4 * q) = mk2(pk2(y0, y1), pk2(y2, y3));
    }
    if (MERGE_F8) *(u32x4*)(p->YB8 + (size_t)r * 1024 + col) = mk4(ow[0], ow[1], ow[2], ow[3]);
}
__device__ __forceinline__ void phase_mlfinish(CP p, int L, int bid, int nb) {
    const int wid = ltid() >> 6;
    const int nv = (L == 0) ? p->G * SALL : p->G * SEQ, st = nb * 8;
    float4 gn[4];
#pragma unroll
    for (int hh = 0; hh < 4; ++hh) gn[hh] = *(const float4*)(p->ml_norm_g + L * 1024 + (ltid() & 63) * 16 + hh * 4);
    MlRow A, B;
    int i = bid * 8 + wid;
    if (i < nv) mlfin_load(p, vidx_to_r(L, i), A);
    while (i < nv) {
        const bool hb = i + st < nv;
        if (hb) mlfin_load(p, vidx_to_r(L, i + st), B);
        mlfin_finish(p, L, vidx_to_r(L, i), A, gn);
        if (!hb) break;
        const bool ha = i + 2 * st < nv;
        if (ha) mlfin_load(p, vidx_to_r(L, i + 2 * st), A);
        mlfin_finish(p, L, vidx_to_r(L, i + st), B, gn);
        if (!ha) break;
        i += 2 * st;
    }
}

constexpr int LSEG = 128, LNSEG = SALL / LSEG, LCTXSEG = CTXL / LSEG, LMT = LSEG / 16;
constexpr int LC_XA = 0, LC_ROW = 272, LC_UB = LC_XA + (LSEG + 4) * LC_ROW, LC_HB = LC_UB + LSEG * LC_ROW, LC_CW = LC_HB + LSEG * LC_ROW, LC_END = LC_CW + 5 * 128 * 4;
static_assert(LC_END <= 131072, "LRU LDS");
template <int D>
__device__ __forceinline__ void lru_scan16(float (&a)[LMT][4], float (&b)[LMT][4]) {
#pragma unroll
    for (int m = 0; m < LMT; ++m)
#pragma unroll
        for (int j = 0; j < 4; ++j) {
            float av = a[m][j], bv = b[m][j], ap, bp;
            if (D == 0) { ap = dppf<0x111>(1.0f, av); bp = dppf<0x111>(0.0f, bv); } else { ap = dppf<0x101>(1.0f, av); bp = dppf<0x101>(0.0f, bv); }
            bv = av * bp + bv; av = av * ap;
            if (D == 0) { ap = dppf<0x112>(1.0f, av); bp = dppf<0x112>(0.0f, bv); } else { ap = dppf<0x102>(1.0f, av); bp = dppf<0x102>(0.0f, bv); }
            bv = av * bp + bv; av = av * ap;
            if (D == 0) { ap = dppf<0x114>(1.0f, av); bp = dppf<0x114>(0.0f, bv); } else { ap = dppf<0x104>(1.0f, av); bp = dppf<0x104>(0.0f, bv); }
            bv = av * bp + bv; av = av * ap;
            if (D == 0) { ap = dppf<0x118>(1.0f, av); bp = dppf<0x118>(0.0f, bv); } else { ap = dppf<0x108>(1.0f, av); bp = dppf<0x108>(0.0f, bv); }
            bv = av * bp + bv; av = av * ap;
            a[m][j] = av; b[m][j] = bv;
        }
}
template <int D>
__device__ __forceinline__ void lru_chain_dir(CP p, int L, LAS unsigned char* lds, int bl, int hb) {
    const int tid = ltid(), lane = tid & 63, wid = tid >> 6, q4 = lane >> 4, l15 = lane & 15;
    const size_t rowbase = (size_t)bl * SALL;
    LAS float* cwl = (LAS float*)(lds + LC_CW);
    __syncthreads();
    for (int e = tid; e < 5 * 128; e += NTHREADS) { const int j = e >> 7, ch = e & 127; cwl[e] = (j < 4) ? p->conv_w[((size_t)L * 4 + j) * 1024 + hb * 128 + ch] : p->conv_b[L * 1024 + hb * 128 + ch]; }
    bf16x8 wf[2][4];
    {
        const int cq = wid >> 1, n0 = wid & 1;
        const bf16_t* wb = p->bt_lru + ((size_t)(D * 8 + hb) * 256 + cq * 64 + n0 * 16 + l15) * 128 + q4 * 8;
#pragma unroll
        for (int g = 0; g < 2; ++g)
#pragma unroll
            for (int ks = 0; ks < 4; ++ks) wf[g][ks] = *(const bf16x8*)(wb + (size_t)g * 32 * 128 + ks * 32);
    }
    const int chb = wid * 16 + 4 * q4, gch = hb * 128 + chb;
    const f32x4 ba = *(const f32x4*)(p->lru_ba + (L * 2 + D) * 1024 + gch), bx = *(const f32x4*)(p->lru_bx + (L * 2 + D) * 1024 + gch);
    f32x4 sp;
    { const f32x4 lam = *(const f32x4*)(p->lru_lam + (L * 2 + D) * 1024 + gch);
#pragma unroll
      for (int j = 0; j < 4; ++j) { const float z = -lam[j]; sp[j] = -8.0f * (fmaxf(z, 0.f) + log1pf(__expf(-fabsf(z)))); } }
    float carry[4] = {0.f, 0.f, 0.f, 0.f};
    const int t = tid >> 3, c8 = tid & 7;
    const bf16_t* pbase = p->P + rowbase * PWID + PC_XA + hb * 128;
    bf16_t* obase = (D == 0 ? p->YA : p->HB2) + rowbase * 1024 + hb * 128;
    u32x4 x0[2], x1[2], h0, h1;
    auto seg_of = [&](int s) -> int { return D == 0 ? s : (s < LCTXSEG ? LCTXSEG - 1 - s : LNSEG + LCTXSEG - 1 - s); };
    auto issue = [&](int s) {
        const int seg = seg_of(s), pb = seg * LSEG, lo = (seg < LCTXSEG) ? 0 : CTXL, hi = (seg < LCTXSEG) ? CTXL : SALL;
        const int tid = ltid(), t = tid >> 3, c8 = tid & 7;
#pragma unroll
        for (int i = 0; i < 2; ++i) { const bf16_t* xr = (const bf16_t*)((const char*)pbase + (unsigned)(((pb + t + 64 * i) * PWID + c8 * 16) * 2)); x0[i] = *(const u32x4*)xr; x1[i] = *(const u32x4*)(xr + 8); }
        h0 = mk4(0u, 0u, 0u, 0u); h1 = h0;
        if (tid < 24) {
            const int pos = (t < 2) ? (pb - 2 + t) : (pb + LSEG);
            if (pos >= lo && pos < hi) { const bf16_t* hr = (const bf16_t*)((const char*)pbase + (unsigned)((pos * PWID + c8 * 16) * 2)); h0 = *(const u32x4*)hr; h1 = *(const u32x4*)(hr + 8); }
        }
    };
    issue(0);
    for (int s = 0; s < LNSEG; ++s) {
        const int seg = seg_of(s), pb = seg * LSEG;
#pragma unroll
        for (int i = 0; i < 2; ++i) { *(LAS u32x4*)(lds + LC_XA + (t + 64 * i + 2) * LC_ROW + c8 * 32) = x0[i]; *(LAS u32x4*)(lds + LC_XA + (t + 64 * i + 2) * LC_ROW + c8 * 32 + 16) = x1[i]; }
        if (tid < 24) { const int lr = (t < 2) ? t : (LSEG + 2); *(LAS u32x4*)(lds + LC_XA + lr * LC_ROW + c8 * 32) = h0; *(LAS u32x4*)(lds + LC_XA + lr * LC_ROW + c8 * 32 + 16) = h1; }
        if (s + 1 < LNSEG) issue(s + 1);
        __syncthreads();
        {
            const int cg = tid & 31, r0c = (tid >> 5) * 8;
            f32x4 cwr[5];
#pragma unroll
            for (int j = 0; j < 5; ++j) cwr[j] = *(LAS f32x4*)(cwl + j * 128 + cg * 4);
            float xw[4][4];
#pragma unroll
            for (int k = 0; k < 3; ++k) { const u32x2 a = *(LAS u32x2*)(lds + LC_XA + (r0c + k) * LC_ROW + cg * 8); xw[k][0] = lo_bf(a.x); xw[k][1] = hi_bf(a.x); xw[k][2] = lo_bf(a.y); xw[k][3] = hi_bf(a.y); }
#pragma unroll
            for (int k = 0; k < 8; ++k) {
                { const u32x2 a = *(LAS u32x2*)(lds + LC_XA + (r0c + k + 3) * LC_ROW + cg * 8); xw[(k + 3) & 3][0] = lo_bf(a.x); xw[(k + 3) & 3][1] = hi_bf(a.x); xw[(k + 3) & 3][2] = lo_bf(a.y); xw[(k + 3) & 3][3] = hi_bf(a.y); }
                float u[4];
#pragma unroll
                for (int i = 0; i < 4; ++i) u[i] = cwr[4][i] + cwr[0][i] * xw[k & 3][i] + cwr[1][i] * xw[(k + 1) & 3][i] + cwr[2][i] * xw[(k + 2) & 3][i] + cwr[3][i] * xw[(k + 3) & 3][i];
                *(LAS u32x2*)(lds + LC_UB + (r0c + k) * LC_ROW + cg * 8) = mk2(pk2(u[0], u[1]), pk2(u[2], u[3]));
            }
        }
        __syncthreads();
        float a[LMT][4], b[LMT][4];
#pragma unroll
        for (int m = 0; m < LMT; ++m) {
            f32x4 acc0 = (f32x4){0.f, 0.f, 0.f, 0.f}, acc1 = acc0;
#pragma unroll
            for (int ks = 0; ks < 4; ++ks) {
                const bf16x8 uu = *(LAS bf16x8*)(lds + LC_UB + (m * 16 + l15) * LC_ROW + ks * 64 + q4 * 16);
                acc0 = __builtin_amdgcn_mfma_f32_16x16x32_bf16(wf[0][ks], uu, acc0, 0, 0, 0);
                acc1 = __builtin_amdgcn_mfma_f32_16x16x32_bf16(wf[1][ks], uu, acc1, 0, 0, 0);
            }
            const u32x2 uv = *(LAS u32x2*)(lds + LC_UB + (m * 16 + l15) * LC_ROW + chb * 2);
            const float uf4[4] = {lo_bf(uv.x), hi_bf(uv.x), lo_bf(uv.y), hi_bf(uv.y)};
#pragma unroll
            for (int j = 0; j < 4; ++j) {
                const float rr = __builtin_amdgcn_rcpf(1.0f + __expf(-(acc0[j] + ba[j]))), ii = __builtin_amdgcn_rcpf(1.0f + __expf(-(acc1[j] + bx[j])));
                const float av = __expf(rr * sp[j]);
                a[m][j] = av; b[m][j] = __builtin_amdgcn_sqrtf(fmaxf(1.0f - av * av, 0.f)) * ii * uf4[j];
            }
        }
        lru_scan16<D>(a, b);
#pragma unroll
        for (int j = 0; j < 4; ++j) {
            float h = carry[j];
#pragma unroll
            for (int mi = 0; mi < LMT; ++mi) {
                const int m = (D == 0) ? mi : LMT - 1 - mi;
                const float hv = a[m][j] * h + b[m][j];
                b[m][j] = hv;
                h = (D == 0) ? dppf<0x15F>(0.f, hv) : dppf<0x150>(0.f, hv);
            }
            carry[j] = h;
        }
#pragma unroll
        for (int m = 0; m < LMT; ++m) *(LAS u32x2*)(lds + LC_HB + (m * 16 + l15) * LC_ROW + chb * 2) = mk2(pk2(b[m][0], b[m][1]), pk2(b[m][2], b[m][3]));
        __syncthreads();
#pragma unroll
        for (int i = 0; i < 2; ++i) {
            const int r = t + 64 * i;
            bf16_t* dst = (bf16_t*)((char*)obase + (unsigned)(((pb + r) * 1024 + c8 * 16) * 2));
            *(u32x4*)dst = *(LAS u32x4*)(lds + LC_HB + r * LC_ROW + c8 * 32); *(u32x4*)(dst + 8) = *(LAS u32x4*)(lds + LC_HB + r * LC_ROW + c8 * 32 + 16);
        }
    }
}
__device__ __forceinline__ void lru_chain_unit(CP p, int L, LAS unsigned char* lds, int bl, int hb, int d) {
    if (d == 0) lru_chain_dir<0>(p, L, lds, bl, hb); else lru_chain_dir<1>(p, L, lds, bl, hb);
}
__device__ __forceinline__ void phase_lrufinish(CP p, int L, int bid, int nb) {
    const int tid = ltid();
    const int nv = (L == 0) ? p->G * SALL : p->G * SEQ;
    const long total = (long)nv * 128, stride = (long)nb * NTHREADS;
    for (long e0 = (long)bid * NTHREADS + tid; e0 < total; e0 += 2 * stride) {
        u32x4 hf[2], hb[2], ga[2]; size_t off[2]; bool ok[2];
#pragma unroll
        for (int k = 0; k < 2; ++k) {
            const long e = e0 + k * stride; ok[k] = e < total;
            const int i = (int)((ok[k] ? e : e0) >> 7), c = (int)((ok[k] ? e : e0) & 127) * 8;
            const int r = (L == 0) ? i : ((i >> 11) * SALL + CTXL + (i & 2047));
            off[k] = (size_t)r * 1024 + c;
            hf[k] = *(const u32x4*)(p->YA + off[k]); hb[k] = *(const u32x4*)(p->HB2 + off[k]); ga[k] = *(const u32x4*)(p->P + (size_t)r * PWID + PC_GA + c);
        }
#pragma unroll
        for (int k = 0; k < 2; ++k) {
            if (!ok[k]) continue;
            u32x4 o;
            o.x = pk2(gelu_tanh(lo_bf(ga[k].x)) * (lo_bf(hf[k].x) + lo_bf(hb[k].x)), gelu_tanh(hi_bf(ga[k].x)) * (hi_bf(hf[k].x) + hi_bf(hb[k].x)));
            o.y = pk2(gelu_tanh(lo_bf(ga[k].y)) * (lo_bf(hf[k].y) + lo_bf(hb[k].y)), gelu_tanh(hi_bf(ga[k].y)) * (hi_bf(hf[k].y) + hi_bf(hb[k].y)));
            o.z = pk2(gelu_tanh(lo_bf(ga[k].z)) * (lo_bf(hf[k].z) + lo_bf(hb[k].z)), gelu_tanh(hi_bf(ga[k].z)) * (hi_bf(hf[k].z) + hi_bf(hb[k].z)));
            o.w = pk2(gelu_tanh(lo_bf(ga[k].w)) * (lo_bf(hf[k].w) + lo_bf(hb[k].w)), gelu_tanh(hi_bf(ga[k].w)) * (hi_bf(hf[k].w) + hi_bf(hb[k].w)));
            *(u32x4*)(p->YA + off[k]) = o;
        }
    }
}

__device__ __forceinline__ int next_unit(unsigned* ctr, LAS unsigned char* lds) {
    LAS int* slot = (LAS int*)(lds + LDS_BYTES - 32);
    __syncthreads();
    if (ltid() == 0) *slot = (int)__hip_atomic_fetch_add(ctr, 1u, __ATOMIC_RELAXED, __HIP_MEMORY_SCOPE_AGENT);
    __syncthreads();
    return __builtin_amdgcn_readfirstlane(*slot);
}
__device__ __forceinline__ void phase_probe_at(CP p, int L, LAS unsigned char* lds, int bid, int nb) {
    const int nqt = (L == 0) ? 9 : 8, nat = p->G * 8 * nqt;
    for (int u = bid; u < nat; u += nb) { const int qt = u % nqt, bh = u / nqt; attn_unit2(p, L, lds, bh >> 3, bh & 7, qt); }
}
__device__ __forceinline__ void phase_probe_lru(CP p, int L, LAS unsigned char* lds, int bid, int nb) {
    for (int v = bid; v < p->G * 16; v += nb) lru_chain_unit(p, L, lds, v >> 4, (v >> 1) & 7, v & 1);
}
__device__ __forceinline__ void phase_probe_ml(CP p, int L, LAS unsigned char* lds, int bid, int nb) {
    for (int u = bid; u < p->G * 8; u += nb) mlstm_unit(p, L, lds, u >> 3, (u >> 1) & 3, u & 1);
}
__device__ __forceinline__ unsigned xb_xcc_id_early() { return (unsigned)__builtin_amdgcn_s_getreg((3 << 11) | 20) & 0xFu; }
__device__ __forceinline__ void phase_mix_dyn(CP p, int L, int grp, LAS unsigned char* lds, int cofs = 0) {
    (void)cofs;
    unsigned* ctr = (unsigned*)p->ecnt + 128 + (L * 8 + grp) * 8;
    const int nct = (L == 0) ? 8 : 0, nq = 8 + 16 + 64 + nct;
    const int G8 = p->G;
    const int qml = G8, qlr = 2 * G8, qat = 8 * G8, qct = (L == 0) ? G8 : 0, qn0 = qml + qlr + qat + qct;
    int Ln = L, gn = grp + 1;
    if (gn >= p->ngroups) { Ln = L + 1; gn = 0; }
    const int npre = (Ln < 2) ? (p->G * SALL / 64) : 0, qpn = npre / 8, qn = qn0 + qpn;
    (void)nq; (void)nct;
    const int x0 = (int)(xb_xcc_id_early() & 7u);
    for (int k = 0; k < 8; ++k) {
        const int q = (x0 + k) & 7;
        for (;;) {
            const int j = next_unit(ctr + q, lds);
            if (j >= qn) break;
            if (j < qml) { const int u = j * 8 + q; mlstm_unit(p, L, lds, u >> 3, (u >> 1) & 3, u & 1); }
            else if (j < qml + qlr) { const int v = (j - qml) * 8 + q; lru_chain_unit(p, L, lds, v >> 4, (v >> 1) & 7, v & 1); }
            else if (j < qml + qlr + qat) { const int a = j - qml - qlr, bh = (a >> 3) * 8 + q; attn_unit2(p, L, lds, bh >> 3, bh & 7, a & 7); }
            else if (j < qn0) { const int bh = (j - qml - qlr - qat) * 8 + q; attn_unit2(p, L, lds, bh >> 3, bh & 7, 8); }
            else phase_prenorm(p, Ln, gn, (j - qn0) * 8 + q, npre);
        }
    }
}
__device__ __forceinline__ bf16_t* xrow_ptr(CP p, int grp, int r, int L, const float*& md) {
    const int bl = r / SALL, pos = r - bl * SALL, b = grp * p->G + bl;
    if (pos < CTXL) { md = p->mods_c + (size_t)L * 6144; return p->XC1 + ((size_t)b * CTXL + pos) * 1024; }
    md = p->mods_l + ((size_t)L * 32 + b) * 6144; return p->XB + ((size_t)b * SEQ + (pos - CTXL)) * 1024;
}
constexpr int RCH = 32, RPICK = RCH * 6;
constexpr int RT_H = 0, RT_HROW = 1028, RT_PART = 16 * RT_HROW * 4, RT_PICK = RT_PART + 8 * 16 * 64 * 4, RT_END = RT_PICK + RPICK * 12;
__device__ __forceinline__ void split_bf(float a0, float a1, unsigned& hi, unsigned& lo) { hi = pk2(a0, a1); lo = pk2(a0 - lo_bf(hi), a1 - hi_bf(hi)); }
__device__ __forceinline__ void phase_route1(CP p, int L, int grp, LAS unsigned char* lds, int bid, int nb) {
    const int tid = ltid(), lane = tid & 63, wid = __builtin_amdgcn_readfirstlane(tid >> 6), q4 = lane >> 4, l15 = lane & 15;
    LAS float* hs = (LAS float*)(lds + RT_H);
    LAS float* part = (LAS float*)(lds + RT_PART);
    LAS int* pick_e = (LAS int*)(lds + RT_PICK);
    LAS float* pick_w = (LAS float*)(pick_e + RPICK);
    LAS int* pick_r = (LAS int*)(pick_e + 2 * RPICK);
    const float* g2 = p->norm2_g + L * 1024;
    const float brv = p->b_router[L * 64 + lane];
    const float* wr = p->w_router + (size_t)L * 1024 * 64;
    const int nchunks = p->G * SALL / RCH;
    bf16x8 whi[4][4], wlo[4][4];
#pragma unroll
    for (int ks = 0; ks < 4; ++ks)
#pragma unroll
        for (int n = 0; n < 4; ++n) { unsigned h[4], l[4];
#pragma unroll
            for (int jj = 0; jj < 4; ++jj) { const float* wp = wr + (size_t)(wid * 128 + ks * 32 + q4 * 8 + 2 * jj) * 64 + n * 16 + l15; split_bf(wp[0], wp[64], h[jj], l[jj]); }
            whi[ks][n] = __builtin_bit_cast(bf16x8, mk4(h[0], h[1], h[2], h[3])); wlo[ks][n] = __builtin_bit_cast(bf16x8, mk4(l[0], l[1], l[2], l[3])); }
    const int cpb = SALL / RCH, cctx = CTXL / RCH;
#define RT_NEXT_VALID(cv) do { while ((cv) < nchunks && L == 1 && ((cv) % cpb) < cctx) { const int t_ = ltid(); if (t_ < 64) p->CC[(cv) * 64 + t_] = 0; (cv) += nb; } } while (0)
#define RT_LOAD(rbase) do { _Pragma("unroll") for (int rr = 0; rr < 2; ++rr) { const float* md_; const bf16_t* src_ = xrow_ptr(p, grp, (rbase) + rr, L, md_); \
        _Pragma("unroll") for (int i = 0; i < 4; ++i) vb[rr][i] = *(const u32x2*)(src_ + i * 256 + lane * 4); } } while (0)
    int chunk = bid; RT_NEXT_VALID(chunk);
    u32x2 vb[2][4];
    if (chunk < nchunks) RT_LOAD(chunk * RCH + wid * 2);
    while (chunk < nchunks) {
        int nchunk = chunk + nb; RT_NEXT_VALID(nchunk);
#pragma nounroll
        for (int sub = 0; sub < RCH / 16; ++sub) {
            const int r0 = chunk * RCH + sub * 16;
            __syncthreads();
            {
                float ss[2] = {0.f, 0.f};
                float4 v[2][4];
#pragma unroll
                for (int rr = 0; rr < 2; ++rr)
#pragma unroll
                    for (int i = 0; i < 4; ++i) { v[rr][i] = make_float4(lo_bf(vb[rr][i].x), hi_bf(vb[rr][i].x), lo_bf(vb[rr][i].y), hi_bf(vb[rr][i].y));
                        ss[rr] += v[rr][i].x * v[rr][i].x + v[rr][i].y * v[rr][i].y + v[rr][i].z * v[rr][i].z + v[rr][i].w * v[rr][i].w; }
#pragma unroll
                for (int o = 32; o >= 1; o >>= 1) { ss[0] += sx_(ss[0], o); ss[1] += sx_(ss[1], o); }
#pragma unroll
                for (int rr = 0; rr < 2; ++rr) {
                    const int tl = wid * 2 + rr, r = r0 + tl;
                    const float* md; (void)xrow_ptr(p, grp, r, L, md);
                    const float rstd = rsqrtf(ss[rr] * (1.0f / 1024.0f) + 1e-6f);
#pragma unroll
                    for (int i = 0; i < 4; ++i) {
                        const int col = i * 256 + lane * 4;
                        const float4 g = *(const float4*)(g2 + col), sh = *(const float4*)(md + 3072 + col), sc = *(const float4*)(md + 4096 + col);
                        const float o0 = v[rr][i].x * rstd * g.x * (1.f + sc.x) + sh.x, o1 = v[rr][i].y * rstd * g.y * (1.f + sc.y) + sh.y;
                        const float o2 = v[rr][i].z * rstd * g.z * (1.f + sc.z) + sh.z, o3 = v[rr][i].w * rstd * g.w * (1.f + sc.w) + sh.w;
                        { int w8 = 0; w8 = __builtin_amdgcn_cvt_pk_fp8_f32(o0, o1, w8, false); w8 = __builtin_amdgcn_cvt_pk_fp8_f32(o2, o3, w8, true); *(unsigned*)((unsigned char*)p->H2 + (size_t)r * 1024 + col) = (unsigned)w8; }
                        *(LAS f32x4*)(hs + tl * RT_HROW + col) = (f32x4){o0, o1, o2, o3};
                    }
                }
                if (sub == 0) RT_LOAD(r0 + 16 + wid * 2); else if (nchunk < nchunks) RT_LOAD(nchunk * RCH + wid * 2);
            }
            __syncthreads();
            {
                f32x4 lg[4];
#pragma unroll
                for (int n = 0; n < 4; ++n) lg[n] = (f32x4){0.f, 0.f, 0.f, 0.f};
#pragma unroll
                for (int ks = 0; ks < 4; ++ks) {
                    const LAS float* hp = hs + l15 * RT_HROW + wid * 128 + ks * 32 + q4 * 8;
                    const f32x4 x0 = *(const LAS f32x4*)hp, x1 = *(const LAS f32x4*)(hp + 4);
                    unsigned h[4], l[4];
                    split_bf(x0[0], x0[1], h[0], l[0]); split_bf(x0[2], x0[3], h[1], l[1]); split_bf(x1[0], x1[1], h[2], l[2]); split_bf(x1[2], x1[3], h[3], l[3]);
                    const bf16x8 ah = __builtin_bit_cast(bf16x8, mk4(h[0], h[1], h[2], h[3])), al = __builtin_bit_cast(bf16x8, mk4(l[0], l[1], l[2], l[3]));
#pragma unroll
                    for (int n = 0; n < 4; ++n) {
                        lg[n] = __builtin_amdgcn_mfma_f32_16x16x32_bf16(al, whi[ks][n], lg[n], 0, 0, 0);
                        lg[n] = __builtin_amdgcn_mfma_f32_16x16x32_bf16(ah, wlo[ks][n], lg[n], 0, 0, 0);
                        lg[n] = __builtin_amdgcn_mfma_f32_16x16x32_bf16(ah, whi[ks][n], lg[n], 0, 0, 0);
                    }
                }
#pragma unroll
                for (int n = 0; n < 4; ++n)
#pragma unroll
                    for (int r = 0; r < 4; ++r) part[(wid * 16 + 4 * q4 + r) * 64 + n * 16 + l15] = lg[n][r];
            }
            __syncthreads();
            {
                float score[2], sel[2], ssum[2] = {0.f, 0.f}; int myrank[2] = {-1, -1};
#pragma unroll
                for (int rr = 0; rr < 2; ++rr) {
                    const int tl = wid * 2 + rr; float lgt = 0.f;
#pragma unroll
                    for (int w8 = 0; w8 < 8; ++w8) lgt += part[(w8 * 16 + tl) * 64 + lane];
                    score[rr] = 1.0f / (1.0f + expf(-lgt)); sel[rr] = score[rr] + brv;
                }
#pragma unroll
                for (int k = 0; k < TOPK; ++k) {
#pragma unroll
                    for (int rr = 0; rr < 2; ++rr) {
                        float mv = sel[rr];
                        mv = fmaxf(mv, dppf<0x111>(-3.0e38f, mv)); mv = fmaxf(mv, dppf<0x112>(-3.0e38f, mv)); mv = fmaxf(mv, dppf<0x114>(-3.0e38f, mv)); mv = fmaxf(mv, dppf<0x118>(-3.0e38f, mv));
                        const float m0 = __builtin_bit_cast(float, __builtin_amdgcn_readlane(__builtin_bit_cast(int, mv), 15)), m1 = __builtin_bit_cast(float, __builtin_amdgcn_readlane(__builtin_bit_cast(int, mv), 31));
                        const float m2 = __builtin_bit_cast(float, __builtin_amdgcn_readlane(__builtin_bit_cast(int, mv), 47)), m3 = __builtin_bit_cast(float, __builtin_amdgcn_readlane(__builtin_bit_cast(int, mv), 63));
                        const float wm = fmaxf(fmaxf(m0, m1), fmaxf(m2, m3));
                        const unsigned long long bal = __ballot(sel[rr] == wm);
                        const int win = __ffsll((long long)bal) - 1;
                        ssum[rr] += __builtin_bit_cast(float, __builtin_amdgcn_readlane(__builtin_bit_cast(int, score[rr]), win));
                        if (lane == win) { myrank[rr] = k; sel[rr] = -1e30f; }
                    }
                }
#pragma unroll
                for (int rr = 0; rr < 2; ++rr)
                    if (myrank[rr] >= 0) { const int slot = (sub * 16 + wid * 2 + rr) * 6 + myrank[rr]; pick_e[slot] = lane; pick_w[slot] = score[rr] / ssum[rr] * 2.5f; }
            }
        }
        __syncthreads();
        {
            const int lane = ltid() & 63;
            const int e0 = pick_e[lane], e1 = pick_e[64 + lane], e2 = pick_e[128 + lane];
            int rk0 = 0, rk1 = 0, rk2 = 0, mycnt = 0;
#pragma unroll
            for (int x = 0; x < 8; ++x) {
                const int ex = wid * 8 + x;
                const unsigned long long m0 = __ballot(e0 == ex), m1 = __ballot(e1 == ex), m2 = __ballot(e2 == ex);
                const int c0 = __builtin_popcountll(m0), c1 = __builtin_popcountll(m1), c2 = __builtin_popcountll(m2);
                if (e0 == ex) rk0 = __builtin_amdgcn_mbcnt_hi((unsigned)(m0 >> 32), __builtin_amdgcn_mbcnt_lo((unsigned)m0, 0));
                if (e1 == ex) rk1 = c0 + __builtin_amdgcn_mbcnt_hi((unsigned)(m1 >> 32), __builtin_amdgcn_mbcnt_lo((unsigned)m1, 0));
                if (e2 == ex) rk2 = c0 + c1 + __builtin_amdgcn_mbcnt_hi((unsigned)(m2 >> 32), __builtin_amdgcn_mbcnt_lo((unsigned)m2, 0));
                if (lane == x) mycnt = c0 + c1 + c2;
            }
            if ((e0 >> 3) == wid) pick_r[lane] = rk0;
            if ((e1 >> 3) == wid) pick_r[64 + lane] = rk1;
            if ((e2 >> 3) == wid) pick_r[128 + lane] = rk2;
            if (lane < 8) p->CC[chunk * 64 + wid * 8 + lane] = mycnt;
        }
        __syncthreads();
        { const int s2 = ltid(); if (s2 < RPICK) { p->PE[(size_t)chunk * RPICK + s2] = pick_e[s2] | (pick_r[s2] << 8); p->PW[(size_t)chunk * RPICK + s2] = pick_w[s2]; } }
        chunk = nchunk;
    }
#undef RT_NEXT_VALID
#undef RT_LOAD
}
__device__ __forceinline__ void phase_route2(CP p, int L, LAS unsigned char* lds, int bid, int nb) {
    const int tid = ltid();
    LAS int* basel = (LAS int*)lds; LAS int* totl = basel + 256; LAS int* tabl = totl + 64; LAS int* pb = tabl + 128; LAS int* pt = pb + 4 * 512;
    const int nchunks = p->G * SALL / RCH;
    const int e = tid & 63, part = tid >> 6, per = (nchunks + 7) >> 3;
    __syncthreads();
    {
        int t = 0, b0 = 0, b1 = 0, b2 = 0, b3 = 0;
        const int k0 = bid, k1 = bid + nb, k2 = bid + 2 * nb, k3 = bid + 3 * nb;
        const int c0 = part * per, c1 = (c0 + per < nchunks) ? c0 + per : nchunks;
#pragma unroll 12
        for (int c = c0; c < c1; ++c) { const int v = p->CC[c * 64 + e]; t += v; b0 += (c < k0) ? v : 0; b1 += (c < k1) ? v : 0; b2 += (c < k2) ? v : 0; b3 += (c < k3) ? v : 0; }
        pt[part * 64 + e] = t; pb[part * 64 + e] = b0; pb[512 + part * 64 + e] = b1; pb[1024 + part * 64 + e] = b2; pb[1536 + part * 64 + e] = b3;
    }
    __syncthreads();
    if (tid < 64) {
        int t = 0, b[4] = {0, 0, 0, 0};
#pragma unroll
        for (int q = 0; q < 8; ++q) { t += pt[q * 64 + tid];
#pragma unroll
            for (int k = 0; k < 4; ++k) b[k] += pb[k * 512 + q * 64 + tid]; }
        totl[tid] = t;
#pragma unroll
        for (int k = 0; k < 4; ++k) basel[k * 64 + tid] = b[k];
        if (bid == 0) p->ecnt[tid] = t;
    }
    __syncthreads();
    if (tid == 0) { int acc = 0; for (int x = 0; x < 64; ++x) { tabl[x] = acc; acc += (totl[x] + 255) >> 8; } tabl[64] = acc; }
    __syncthreads();
    if (bid == 0) {
        const int dummy = (L == 0) ? 0 : CTXL;
        for (int x = tid; x < 64 * 256; x += NTHREADS) { const int ee = x >> 8, i = totl[ee] + (x & 255); if (i < (((totl[ee] + 255) >> 8) << 8)) { p->LIST[(size_t)tabl[ee] * 256 + i] = dummy; p->LISTW[(size_t)tabl[ee] * 256 + i] = 0.f; } }
    }
    {
        const int nv = (L == 0) ? p->G * SALL : p->G * SEQ; int* idl = p->LIST + (size_t)tabl[64] * 256;
        for (int i = bid * NTHREADS + tid; i < nv; i += nb * NTHREADS) idl[i] = vidx_to_r(L, i);
    }
    int kq = 0;
    for (int chunk = bid; chunk < nchunks; chunk += nb, ++kq) {
        if (L == 1 && (chunk % (SALL / RCH)) < (CTXL / RCH)) continue;
        for (int s2 = tid; s2 < RPICK; s2 += NTHREADS) {
            const int pe = p->PE[(size_t)chunk * RPICK + s2], ee = pe & 255, lr = pe >> 8;
            const int r = chunk * RCH + s2 / 6, pos = tabl[ee] * 256 + basel[kq * 64 + ee] + lr;
            p->LIST[pos] = r; p->LISTW[pos] = p->PW[(size_t)chunk * RPICK + s2];
            p->POS[(size_t)chunk * RPICK + s2] = pos;
        }
    }
}

constexpr int MOE_TAB = 131072;
__device__ __forceinline__ int moe_nshared(CP p, int L) { return L == 0 ? p->G * SALL : p->G * SEQ; }
__device__ __forceinline__ int moe_find(LAS int* tab, int tile) { int e = 0; for (int s = 64; s >= 1; s >>= 1) if (e + s <= 64 && tab[e + s] <= tile) e += s; return e; }
__device__ __forceinline__ void moe_table8(CP p, int L, LAS unsigned char* lds) {
    LAS int* tab = (LAS int*)(lds + MOE_TAB);
    __syncthreads();
    if (ltid() == 0) {
        int acc = 0;
        for (int e = 0; e < 65; ++e) { tab[e] = acc; const int c = (e < 64) ? p->ecnt[e] : moe_nshared(p, L); acc += (c + 255) >> 8; }
        tab[65] = acc;
    }
    __syncthreads();
}
__device__ __forceinline__ void phase_moe_combine(CP p, int L, int grp, LAS unsigned char* lds, int bid, int nb) {
    const int lane = ltid() & 63, wid = ltid() >> 6;
    moe_table8(p, L, lds);
    LAS int* tab = (LAS int*)(lds + MOE_TAB);
    const int nv = moe_nshared(p, L);
    const size_t sbase = (size_t)tab[64] * 256;
    const unsigned char* D8 = (const unsigned char*)p->DBUF;
    for (int i = bid * 8 + wid; i < nv; i += nb * 8) {
        const int r = vidx_to_r(L, i);
        const float* md; bf16_t* xr = xrow_ptr(p, grp, r, L, md);
        const int bl_ = r / SALL, pos_ = r - bl_ * SALL;
        const bool fin = (L == 1) && pos_ >= CTXL;
        float* xo = p->out + ((size_t)(grp * p->G + bl_) * SEQ + (pos_ - CTXL)) * 1024;
        float a[16];
        u32x4 dv[7];
        int pos6[6];
#pragma unroll
        for (int k = 0; k < 6; ++k) pos6[k] = p->POS[(size_t)r * 6 + k];
        dv[0] = *(const u32x4*)(D8 + (sbase + i) * 1024 + lane * 16);
        f32x4 g4[4]; u32x4 xb[2];
        xb[0] = *(const u32x4*)(xr + lane * 16); xb[1] = *(const u32x4*)(xr + lane * 16 + 8);
#pragma unroll
        for (int q = 0; q < 4; ++q) g4[q] = *(const f32x4*)(md + 5120 + lane * 16 + q * 4);
#pragma unroll
        for (int k = 0; k < 6; ++k) dv[k + 1] = *(const u32x4*)(D8 + (size_t)pos6[k] * 1024 + lane * 16);
#pragma unroll
        for (int q = 0; q < 16; ++q) a[q] = 0.f;
#pragma unroll
        for (int k = 0; k < 7; ++k)
#pragma unroll
            for (int w = 0; w < 4; ++w) {
                const f32x2 lo = __builtin_amdgcn_cvt_pk_f32_fp8((int)dv[k][w], false), hi = __builtin_amdgcn_cvt_pk_f32_fp8((int)dv[k][w], true);
                a[4 * w] += lo[0]; a[4 * w + 1] += lo[1]; a[4 * w + 2] += hi[0]; a[4 * w + 3] += hi[1];
            }
        unsigned ow[8];
#pragma unroll
        for (int q = 0; q < 4; ++q) {
            const int col = lane * 16 + q * 4;
            const f32x4 g = g4[q];
            const unsigned w0 = (q & 1) ? xb[q >> 1].z : xb[q >> 1].x, w1 = (q & 1) ? xb[q >> 1].w : xb[q >> 1].y;
            f32x4 xv = {lo_bf(w0), hi_bf(w0), lo_bf(w1), hi_bf(w1)};
            xv[0] += g[0] * a[4 * q] * D_ISCALE; xv[1] += g[1] * a[4 * q + 1] * D_ISCALE; xv[2] += g[2] * a[4 * q + 2] * D_ISCALE; xv[3] += g[3] * a[4 * q + 3] * D_ISCALE;
            if (fin) *(f32x4*)(xo + col) = xv;
            ow[2 * q] = pk2(xv[0], xv[1]); ow[2 * q + 1] = pk2(xv[2], xv[3]);
        }
        if (!fin) { *(u32x4*)(xr + lane * 16) = mk4(ow[0], ow[1], ow[2], ow[3]); *(u32x4*)(xr + lane * 16 + 8) = mk4(ow[4], ow[5], ow[6], ow[7]); }
    }
}

__device__ __forceinline__ int valid_tile(int L, int pmv) { return L == 0 ? pmv : ((pmv >> 3) * 9 + 1 + (pmv & 7)); }
struct SchedMerge { const char *Y, *B; size_t ystride; int nMv, L, G, c;
    __device__ __forceinline__ bool next(int i, pg8::Unit& u) const { int pmv, pn; if (!pg8::static_tile(i, G, c, nMv, 12, pmv, pn)) return false; const int pm = valid_tile(L, pmv), j = pn >> 2;
        u.pm = pm; u.pn = pn; u.tag = 0; u.rows = nullptr; u.a = Y + (size_t)j * ystride + (size_t)pm * 256 * 1024 * 2; u.b = B + (size_t)pn * 256 * 1024 * 2; return true; } };
struct SchedMerge8 { const char *YB8, *YC8, *B; int nMv, L, G, c;
    __device__ __forceinline__ bool next(int i, pg8::Unit& u) const { int pmv, q; if (!pg8::static_tile(i, G, c, nMv, 8, pmv, q)) return false; const int pm = valid_tile(L, pmv), pn = 4 + q, j = pn >> 2;
        u.pm = pm; u.pn = pn; u.tag = 0; u.rows = nullptr; u.a = (j == 1 ? YB8 : YC8) + (size_t)pm * 256 * 1024; u.b = B + (size_t)j * 1024 * 1024 * 2 + (size_t)(pn & 3) * 256 * 1024; return true; } };
struct SchedMerge0 { const char *Y, *B; int nMv, L, G, c;
    __device__ __forceinline__ bool next(int i, pg8::Unit& u) const { int pmv, pn; if (!pg8::static_tile(i, G, c, nMv, 4, pmv, pn)) return false; const int pm = valid_tile(L, pmv);
        u.pm = pm; u.pn = pn; u.tag = 0; u.rows = nullptr; u.a = Y + (size_t)pm * 256 * 1024 * 2; u.b = B + (size_t)pn * 256 * 1024 * 2; return true; } };
struct EpiBf16RowsS { static constexpr bool PERM = true; bf16_t* O; int ldo; float sc;
    __device__ __forceinline__ void operator()(const f32x4 (&acc)[2][2][4][2], const pg8::Unit& u, int wr, int wc, int fr, int fq) const {
        const size_t row0 = (size_t)u.pm * 256 + wr * 64 + fr;
#pragma unroll
        for (int ai = 0; ai < 2; ++ai)
#pragma unroll
            for (int m = 0; m < 4; ++m) { bf16_t* rowp = O + (row0 + ai * 128 + m * 16) * ldo + u.pn * 256 + wc * 32 + 8 * fq;
#pragma unroll
                for (int bj = 0; bj < 2; ++bj) { const f32x4 v0 = acc[ai][bj][m][0] * sc, v1 = acc[ai][bj][m][1] * sc;
                    *(u32x4*)(rowp + bj * 128) = mk4(pk2(v0[0], v0[1]), pk2(v0[2], v0[3]), pk2(v1[0], v1[1]), pk2(v1[2], v1[3])); } }
    } };
struct EpiBf16Rows { static constexpr int PERM = 2; bf16_t* O; int ldo;
    __device__ __forceinline__ void operator()(const f32x4 (&acc)[2][2][4][2], const pg8::Unit& u, int wr, int wc, int fr, int fq) const {
        const size_t row0 = (size_t)u.pm * 256 + wr * 64 + fr;
#pragma unroll
        for (int ai = 0; ai < 2; ++ai)
#pragma unroll
            for (int m = 0; m < 4; ++m) { bf16_t* rowp = O + (row0 + ai * 128 + m * 16) * ldo + u.pn * 256 + wc * 64 + 16 * fq;
#pragma unroll
                for (int bj = 0; bj < 2; ++bj) { const f32x4 v0 = acc[ai][bj][m][0], v1 = acc[ai][bj][m][1];
                    *(u32x4*)(rowp + bj * 8) = mk4(pk2(v0[0], v0[1]), pk2(v0[2], v0[3]), pk2(v1[0], v1[1]), pk2(v1[2], v1[3])); } }
    } };
template <int SCALED>
struct EpiFp8RowsT { static constexpr int PERM = 2; unsigned char* O; int ldo;
    __device__ __forceinline__ void operator()(const f32x4 (&acc)[2][2][4][2], const pg8::Unit& u, int wr, int wc, int fr, int fq) const {
        constexpr float SC = SCALED == 1 ? pg8::F8_WINV : (SCALED == 2 ? D_SCALE / (ACT_SC * DW_SC) : 1.0f);
        unsigned char* tb = O + ((size_t)u.pm * 256) * ldo + u.pn * 256;
        const unsigned lo0 = (unsigned)(wr * 64 + fr) * (unsigned)ldo + wc * 64 + 16 * fq;
#pragma unroll
        for (int ai = 0; ai < 2; ++ai)
#pragma unroll
            for (int m = 0; m < 4; ++m) { unsigned char* rowp = tb + (lo0 + (unsigned)(ai * 128 + m * 16) * (unsigned)ldo);
                unsigned w[4];
#pragma unroll
                for (int bj = 0; bj < 2; ++bj) { const f32x4 v0 = acc[ai][bj][m][0] * SC, v1 = acc[ai][bj][m][1] * SC;
                    int w0 = 0, w1 = 0;
                    w0 = __builtin_amdgcn_cvt_pk_fp8_f32(v0[0], v0[1], w0, false); w0 = __builtin_amdgcn_cvt_pk_fp8_f32(v0[2], v0[3], w0, true);
                    w1 = __builtin_amdgcn_cvt_pk_fp8_f32(v1[0], v1[1], w1, false); w1 = __builtin_amdgcn_cvt_pk_fp8_f32(v1[2], v1[3], w1, true);
                    w[2 * bj] = (unsigned)w0; w[2 * bj + 1] = (unsigned)w1; }
                *(u32x4*)rowp = mk4(w[0], w[1], w[2], w[3]); }
    } };
typedef EpiFp8RowsT<0> EpiFp8Rows;
__device__ __forceinline__ void phase_merge8(CP p, int L, LAS unsigned char* lds, int bid, int nb) {
    if constexpr (MERGE_F8) {
        { SchedMerge8 S{(const char*)p->YB8, (const char*)p->YC, (const char*)p->bt_br, (L == 0 ? p->G * 9 : p->G * 8), L, nb, bid};
          EpiFp8RowsT<1> E{(unsigned char*)p->Z + 2048 - 4 * 256, 6144};
          pg8::gemm_phase<false, true>(lds, 512, S, E); }
        { SchedMerge0 S{(const char*)p->YA, (const char*)p->bt_br, (L == 0 ? p->G * 9 : p->G * 8), L, nb, nb - 1 - bid};
          EpiBf16Rows E{p->Z, 3072};
          pg8::gemm_phase<false, false>(lds, 1024, S, E); }
        return;
    }
    SchedMerge S{(const char*)p->YA, (const char*)p->bt_br, (size_t)((const char*)p->YB - (const char*)p->YA), (L == 0 ? p->G * 9 : p->G * 8), L, nb, bid};
    EpiBf16Rows E{p->Z, 3072};
    pg8::gemm_phase<false, false>(lds, 1024, S, E);
}
__device__ __forceinline__ void phase_gate(CP p, int L, int bid, int nb) {
    const int lane = ltid() & 63, wid = ltid() >> 6;
    const int nv = (L == 0) ? p->G * SALL : p->G * SEQ;
    for (int i = bid * 8 + wid; i < nv; i += nb * 8) {
        const int r = (L == 0) ? i : ((i >> 11) * SALL + CTXL + (i & 2047));
        const bf16_t* z = p->Z + (size_t)r * 3072; const unsigned char* g = p->GP8 + (size_t)r * 3072;
        u32x4 zv[2][3]; u32x2 gv[2][3];
#pragma unroll
        for (int q = 0; q < 2; ++q)
#pragma unroll
            for (int j = 0; j < 3; ++j) { const int col = q * 512 + lane * 8; gv[q][j] = *(const u32x2*)(g + j * 1024 + col);
                if (MERGE_F8 && j > 0) { const u32x2 t8 = *(const u32x2*)((const unsigned char*)z + 2048 + (j - 1) * 1024 + col); zv[q][j] = mk4(t8.x, t8.y, 0u, 0u); }
                else zv[q][j] = *(const u32x4*)(z + j * 1024 + col); }
#pragma unroll
        for (int q = 0; q < 2; ++q) {
            const int col = q * 512 + lane * 8;
            float a[8] = {0.f, 0.f, 0.f, 0.f, 0.f, 0.f, 0.f, 0.f};
#pragma unroll
            for (int j = 0; j < 3; ++j) {
                const f32x2 g0 = __builtin_amdgcn_cvt_pk_f32_fp8((int)gv[q][j].x, false), g1 = __builtin_amdgcn_cvt_pk_f32_fp8((int)gv[q][j].x, true), g2 = __builtin_amdgcn_cvt_pk_f32_fp8((int)gv[q][j].y, false), g3 = __builtin_amdgcn_cvt_pk_f32_fp8((int)gv[q][j].y, true);
                float zf[8];
                if (MERGE_F8 && j > 0) { const f32x2 z0 = __builtin_amdgcn_cvt_pk_f32_fp8((int)zv[q][j].x, false), z1 = __builtin_amdgcn_cvt_pk_f32_fp8((int)zv[q][j].x, true), z2 = __builtin_amdgcn_cvt_pk_f32_fp8((int)zv[q][j].y, false), z3 = __builtin_amdgcn_cvt_pk_f32_fp8((int)zv[q][j].y, true);
                    zf[0] = z0[0]; zf[1] = z0[1]; zf[2] = z1[0]; zf[3] = z1[1]; zf[4] = z2[0]; zf[5] = z2[1]; zf[6] = z3[0]; zf[7] = z3[1]; }
                else { zf[0] = lo_bf(zv[q][j].x); zf[1] = hi_bf(zv[q][j].x); zf[2] = lo_bf(zv[q][j].y); zf[3] = hi_bf(zv[q][j].y); zf[4] = lo_bf(zv[q][j].z); zf[5] = hi_bf(zv[q][j].z); zf[6] = lo_bf(zv[q][j].w); zf[7] = hi_bf(zv[q][j].w); }
                a[0] += sigmoidf_(g0[0]) * zf[0]; a[1] += sigmoidf_(g0[1]) * zf[1]; a[2] += sigmoidf_(g1[0]) * zf[2]; a[3] += sigmoidf_(g1[1]) * zf[3];
                a[4] += sigmoidf_(g2[0]) * zf[4]; a[5] += sigmoidf_(g2[1]) * zf[5]; a[6] += sigmoidf_(g3[0]) * zf[6]; a[7] += sigmoidf_(g3[1]) * zf[7];
            }
            *(u32x4*)(p->HM + (size_t)r * 1024 + col) = mk4(pk2(a[0], a[1]), pk2(a[2], a[3]), pk2(a[4], a[5]), pk2(a[6], a[7]));
        }
    }
}
struct SchedOut { const char *A, *B; int nMv, L, G, c;
    __device__ __forceinline__ bool next(int i, pg8::Unit& u) const { int pmv, pn; if (!pg8::static_tile(i, G, c, nMv, 4, pmv, pn)) return false; const int pm = valid_tile(L, pmv);
        u.pm = pm; u.pn = pn; u.tag = 0; u.rows = nullptr; u.a = A + (size_t)pm * 256 * 1024 * 2; u.b = B + (size_t)pn * 256 * 1024 * 2; return true; } };
struct EpiOut { static constexpr int PERM = 2; CP p; int L, grp;
    __device__ __forceinline__ void operator()(const f32x4 (&acc)[2][2][4][2], const pg8::Unit& u, int wr, int wc, int fr, int fq) const {
        const int bl = u.pm / 9, mloc = u.pm - bl * 9, b = grp * p->G + bl;
        const bool isctx = mloc == 0;
        const float* md = isctx ? (p->mods_c + (size_t)L * 6144 + 2048) : (p->mods_l + ((size_t)L * 32 + b) * 6144 + 2048);
        const int col0 = u.pn * 256 + wc * 64 + 16 * fq;
#pragma unroll
        for (int ai = 0; ai < 2; ++ai)
#pragma unroll
            for (int m = 0; m < 4; ++m) {
                const int pos = mloc * 256 + ai * 128 + wr * 64 + m * 16 + fr;
                const float* src; bf16_t* dst;
                if (isctx) { src = p->ctx + ((size_t)b * CTXL + pos) * 1024; dst = p->XC1 + ((size_t)b * CTXL + pos) * 1024; }
                else { const size_t o = ((size_t)b * SEQ + pos - CTXL) * 1024; src = p->x + o; dst = p->XB + o; }
                f32x4 xq[4];
                if (L == 0) {
#pragma unroll
                    for (int q = 0; q < 4; ++q) xq[q] = *(const f32x4*)(src + col0 + 4 * q);
                } else { const u32x4 t0 = *(const u32x4*)(dst + col0), t1 = *(const u32x4*)(dst + col0 + 8);
                    xq[0] = (f32x4){lo_bf(t0.x), hi_bf(t0.x), lo_bf(t0.y), hi_bf(t0.y)}; xq[1] = (f32x4){lo_bf(t0.z), hi_bf(t0.z), lo_bf(t0.w), hi_bf(t0.w)};
                    xq[2] = (f32x4){lo_bf(t1.x), hi_bf(t1.x), lo_bf(t1.y), hi_bf(t1.y)}; xq[3] = (f32x4){lo_bf(t1.z), hi_bf(t1.z), lo_bf(t1.w), hi_bf(t1.w)}; }
                unsigned ow[8];
#pragma unroll
                for (int bj = 0; bj < 2; ++bj)
#pragma unroll
                    for (int n = 0; n < 2; ++n) { const int q = 2 * bj + n; const f32x4 g = *(const f32x4*)(md + col0 + 4 * q); const f32x4 xv = xq[q] + g * acc[ai][bj][m][n];
                        ow[2 * q] = pk2(xv[0], xv[1]); ow[2 * q + 1] = pk2(xv[2], xv[3]); }
                *(u32x4*)(dst + col0) = mk4(ow[0], ow[1], ow[2], ow[3]); *(u32x4*)(dst + col0 + 8) = mk4(ow[4], ow[5], ow[6], ow[7]);
            }
    } };
__device__ __forceinline__ void phase_outproj8(CP p, int L, int grp, LAS unsigned char* lds, int bid, int nb) {
    const int nMv = (L == 0 ? p->G * 9 : p->G * 8);
    {
        SchedOut S{(const char*)p->HM, (const char*)p->bt_out, nMv, L, nb, bid};
        EpiOut E{p, L, grp};
        pg8::gemm_phase<false, false>(lds, 1024, S, E);
    }
    int Ln = L, gn = grp + 1;
    if (gn >= p->ngroups) { Ln = L + 1; gn = 0; }
    if (false && Ln < 2) {
        const int ntiles = nMv * 4, rounds = (ntiles + nb - 1) / nb, rem = ntiles - (rounds - 1) * nb;
        const int skip = (rem < nb) ? rem : 0;
        if (bid >= skip) phase_prenorm(p, Ln, gn, bid - skip, nb - skip);
    }
}
struct SchedMoeUp { CP p; LAS int* tab; int L, G, c;
    __device__ __forceinline__ bool next(int i, pg8::Unit& u) const { const int x = i * G + c, tile = (x >> 4) * 8 + (x & 7), nt = (x >> 3) & 1; if (tile >= __builtin_amdgcn_readfirstlane(tab[65])) return false;
        const int e = __builtin_amdgcn_readfirstlane(moe_find(tab, tile));
        u.pm = tile; u.pn = nt; u.tag = e;
        u.rows = p->LIST + (size_t)tile * 256; u.a = (const char*)p->H2;
        u.b = (const char*)p->bt_eup + ((size_t)e * 512 + nt * 256) * 1024; return true; } };
struct EpiMoeUp { static constexpr bool PERM = true; bf16_t* ACT; const float* W;
    __device__ __forceinline__ void operator()(const f32x4 (&acc)[2][2][4][2], const pg8::Unit& u, int wr, int wc, int fr, int fq) const {
        const size_t pos0 = (size_t)u.pm * 256 + wr * 64 + fr;
#pragma unroll
        for (int ai = 0; ai < 2; ++ai)
#pragma unroll
            for (int m = 0; m < 4; ++m) { const size_t pos = pos0 + ai * 128 + m * 16; const float w = ((u.tag < 64) ? W[pos] : 1.0f) * pg8::F8_WINV;
                float v[8];
#pragma unroll
                for (int n = 0; n < 2; ++n)
#pragma unroll
                    for (int j = 0; j < 4; ++j) { const float g = acc[ai][0][m][n][j] * pg8::F8_WINV; v[n * 4 + j] = g * __builtin_amdgcn_rcpf(1.0f + __expf(-g)) * acc[ai][1][m][n][j] * w; }
                if (DOWN_F8) { int w0 = 0, w1 = 0;
                    w0 = __builtin_amdgcn_cvt_pk_fp8_f32(v[0] * ACT_SC, v[1] * ACT_SC, w0, false); w0 = __builtin_amdgcn_cvt_pk_fp8_f32(v[2] * ACT_SC, v[3] * ACT_SC, w0, true);
                    w1 = __builtin_amdgcn_cvt_pk_fp8_f32(v[4] * ACT_SC, v[5] * ACT_SC, w1, false); w1 = __builtin_amdgcn_cvt_pk_fp8_f32(v[6] * ACT_SC, v[7] * ACT_SC, w1, true);
                    *(u32x2*)((unsigned char*)ACT + pos * 256 + u.pn * 128 + wc * 32 + 8 * fq) = mk2((unsigned)w0, (unsigned)w1); }
                else *(u32x4*)(ACT + pos * 256 + u.pn * 128 + wc * 32 + 8 * fq) = mk4(pk2(v[0], v[1]), pk2(v[2], v[3]), pk2(v[4], v[5]), pk2(v[6], v[7])); }
    } };
__device__ __forceinline__ void phase_moe_up8(CP p, int L, LAS unsigned char* lds, int bid, int nb) {
    moe_table8(p, L, lds);
    SchedMoeUp S{p, (LAS int*)(lds + MOE_TAB), L, nb, bid};
    EpiMoeUp E{p->ACT, p->LISTW};
    pg8::gemm_phase<true, true>(lds, 512, S, E);
}
struct SchedMoeDown { CP p; LAS int* tab; int G, c;
    __device__ __forceinline__ bool next(int i, pg8::Unit& u) const { const int x = i * G + c, tile = (x >> 5) * 8 + (x & 7), nt = (x >> 3) & 3; if (tile >= __builtin_amdgcn_readfirstlane(tab[65])) return false;
        const int e = __builtin_amdgcn_readfirstlane(moe_find(tab, tile));
        u.pm = tile; u.pn = nt; u.tag = e; u.rows = nullptr; u.a = (const char*)p->ACT + (size_t)tile * 256 * 256 * (DOWN_F8 ? 1 : 2); u.b = (const char*)p->bt_edn + ((size_t)e * 1024 + nt * 256) * 256 * (DOWN_F8 ? 1 : 2); return true; } };
__device__ __forceinline__ void phase_moe_down8(CP p, int L, LAS unsigned char* lds, int bid, int nb) {
    moe_table8(p, L, lds);
    SchedMoeDown S{p, (LAS int*)(lds + MOE_TAB), nb, bid};
    if constexpr (DOWN_F8) { EpiFp8RowsT<2> E{(unsigned char*)p->DBUF, 1024}; pg8::gemm_phase<false, true>(lds, 128, S, E); return; }
    EpiFp8Rows E{(unsigned char*)p->DBUF, 1024};
    pg8::gemm_phase<false, false>(lds, 256, S, E);
}

extern __shared__ __attribute__((aligned(16))) unsigned char smem_raw[];
#define XB_TMO      128
#define XB_XCNT(j)  (256  + 64 * (j))
#define XB_XSUB(j)  (1280 + 64 * (j))
#define XB_XGEN(j)  (2304 + 64 * (j))
#define XB_TOP      3328
#define XB_TOPGEN   3392
#define XCD_BAR_WORDS 3456
#define XB_SPIN_CAP (1u << 18)

__device__ __forceinline__ unsigned xb_ld(unsigned* p)              { return __hip_atomic_load(p, __ATOMIC_RELAXED, __HIP_MEMORY_SCOPE_AGENT); }
__device__ __forceinline__ unsigned xb_add(unsigned* p, unsigned v) { return __hip_atomic_fetch_add(p, v, __ATOMIC_RELAXED, __HIP_MEMORY_SCOPE_AGENT); }
__device__ __forceinline__ unsigned xb_xcc_id() { return (unsigned)__builtin_amdgcn_s_getreg((3 << 11) | 20) & 0xFu; }
#define XB_SPIN(cond, bar) do { unsigned _sp = 0; while (cond) { __builtin_amdgcn_s_sleep(1); \
    if ((++_sp & 255u) == 0u) { if (xb_ld(&(bar)[XB_TMO])) break; if (_sp > XB_SPIN_CAP) { atomicAdd(&(bar)[XB_TMO], 1u); break; } } } } while (0)

struct XcdBarrier {
    unsigned* bar; unsigned x;
    volatile LAS unsigned* st;
};

__device__ __forceinline__ XcdBarrier xcd_barrier_post(unsigned* bar, volatile LAS unsigned* st) {
    XcdBarrier b; b.bar = bar; b.x = xb_xcc_id(); b.st = st;
    if (threadIdx.x == 0) (void)xb_add(&bar[XB_XCNT(b.x)], 1u);
    return b;
}
__device__ __forceinline__ void xcd_barrier_complete(unsigned* bar, unsigned x, unsigned& nloc, unsigned& nx) {
    const unsigned G = gridDim.x * gridDim.y * gridDim.z;
    unsigned sum, cnt, mine, sp = 0u;
    for (;;) {
        sum = 0u; cnt = 0u; mine = 0u;
#pragma unroll
        for (unsigned j = 0; j < 16; ++j) { const unsigned c = xb_ld(&bar[XB_XCNT(j)]); sum += c; cnt += (c > 0u) ? 1u : 0u; mine = (j == x) ? c : mine; }
        if (sum == G) break;
        __builtin_amdgcn_s_sleep(1);
        if ((++sp & 255u) == 0u) { if (xb_ld(&bar[XB_TMO])) break; if (sp > XB_SPIN_CAP) { atomicAdd(&bar[XB_TMO], 1u); break; } }
    }
    nloc = mine > 0u ? mine : 1u; nx = cnt > 0u ? cnt : 1u;
}

__device__ __forceinline__ void xcd_barrier(const XcdBarrier& b) {
    asm volatile("s_waitcnt vmcnt(0)" ::: "memory");
    __syncthreads();
    if (threadIdx.x == 0) {
        unsigned* bar = b.bar;
        __builtin_amdgcn_s_waitcnt(0);
        unsigned nloc = b.st[0], nx = b.st[1];
        if (nloc == 0u) { xcd_barrier_complete(bar, b.x, nloc, nx); b.st[0] = nloc; b.st[1] = nx; }
        const unsigned old = xb_add(&bar[XB_XSUB(b.x)], 1u);
        const unsigned gen = old / nloc;
        if (old + 1u == (gen + 1u) * nloc) {
            __builtin_amdgcn_fence(__ATOMIC_RELEASE, "agent");
            asm volatile("s_waitcnt vmcnt(0)" ::: "memory");
            const unsigned og = xb_add(&bar[XB_TOP], 1u);
            const unsigned tg = og / nx;
            if (og + 1u == (tg + 1u) * nx) xb_add(&bar[XB_TOPGEN], 1u);
            else XB_SPIN(xb_ld(&bar[XB_TOPGEN]) == tg, bar);
            __builtin_amdgcn_fence(__ATOMIC_ACQUIRE, "agent");
            xb_add(&bar[XB_XGEN(b.x)], 1u);
            asm volatile("s_waitcnt vmcnt(0)" ::: "memory");
        } else {
            XB_SPIN(xb_ld(&bar[XB_XGEN(b.x)]) == gen, bar);
            __builtin_amdgcn_fence(__ATOMIC_ACQUIRE, "agent");
            asm volatile("s_waitcnt vmcnt(0)" ::: "memory");
        }
    }
    __syncthreads();
}


constexpr int XB_LDS_OFF = LDS_BYTES - 16;
#if MK_CG_SYNC
#define GBAR() cooperative_groups::this_grid().sync()
#else
#define GBAR() do { XcdBarrier b2_ = bar; asm volatile("" : "+s"(b2_.bar), "+s"(b2_.x)); xcd_barrier(b2_); } while (0)
#endif
#define PH(call) do { CP p = pk; int bid = bid0, nb = nb0, L = L0v, grp = grp0v; LAS unsigned char* lds = lds0; asm volatile("" : "+s"(p), "+s"(bid), "+s"(nb), "+s"(lds), "+s"(L), "+s"(grp)); (void)L; (void)grp; (void)bid; (void)nb; (void)lds; __syncthreads(); call; } while (0)
__global__ void __launch_bounds__(NTHREADS, 2) k_fused(Params p_) {
    CP pk = (CP)__builtin_amdgcn_kernarg_segment_ptr();
    LAS unsigned char* lds0 = (LAS unsigned char*)smem_raw;
    asm volatile("s_setreg_imm32_b32 hwreg(HW_REG_MODE, 23, 1), 1");
    const int bid0 = blockIdx.x, nb0 = gridDim.x;
    if (ltid() == 0) *(LAS u32x4*)(lds0 + XB_LDS_OFF) = mk4(0u, 0u, 0u, 0u);
    __syncthreads();
    XcdBarrier bar = xcd_barrier_post(pk->bar, (volatile LAS unsigned*)(lds0 + XB_LDS_OFF));
    int L0v = 0, grp0v = 0;
    PH(phase_mods(p, lds, bid, nb));
    for (L0v = 0; L0v < 2; ++L0v) {
        PH(phase_convert(p, L, lds, bid, nb));
        GBAR();
        const int ngroups = pk->ngroups;
        for (grp0v = 0; grp0v < ngroups; ++grp0v) {
            if (L0v == 0 && grp0v == 0) { PH(phase_prenorm(p, L, grp, bid, nb)); GBAR(); }
            if (PROBE & 128) { PH(phase_prenorm(p, L, grp, bid, nb)); GBAR(); }
            PH(phase_inproj8(p, L, lds, bid, nb));             GBAR();
            if (PROBE & 1) { PH(phase_inproj8(p, L, lds, bid, nb)); GBAR(); }
            PH(phase_daprep(p, L, grp, bid, nb));           GBAR();
            PH(phase_mix_dyn(p, L, grp, lds));              GBAR();
            if (PROBE & 2) { PH(phase_mix_dyn(p, L, grp, lds, 1)); GBAR(); }
            if (PROBE & 4) { PH(phase_probe_at(p, L, lds, bid, nb)); GBAR(); }
            if (PROBE & 8) { PH(phase_probe_lru(p, L, lds, bid, nb)); GBAR(); }
            if (PROBE & 512) { PH(phase_probe_ml(p, L, lds, bid, nb)); GBAR(); }
            PH(phase_lrufinish(p, L, bid, nb));
            PH(phase_mlfinish(p, L, bid, nb));              GBAR();
            PH(phase_merge8(p, L, lds, bid, nb));           GBAR();
            PH(phase_gate(p, L, bid, nb));                  GBAR();
            if (PROBE & 64) { PH(phase_merge8(p, L, lds, bid, nb)); GBAR(); PH(phase_gate(p, L, bid, nb)); GBAR(); }
            PH(phase_outproj8(p, L, grp, lds, bid, nb));    GBAR();
            PH(phase_route1(p, L, grp, lds, bid, nb));      GBAR();
            PH(phase_route2(p, L, lds, bid, nb));           GBAR();
            if (PROBE & 16384) { PH(phase_route1(p, L, grp, lds, bid, nb)); GBAR(); }
            if (PROBE & 32768) { PH(phase_route2(p, L, lds, bid, nb)); GBAR(); }
            if (PROBE & 16) { PH(phase_route1(p, L, grp, lds, bid, nb)); GBAR(); PH(phase_route2(p, L, lds, bid, nb)); GBAR(); }
            PH(phase_moe_up8(p, L, lds, bid, nb));          GBAR();
            PH(phase_moe_down8(p, L, lds, bid, nb));        GBAR();
            if (PROBE & 32) { PH(phase_moe_up8(p, L, lds, bid, nb)); GBAR(); PH(phase_moe_down8(p, L, lds, bid, nb)); GBAR(); }
            if (PROBE & 2048) { PH(phase_moe_up8(p, L, lds, bid, nb)); GBAR(); }
            if (PROBE & 4096) { PH(phase_moe_down8(p, L, lds, bid, nb)); GBAR(); }
            if (PROBE & 256) { for (int z = 0; z < 12; ++z) GBAR(); }
            PH(phase_moe_combine(p, L, grp, lds, bid, nb)); GBAR();
        }
    }
}

static inline size_t align_up(size_t v, size_t a) { return (v + a - 1) / a * a; }

extern "C" void kernel_launch(void* const* d_in, const int* in_sizes, int n_in, void* d_out, int out_size, void* d_ws, size_t ws_size, hipStream_t stream) {
    (void)in_sizes; (void)n_in; (void)out_size;
    Params p; memset(&p, 0, sizeof(p));
    const float** f = (const float**)&p;
    for (int i = 0; i < 32; ++i) f[i] = (const float*)d_in[i];
    p.out = (float*)d_out;
    unsigned char* ws = (unsigned char*)d_ws;
    int G = 8;
    for (;;) {
        size_t o = 0;
        auto take = [&](size_t bytes) { size_t r = o; o = align_up(o + bytes, 256); return r; };
        const size_t RG = (size_t)G * SALL;
        const size_t o_bar = take(16384), o_ecnt = take(1024), o_lam = take(256), o_modsl = take((size_t)2 * 32 * 6144 * 4), o_modsc = take((size_t)2 * 6144 * 4), o_rope = take((size_t)2048 * 32 * 2 * 4);
        const size_t o_btin = take((size_t)BTIN_ROWS * 1024 * 2), o_btbr = take((size_t)3 * 1024 * 1024 * 2), o_btout = take((size_t)1024 * 1024 * 2);
        const size_t o_bteup = take((size_t)65 * 512 * 1024), o_btin8 = take((size_t)BTIN_ROWS * 1024), o_h8 = take(RG * 1024), o_yb8 = take(RG * 1024), o_mo8 = take(RG * 1024), o_hm = take(RG * 1024 * 2), o_btedn = take((size_t)65 * 1024 * 256 * (DOWN_F8 ? 1 : 2)), o_btlru = take((size_t)16 * 256 * 128 * 2);
        const size_t o_h = take(RG * 1024 * 2);
        size_t pbytes = RG * PWID * 2; const size_t actrows = (size_t)7 * RG + 65 * 256; const size_t actbytes = align_up(actrows * 256 * 2, 256); if (pbytes < actbytes + actrows * 1024) pbytes = actbytes + actrows * 1024;
        const size_t o_p = take(pbytes), o_gates = take(RG * 16 * 4);
        const size_t o_ya = take(RG * 1024 * 2), o_yb = take(RG * 1024 * 2), o_yc = take(RG * 1024 * (MERGE_F8 ? 1 : 2)), o_hb = take(RG * 1024 * 2);
        const size_t o_lsum = take((size_t)G * 2 * 36 * 1024 * 8), o_xc1 = take((size_t)TCTX * 1024 * 2), o_xb = take((size_t)NBATCH * SEQ * 1024 * 2);
        const size_t o_z = take(RG * 3072 * 2), o_hb2 = take(RG * 1024 * 2), o_gp8 = take(RG * 3072);
        const size_t o_list = take(actrows * 4), o_listw = take(actrows * 4), o_cc = take(RG / 32 * 64 * 4), o_pe = take(RG * 6 * 4), o_pw = take(RG * 6 * 4), o_pos = take(RG * 6 * 4);
        if (o > ws_size && G > 1) { G >>= 1; continue; }
        p.bar = (unsigned*)(ws + o_bar); p.ecnt = (int*)(ws + o_ecnt); p.lamv = (float*)(ws + o_lam); p.mods_l = (float*)(ws + o_modsl); p.mods_c = (float*)(ws + o_modsc); p.rope = (float*)(ws + o_rope);
        p.bt_in = (bf16_t*)(ws + o_btin); p.bt_br = (bf16_t*)(ws + o_btbr); p.bt_out = (bf16_t*)(ws + o_btout); p.bt_eup = (bf16_t*)(ws + o_bteup); p.bt_edn = (bf16_t*)(ws + o_btedn); p.bt_lru = (bf16_t*)(ws + o_btlru);
        p.H8 = ws + o_h8; p.bt_in8 = ws + o_btin8; p.YB8 = ws + o_yb8; p.MO8 = ws + o_mo8; p.HM = (bf16_t*)(ws + o_hm);
        p.H = (bf16_t*)(ws + o_h); p.P = (bf16_t*)(ws + o_p); p.ACT = p.P; p.GATES = (float*)(ws + o_gates);
        p.YA = (bf16_t*)(ws + o_ya); p.YB = (bf16_t*)(ws + o_yb); p.HB = (bf16_t*)(ws + o_hb); p.YC = (bf16_t*)(ws + o_yc);
        p.LSUM = (float*)(ws + o_lsum); p.XC1 = (bf16_t*)(ws + o_xc1); p.XB = (bf16_t*)(ws + o_xb); p.H2 = p.YA; p.LIST = (int*)(ws + o_list); p.LISTW = (float*)(ws + o_listw);
        p.DBUF = (bf16_t*)(ws + o_p + actbytes); p.Z = (bf16_t*)(ws + o_z); p.HB2 = (bf16_t*)(ws + o_hb2); p.GP8 = ws + o_gp8; p.CC = (int*)(ws + o_cc); p.PE = (int*)(ws + o_pe); p.PW = (float*)(ws + o_pw); p.POS = (int*)(ws + o_pos);
        break;
    }
    p.G = G; p.ngroups = NBATCH / G;
#if MK_ONE_LAUNCH
    static int grid1 = 0;
    if (!grid1) {
        (void)hipFuncSetAttribute((const void*)k_fused, hipFuncAttributeMaxDynamicSharedMemorySize, LDS_BYTES);
        int dev = 0, cus = 0, per_cu = 0;
        (void)hipGetDevice(&dev);
        (void)hipDeviceGetAttribute(&cus, hipDeviceAttributeMultiprocessorCount, dev);
        (void)hipOccupancyMaxActiveBlocksPerMultiprocessor(&per_cu, k_fused, NTHREADS, LDS_BYTES);
        grid1 = (per_cu >= 1) ? cus : 0;
    }
    (void)hipMemsetAsync(p.bar, 0, 16384 + 1024, stream);
#if MK_CG_SYNC
    if (grid1 > 0) { void* args[] = {&p}; (void)hipLaunchCooperativeKernel((const void*)k_fused, dim3(grid1), dim3(NTHREADS), args, LDS_BYTES, stream); }
#else
    if (grid1 > 0) hipLaunchKernelGGL(k_fused, dim3(grid1), dim3(NTHREADS), LDS_BYTES, stream, p);
#endif
    return;
#endif
}
```
